# Optimizing an MI355X kernel written in HIP

```python
import jax, jax.numpy as jnp
from jax import lax
import numpy as np

D_MODEL = 1024
BATCH = 32
SEQ = 2048
DEPTH = 2

CHUNK = 64

A_HEADS = 8
A_HEAD_DIM = 64
A_WIDTH = A_HEADS * A_HEAD_DIM
A_LEFT_CHUNKS = 8
A_BAND = (A_LEFT_CHUNKS + 1) * CHUNK
A_REL_CLIP = 256
A_N_REL = (CHUNK - 1) + A_REL_CLIP + 1

B_HEADS = 4
B_HEAD_DIM = 128
B_WIDTH = B_HEADS * B_HEAD_DIM
B_CONV = 4

C_WINDOWS = (2, 4, 8, 16)
C_GROUPS = 4
C_GROUP_DIM = 128
C_WIDTH = C_GROUPS * C_GROUP_DIM

N_BRANCH = 3
IN_SIZES = (A_WIDTH, A_WIDTH, A_WIDTH, 3 * B_WIDTH, B_HEADS, B_HEADS, B_WIDTH, C_WIDTH, N_BRANCH * D_MODEL)
D_IN = 3 * A_WIDTH + 4 * B_WIDTH + 2 * B_HEADS + C_WIDTH + N_BRANCH * D_MODEL

MOE_GROUPS = 4
MOE_PER_GROUP = 8
N_EXPERTS = MOE_GROUPS * MOE_PER_GROUP
MOE_TOPK = 2
MOE_FF = 512
MOE_BLOCK = 256

DN_ALPHA = (2 * DEPTH) ** 0.25
DN_BETA = (8 * DEPTH) ** -0.25
LN_EPS = 1e-5
RMS_EPS = 1e-6

kernel_name = 'hybrid_chunk_attn_gdn_pool_hmoe'


def layer_norm(x, g, b):
    xf = x.astype(jnp.float32)
    mu = jnp.mean(xf, axis=-1, keepdims=True)
    var = jnp.mean(jnp.square(xf - mu), axis=-1, keepdims=True)
    return ((xf - mu) * lax.rsqrt(var + LN_EPS) * g + b).astype(x.dtype)


def split_cols(t, sizes):
    outs, start = [], 0
    for s in sizes:
        outs.append(t[..., start:start + s])
        start += s
    return outs


def chunk_band_attention(q, k, v, rel_bias):
    b, l, h, dh = q.shape
    nc = l // CHUNK
    pad = A_LEFT_CHUNKS * CHUNK
    kp = jnp.pad(k, ((0, 0), (pad, 0), (0, 0), (0, 0)))
    vp = jnp.pad(v, ((0, 0), (pad, 0), (0, 0), (0, 0)))
    dist = jnp.arange(CHUNK)[:, None] + pad - jnp.arange(A_BAND)[None, :]
    idx = jnp.clip(dist, -(CHUNK - 1), A_REL_CLIP) + (CHUNK - 1)
    bias = rel_bias[:, idx].astype(jnp.float32)
    qc = jnp.moveaxis(q.reshape(b, nc, CHUNK, h, dh), 1, 0)
    scale = dh ** -0.5

    def one_chunk(args):
        qi, ci = args
        start = ci * CHUNK
        kb = lax.dynamic_slice_in_dim(kp, start, A_BAND, axis=1)
        vb = lax.dynamic_slice_in_dim(vp, start, A_BAND, axis=1)
        s = jnp.einsum('bqhd,bkhd->bhqk', qi, kb, preferred_element_type=jnp.float32) * scale + bias
        valid = (start - pad + jnp.arange(A_BAND)) >= 0
        s = jnp.where(valid, s, -jnp.inf)
        p = jax.nn.softmax(s, axis=-1).astype(vb.dtype)
        return jnp.einsum('bhqk,bkhd->bqhd', p, vb)

    o = lax.map(one_chunk, (qc, jnp.arange(nc)))
    return jnp.moveaxis(o, 0, 1).reshape(b, l, h * dh)


def causal_depthwise_conv(x, w):
    kw, c = w.shape
    return lax.conv_general_dilated(
        x, w[:, None, :].astype(x.dtype), window_strides=(1,), padding=[(kw - 1, 0)],
        dimension_numbers=('NWC', 'WIO', 'NWC'), feature_group_count=c)


def l2_normalize(t):
    return t * lax.rsqrt(jnp.sum(t * t, axis=-1, keepdims=True) + RMS_EPS)


def gated_delta_rule(q, k, v, beta, g):
    b, l, h, dk = q.shape
    dv = v.shape[-1]
    nc = l // CHUNK

    def to_chunks(t):
        t = t.reshape((b, nc, CHUNK, h) + t.shape[3:])
        return jnp.moveaxis(t, 3, 1)

    q = to_chunks(q) * (dk ** -0.5)
    k = to_chunks(k)
    v = to_chunks(v)
    beta = to_chunks(beta)
    gc = jnp.cumsum(to_chunks(g), axis=-1)
    tril = jnp.tril(jnp.ones((CHUNK, CHUNK), dtype=bool))
    strict = jnp.tril(jnp.ones((CHUNK, CHUNK), dtype=bool), -1)
    decay = jnp.exp(jnp.where(tril, gc[..., :, None] - gc[..., None, :], -jnp.inf))
    kbeta = k * beta[..., None]
    lower = jnp.where(strict, jnp.einsum('bhnid,bhnjd->bhnij', kbeta, k) * decay, 0.0)
    eye = jnp.eye(CHUNK, dtype=q.dtype)
    tmat = lax.linalg.triangular_solve(eye + lower, jnp.broadcast_to(eye, lower.shape),
                                       left_side=True, lower=True)
    u = tmat @ (v * beta[..., None])
    w = tmat @ (kbeta * jnp.exp(gc)[..., None])
    qk = jnp.einsum('bhnid,bhnjd->bhnij', q, k) * decay
    qg = q * jnp.exp(gc)[..., None]
    kd = k * jnp.exp(gc[..., -1:] - gc)[..., None]
    glast = jnp.exp(gc[..., -1])

    def step(state, inp):
        u_i, w_i, qk_i, qg_i, kd_i, gl_i = inp
        v_new = u_i - w_i @ state
        o_i = qg_i @ state + qk_i @ v_new
        state = state * gl_i[..., None, None] + jnp.einsum('bhck,bhcv->bhkv', kd_i, v_new)
        return state, o_i

    xs = tuple(jnp.moveaxis(t, 2, 0) for t in (u, w, qk, qg, kd, glast))
    s0 = jnp.zeros((b, h, dk, dv), q.dtype)
    _, o = lax.scan(step, s0, xs)
    return o.transpose(1, 0, 3, 2, 4).reshape(b, l, h, dv)


def multiscale_pool(u, pool_w, pool_scale):
    b, l, _ = u.shape
    uf = u.astype(jnp.float32)
    cs0 = jnp.pad(jnp.cumsum(uf, axis=1), ((0, 0), (1, 0), (0, 0)))
    pos = jnp.arange(1, l + 1, dtype=jnp.float32)
    groups = []
    for gi, win in enumerate(C_WINDOWS):
        lo_c, hi_c = gi * C_GROUP_DIM, (gi + 1) * C_GROUP_DIM
        hi = cs0[:, 1:, lo_c:hi_c]
        lo = jnp.pad(cs0[:, :, lo_c:hi_c], ((0, 0), (win - 1, 0), (0, 0)))[:, :l]
        cnt = jnp.minimum(pos, float(win))[None, :, None]
        groups.append((hi - lo) / cnt - uf[:, :, lo_c:hi_c])
    pooled = jnp.stack(groups, axis=2)
    mixed = jnp.einsum('blgc,gcd->blgd', pooled, pool_w.astype(jnp.float32))
    return (mixed.reshape(b, l, C_WIDTH) * pool_scale).astype(u.dtype)


def hybrid_mixer(x, w_in, rel_bias, conv_w, a_log, dt_bias, gdn_norm_g, pool_w, pool_scale,
                 w_br_a, w_br_b, w_br_c, gate_b, w_out):
    b, l, d = x.shape
    proj = x @ w_in
    qa, ka, va, qkv_b, beta_l, a_l, gate_bo, u_c, gate_l = split_cols(proj, IN_SIZES)
    shp_a = (b, l, A_HEADS, A_HEAD_DIM)
    o_a = chunk_band_attention(qa.reshape(shp_a), ka.reshape(shp_a), va.reshape(shp_a), rel_bias)
    qkv_b = jax.nn.silu(causal_depthwise_conv(qkv_b, conv_w)).astype(jnp.float32)
    shp_b = (b, l, B_HEADS, B_HEAD_DIM)
    qb, kb, vb = [t.reshape(shp_b) for t in split_cols(qkv_b, (B_WIDTH, B_WIDTH, B_WIDTH))]
    beta = jax.nn.sigmoid(beta_l.astype(jnp.float32))
    g = -jnp.exp(a_log.astype(jnp.float32)) * jax.nn.softplus(a_l.astype(jnp.float32) + dt_bias)
    o_b = gated_delta_rule(l2_normalize(qb), l2_normalize(kb), vb, beta, g)
    o_b = o_b * lax.rsqrt(jnp.mean(o_b * o_b, axis=-1, keepdims=True) + RMS_EPS) * gdn_norm_g
    o_b = o_b * jax.nn.silu(gate_bo.reshape(shp_b).astype(jnp.float32))
    o_b = o_b.reshape(b, l, B_WIDTH).astype(x.dtype)
    o_c = multiscale_pool(u_c, pool_w, pool_scale)
    gates = jax.nn.sigmoid(gate_l.reshape(b, l, N_BRANCH, d).astype(jnp.float32) + gate_b).astype(x.dtype)
    y = (gates[:, :, 0] * (o_a @ w_br_a) + gates[:, :, 1] * (o_b @ w_br_b)
         + gates[:, :, 2] * (o_c @ w_br_c))
    return y @ w_out


def hierarchical_moe(x, wg, bg, we, be, w1, w3, w2):
    b, l, d = x.shape
    xt = x.reshape(-1, d)
    t = xt.shape[0]
    lg = (xt @ wg).astype(jnp.float32) + bg
    pg = jax.nn.softmax(lg, axis=-1)
    gsel = jnp.argmax(lg, axis=-1)
    p_top = jnp.take_along_axis(pg, gsel[:, None], axis=-1)
    le = ((xt @ we).astype(jnp.float32) + be).reshape(t, MOE_GROUPS, MOE_PER_GROUP)
    le = jnp.take_along_axis(le, gsel[:, None, None], axis=1)[:, 0]
    top_l, top_i = lax.top_k(le, MOE_TOPK)
    wts = jax.nn.softmax(top_l, axis=-1) * p_top
    eid = gsel[:, None] * MOE_PER_GROUP + top_i
    m = t * MOE_TOPK
    e_flat = eid.reshape(-1).astype(jnp.int32)
    w_flat = wts.reshape(-1)
    tok_flat = jnp.repeat(jnp.arange(t, dtype=jnp.int32), MOE_TOPK)
    order = jnp.argsort(e_flat)
    e_sorted = e_flat[order]
    counts = jnp.bincount(e_flat, length=N_EXPERTS)
    padded = (counts + MOE_BLOCK - 1) // MOE_BLOCK * MOE_BLOCK
    pad_end = jnp.cumsum(padded)
    pad_start = pad_end - padded
    start = jnp.cumsum(counts) - counts
    dest = pad_start[e_sorted] + jnp.arange(m) - start[e_sorted]
    n_blocks = -(-m // MOE_BLOCK) + N_EXPERTS
    cap = n_blocks * MOE_BLOCK
    row_tok = jnp.zeros((cap,), jnp.int32).at[dest].set(tok_flat[order])
    row_w = jnp.zeros((cap,), jnp.float32).at[dest].set(w_flat[order])
    block_e = jnp.minimum(jnp.searchsorted(pad_end, jnp.arange(n_blocks) * MOE_BLOCK, side='right'),
                          N_EXPERTS - 1)
    xs = xt[row_tok].reshape(n_blocks, MOE_BLOCK, d)

    def expert_block(args):
        xb, e = args
        hdn = jax.nn.silu(xb @ w1[e]) * (xb @ w3[e])
        return hdn @ w2[e]

    yb = lax.map(expert_block, (xs, block_e)).reshape(cap, d)
    y = jnp.zeros((t, d), jnp.float32).at[row_tok].add(yb.astype(jnp.float32) * row_w[:, None])
    return y.astype(x.dtype).reshape(b, l, d)


def setup_inputs(seed: int = 0) -> dict:
    key = jax.random.key(seed)
    ks = iter(jax.random.split(key, 40))

    def nrm(shape, scale):
        return jax.random.normal(next(ks), shape, jnp.float32) * scale

    def unif(shape, lo, hi):
        return jax.random.uniform(next(ks), shape, jnp.float32, lo, hi)

    L = DEPTH
    d = D_MODEL
    dt = jnp.exp(unif((L, B_HEADS), float(np.log(1e-3)), float(np.log(1e-1))))
    return {
        'x': nrm((BATCH, SEQ, d), 1.0),
        'w_in': nrm((L, d, D_IN), d ** -0.5),
        'attn_rel_bias': nrm((L, A_HEADS, A_N_REL), 0.2),
        'gdn_conv_w': nrm((L, B_CONV, 3 * B_WIDTH), B_CONV ** -0.5),
        'gdn_a_log': jnp.log(unif((L, B_HEADS), 1.0, 16.0)),
        'gdn_dt_bias': dt + jnp.log(-jnp.expm1(-dt)),
        'gdn_norm_g': 1.0 + nrm((L, B_HEAD_DIM), 0.02),
        'pool_w': nrm((L, C_GROUPS, C_GROUP_DIM, C_GROUP_DIM), C_GROUP_DIM ** -0.5),
        'pool_scale': 1.0 + nrm((L, C_WIDTH), 0.02),
        'w_branch_a': nrm((L, A_WIDTH, d), A_WIDTH ** -0.5),
        'w_branch_b': nrm((L, B_WIDTH, d), B_WIDTH ** -0.5),
        'w_branch_c': nrm((L, C_WIDTH, d), C_WIDTH ** -0.5),
        'gate_b': nrm((L, N_BRANCH, d), 0.02),
        'w_out': nrm((L, d, d), d ** -0.5 * DN_BETA),
        'ln1_g': 1.0 + nrm((L, d), 0.02),
        'ln1_b': nrm((L, d), 0.02),
        'router_group_w': nrm((L, d, MOE_GROUPS), d ** -0.5),
        'router_group_b': nrm((L, MOE_GROUPS), 0.01),
        'router_expert_w': nrm((L, d, N_EXPERTS), d ** -0.5),
        'router_expert_b': nrm((L, N_EXPERTS), 0.01),
        'moe_w1': nrm((L, N_EXPERTS, d, MOE_FF), d ** -0.5),
        'moe_w3': nrm((L, N_EXPERTS, d, MOE_FF), d ** -0.5),
        'moe_w2': nrm((L, N_EXPERTS, MOE_FF, d), MOE_FF ** -0.5 * DN_BETA),
        'ln2_g': 1.0 + nrm((L, d), 0.02),
        'ln2_b': nrm((L, d), 0.02),
    }


def reference(x, w_in, attn_rel_bias, gdn_conv_w, gdn_a_log, gdn_dt_bias, gdn_norm_g, pool_w,
              pool_scale, w_branch_a, w_branch_b, w_branch_c, gate_b, w_out, ln1_g, ln1_b,
              router_group_w, router_group_b, router_expert_w, router_expert_b,
              moe_w1, moe_w3, moe_w2, ln2_g, ln2_b):
    for i in range(DEPTH):
        mix = hybrid_mixer(x, w_in[i], attn_rel_bias[i], gdn_conv_w[i], gdn_a_log[i], gdn_dt_bias[i],
                           gdn_norm_g[i], pool_w[i], pool_scale[i], w_branch_a[i], w_branch_b[i],
                           w_branch_c[i], gate_b[i], w_out[i])
        x = layer_norm(DN_ALPHA * x + mix, ln1_g[i], ln1_b[i])
        ffn = hierarchical_moe(x, router_group_w[i], router_group_b[i], router_expert_w[i],
                               router_expert_b[i], moe_w1[i], moe_w3[i], moe_w2[i])
        x = layer_norm(DN_ALPHA * x + ffn, ln2_g[i], ln2_b[i])
    return x
```

```cpp
#include <hip/hip_runtime.h>
#include <cstdio>
#include <cstdint>

#define GAS __attribute__((address_space(1)))
#define LAS __attribute__((address_space(3)))
typedef unsigned short bf16_t;
typedef short bf16x8 __attribute__((ext_vector_type(8)));
typedef float f32x4 __attribute__((ext_vector_type(4)));
typedef float f32x2 __attribute__((ext_vector_type(2)));
typedef unsigned u32x4 __attribute__((ext_vector_type(4)));
typedef unsigned u32x2 __attribute__((ext_vector_type(2)));

constexpr int BATCH = 32, SEQ = 2048, D = 1024, T = BATCH * SEQ, DEPTH = 2, CHUNK = 64, NCH = SEQ / CHUNK;
constexpr int A_HEADS = 8, A_HD = 64, A_W = 512, A_LEFT = 8, A_BAND = 576, A_CLIP = 256, A_NREL = 320;
constexpr int B_HEADS = 4, B_HD = 128, B_W = 512;
constexpr int C_W = 512;
constexpr int D_IN = 7176;
constexpr int OFF_QA = 0, OFF_KA = 512, OFF_VA = 1024, OFF_QKVB = 1536, OFF_BETA = 3072, OFF_DEC = 3076, OFF_GATEB = 3080, OFF_POOL = 3592, OFF_GATES = 4104;
constexpr int NEXP = 32, MOE_FF = 512, MOE_BLOCK = 256;
constexpr int NPAIR = 2 * T, NBLK_MAX = NPAIR / MOE_BLOCK + NEXP, CAP = NBLK_MAX * MOE_BLOCK;
constexpr float DN_ALPHA = 1.4142135623730951f;
constexpr float LN_EPS = 1e-5f, RMS_EPS = 1e-6f;
constexpr int N1 = 3584;

constexpr size_t MiB = 1ull << 20, U = 128 * MiB;
constexpr size_t WS_CTL = 0;
constexpr size_t WS_WIN1 = 1 * MiB, WS_WV = 8 * MiB, WS_WG = 9 * MiB, WS_WBR = 15 * MiB, WS_WOUT = 18 * MiB, WS_W13 = 20 * MiB, WS_W2 = 84 * MiB;
constexpr size_t WS_XB = U;
constexpr size_t WS_P = 2 * U;
constexpr size_t WS_QA = WS_P, WS_KA = WS_P + U / 2, WS_VT = WS_P + U, WS_QKVB = WS_P + 3 * U / 2, WS_GATEB = WS_P + 3 * U, WS_POOL = WS_P + 7 * U / 2;
constexpr size_t WS_OA = WS_P + 4 * U, WS_OB = WS_P + 9 * U / 2, WS_PLD = WS_P + 5 * U;
constexpr size_t WS_SM = WS_P + 11 * U / 2;
constexpr size_t WS_BDL = WS_SM, WS_EID = WS_SM + 2 * MiB, WS_WTS = WS_SM + 5 * MiB / 2, WS_SLOT = WS_SM + 3 * MiB, WS_HIST = WS_SM + 7 * MiB / 2, WS_BLKE = WS_SM + 15 * MiB / 4;
constexpr size_t WS_GATES = WS_P, WS_Y = WS_P + 3 * U, WS_MIX = WS_P;
constexpr size_t WS_XG = WS_P, WS_HDN = WS_P + (size_t)CAP * 2048, WS_YMOE = WS_HDN + (size_t)CAP * 1024;
constexpr size_t WS_END = 8 * U;
static_assert(WS_YMOE + (size_t)CAP * 2048 <= WS_SM, "moe buffers");
static_assert(WS_W2 + 32 * MiB <= U, "weights");

__device__ __forceinline__ unsigned f2bf(float f) { unsigned u = __builtin_bit_cast(unsigned, f); return (u + 0x7fffu + ((u >> 16) & 1u)) >> 16; }
__device__ __forceinline__ unsigned pk2(float lo, float hi) { return f2bf(lo) | (f2bf(hi) << 16); }
__device__ __forceinline__ float bf2f(unsigned short b) { return __builtin_bit_cast(float, ((unsigned)b) << 16); }
__device__ __forceinline__ float bflo(unsigned w) { return __builtin_bit_cast(float, w << 16); }
__device__ __forceinline__ float bfhi(unsigned w) { return __builtin_bit_cast(float, w & 0xffff0000u); }
__device__ __forceinline__ float wave_sum(float v) {
#pragma unroll
    for (int o = 1; o < 64; o <<= 1) v += __shfl_xor(v, o);
    return v;
}
__device__ __forceinline__ float sigmoidf_(float x) { return 1.0f / (1.0f + __expf(-x)); }
__device__ __forceinline__ float siluf_(float x) { return x / (1.0f + __expf(-x)); }
__device__ __forceinline__ float softplusf_(float x) { return x > 20.f ? x : log1pf(expf(x)); }

struct Args { const float* in[25]; float* out; unsigned char* ws; int layer, ph_lo, ph_hi, pad; };

enum Phase { PH_CONVERT = 0, PH_POOL = 1, PH_LN1 = 2, PH_SLOTS = 3, PH_LN2 = 4 };

constexpr int NWAVES = 8, NTHR = 512;
constexpr int LDS_BYTES = 147456;

__device__ __forceinline__ void transpose_item(const float* W, int ldw, int col0, int K, bf16_t* WT, int row0, LAS float* scr, int kb, int nb, int lane) {
    const int k0 = 64 * kb, n0 = 32 * nb;
#pragma unroll 8
    for (int i = 0; i < 32; ++i) { const int kk = 2 * i + (lane >> 5); scr[kk * 33 + (lane & 31)] = W[(size_t)(k0 + kk) * ldw + col0 + n0 + (lane & 31)]; }
    asm volatile("s_waitcnt lgkmcnt(0)" ::: "memory");
    const int c = lane & 7;
#pragma unroll
    for (int j = 0; j < 4; ++j) { const int n = (lane >> 3) + 8 * j; const LAS float* s = scr + (8 * c) * 33 + n;
        u32x4 o; o.x = pk2(s[0 * 33], s[1 * 33]); o.y = pk2(s[2 * 33], s[3 * 33]); o.z = pk2(s[4 * 33], s[5 * 33]); o.w = pk2(s[6 * 33], s[7 * 33]);
        *(u32x4*)(WT + (size_t)(row0 + n0 + n) * K + k0 + 8 * c) = o; }
    asm volatile("s_waitcnt lgkmcnt(0)" ::: "memory");
}

__device__ __forceinline__ void phase_convert(const Args& a, LAS unsigned char* lds, int layer, int gw, int NGW, int wave, int lane, int tid, int gtid, int GT) {
    LAS float* scr = (LAS float*)(lds + wave * 16384);
    unsigned char* ws = a.ws;
    const float* w_in = a.in[1] + (size_t)layer * D * D_IN;
    constexpr int NJ = 7;
#define JC0(q) ((q) == 0 ? OFF_QA : (q) == 1 ? OFF_KA : (q) == 2 ? OFF_QKVB : (q) == 3 ? OFF_GATEB : (q) == 4 ? OFF_POOL : (q) == 5 ? OFF_VA : OFF_GATES)
#define JN(q)  ((q) == 2 ? 1536 : (q) == 6 ? 3072 : 512)
#define JR0(q) ((q) == 1 ? 512 : (q) == 2 ? 1024 : (q) == 3 ? 2560 : (q) == 4 ? 3072 : 0)
#define JD(q)  ((q) == 5 ? WS_WV : (q) == 6 ? WS_WG : WS_WIN1)
    constexpr int I_IN = 224 * 16;
    constexpr int I_BR = 2 * (1024 / 32) * (512 / 64);
    constexpr int I_OUT = (1024 / 32) * (1024 / 64);
    constexpr int I_W13 = NEXP * 2 * (512 / 32) * (1024 / 64);
    constexpr int I_W2 = NEXP * (1024 / 32) * (512 / 64);
    constexpr int NITEMS = I_IN + I_BR + I_OUT + I_W13 + I_W2;
    for (int it = gw; it < NITEMS; it += NGW) {
        int r = it;
        if (r < I_IN) {
            const int kb = r & 15; int nbg = r >> 4;
            int j = 0, nb = nbg;
#pragma unroll
            for (int q = 0; q < NJ; ++q) { if (j == q && nb >= JN(q) / 32) { nb -= JN(q) / 32; j = q + 1; } }
            int c0 = 0, r0 = 0; size_t dd = 0;
#pragma unroll
            for (int q = 0; q < NJ; ++q) if (j == q) { c0 = JC0(q); r0 = JR0(q); dd = JD(q); }
            transpose_item(w_in, D_IN, c0, 1024, (bf16_t*)(ws + dd), r0, scr, kb, nb, lane);
            continue;
        }
        r -= I_IN;
        if (r < I_BR) {
            const int which = r / 256, rr = r % 256, kb = rr & 7, nb = rr >> 3;
            const float* W = (which == 0 ? a.in[9] : a.in[10]) + (size_t)layer * 512 * 1024;
            transpose_item(W, 1024, 0, 512, (bf16_t*)(ws + WS_WBR) + (size_t)which * 1024 * 512, 0, scr, kb, nb, lane);
            continue;
        }
        r -= I_BR;
        if (r < I_OUT) {
            const int kb = r & 15, nb = r >> 4;
            transpose_item(a.in[13] + (size_t)layer * 1024 * 1024, 1024, 0, 1024, (bf16_t*)(ws + WS_WOUT), 0, scr, kb, nb, lane);
            continue;
        }
        r -= I_OUT;
        if (r < I_W13) {
            const int e = r / 512, rr = r % 512, half = rr / 256, r2 = rr % 256, kb = r2 & 15, nb = r2 >> 4;
            const float* W = (half == 0 ? a.in[20] : a.in[21]) + ((size_t)layer * NEXP + e) * 1024 * 512;
            const int f0 = 32 * nb, jt = f0 / 128, cc = f0 % 128;
            transpose_item(W, 512, f0, 1024, (bf16_t*)(ws + WS_W13), e * 1024 + jt * 256 + half * 128 + cc - 0, scr, kb, 0, lane);
            continue;
        }
        r -= I_W13;
        {
            const int e = r / 256, rr = r % 256, kb = rr & 7, nb = rr >> 3;
            const float* W = a.in[22] + ((size_t)layer * NEXP + e) * 512 * 1024;
            transpose_item(W, 1024, 0, 512, (bf16_t*)(ws + WS_W2), e * 1024, scr, kb, nb, lane);
        }
    }
    {
        const float* pw = a.in[7] + (size_t)layer * 4 * 128 * 128;
        const float* ps = a.in[8] + (size_t)layer * 512;
        const float* wc = a.in[11] + (size_t)layer * 512 * 1024;
        bf16_t* dst = (bf16_t*)(ws + WS_WBR) + (size_t)2 * 1024 * 512;
        for (int i = gtid; i < 512 * 1024; i += GT) {
            const int d = i & 1023, gc = i >> 10, g = gc >> 7;
            float s = 0.f;
            for (int c2 = 0; c2 < 128; ++c2) s += pw[(size_t)gc * 128 + c2] * ps[g * 128 + c2] * wc[(size_t)(g * 128 + c2) * 1024 + d];
            dst[(size_t)d * 512 + gc] = (bf16_t)f2bf(s);
        }
    }
}

__device__ __forceinline__ void row_store_bf16(bf16_t* dst_row, const f32x4 (&v)[4], int lane) {
    unsigned long long* o8 = (unsigned long long*)dst_row + lane;
#pragma unroll
    for (int j = 0; j < 4; ++j) o8[64 * j] = (unsigned long long)pk2(v[j].x, v[j].y) | ((unsigned long long)pk2(v[j].z, v[j].w) << 32);
}
__device__ __forceinline__ void row_bd_logits(const f32x4 (&v)[4], const LAS float* wbd, float* bdl_row, int lane) {
    float acc[8];
#pragma unroll
    for (int i = 0; i < 8; ++i) acc[i] = 0.f;
#pragma unroll
    for (int j = 0; j < 4; ++j)
#pragma unroll
        for (int c = 0; c < 4; ++c) {
            const int k = 256 * j + 4 * lane + c; const float xv = v[j][c];
            const f32x4 w0 = *(const LAS f32x4*)(wbd + k * 8), w1 = *(const LAS f32x4*)(wbd + k * 8 + 4);
            acc[0] += xv * w0.x; acc[1] += xv * w0.y; acc[2] += xv * w0.z; acc[3] += xv * w0.w;
            acc[4] += xv * w1.x; acc[5] += xv * w1.y; acc[6] += xv * w1.z; acc[7] += xv * w1.w;
        }
    float r = 0.f;
#pragma unroll
    for (int i = 0; i < 8; ++i) { const float s = wave_sum(acc[i]); r = (lane == i) ? s : r; }
    if (lane < 8) bdl_row[lane] = r;
}
__device__ __forceinline__ void stage_wbd(const float* w_in_layer, LAS float* wbd, int tid) {
    for (int k = tid; k < 1024; k += NTHR) {
        const f32x4 a0 = *(const f32x4*)(w_in_layer + (size_t)k * D_IN + OFF_BETA), a1 = *(const f32x4*)(w_in_layer + (size_t)k * D_IN + OFF_BETA + 4);
        *(LAS f32x4*)(wbd + k * 8) = a0; *(LAS f32x4*)(wbd + k * 8 + 4) = a1;
    }
    __syncthreads();
}

__device__ __forceinline__ void phase_xconv(const Args& a, LAS unsigned char* lds, int gw, int NGW, int lane, int tid) {
    LAS float* wbd = (LAS float*)(lds);
    stage_wbd(a.in[1], wbd, tid);
    const float* x = a.in[0]; bf16_t* XB = (bf16_t*)(a.ws + WS_XB); float* bdl = (float*)(a.ws + WS_BDL);
    for (int m = gw; m < T; m += NGW) {
        const f32x4* xr = (const f32x4*)(x + (size_t)m * D) + lane;
        f32x4 v[4];
#pragma unroll
        for (int j = 0; j < 4; ++j) v[j] = xr[64 * j];
        row_store_bf16(XB + (size_t)m * D, v, lane);
        row_bd_logits(v, wbd, bdl + (size_t)m * 8, lane);
    }
    __syncthreads();
}

__device__ __forceinline__ void phase_pool(const Args& a, int gw, int NGW, int lane) {
    const bf16_t* pool = (const bf16_t*)(a.ws + WS_POOL); bf16_t* pld = (bf16_t*)(a.ws + WS_PLD);
    const int g = lane >> 4, win = 2 << g;
    for (int m = gw; m < T; m += NGW) {
        const int tl = m & (SEQ - 1);
        const int n = (tl + 1 < win) ? tl + 1 : win;
        float s[8];
#pragma unroll
        for (int i = 0; i < 8; ++i) s[i] = 0.f;
        u32x4 cur = {0u, 0u, 0u, 0u};
        for (int q = 0; q < n; ++q) {
            const u32x4 w = *(const u32x4*)(pool + (size_t)(m - q) * 512 + 8 * lane);
            if (q == 0) cur = w;
            s[0] += bflo(w.x); s[1] += bfhi(w.x); s[2] += bflo(w.y); s[3] += bfhi(w.y); s[4] += bflo(w.z); s[5] += bfhi(w.z); s[6] += bflo(w.w); s[7] += bfhi(w.w);
        }
        const float inv = 1.0f / (float)n;
        u32x4 o;
        o.x = pk2(s[0] * inv - bflo(cur.x), s[1] * inv - bfhi(cur.x)); o.y = pk2(s[2] * inv - bflo(cur.y), s[3] * inv - bfhi(cur.y));
        o.z = pk2(s[4] * inv - bflo(cur.z), s[5] * inv - bfhi(cur.z)); o.w = pk2(s[6] * inv - bflo(cur.w), s[7] * inv - bfhi(cur.w));
        *(u32x4*)(pld + (size_t)m * 512 + 8 * lane) = o;
    }
}

__device__ __forceinline__ void phase_ln1(const Args& a, int layer, int gw, int NGW, int lane) {
    const float* xin = (layer == 0) ? a.in[0] : a.out;
    const float* mix = (const float*)(a.ws + WS_MIX);
    float* xo = a.out; bf16_t* XB = (bf16_t*)(a.ws + WS_XB);
    const float* lg_ = a.in[14] + (size_t)layer * D; const float* lb_ = a.in[15] + (size_t)layer * D;
    const float* wg = a.in[16] + (size_t)layer * D * 4; const float* bg = a.in[17] + (size_t)layer * 4;
    const float* we = a.in[18] + (size_t)layer * D * 32; const float* be = a.in[19] + (size_t)layer * 32;
    int* eid = (int*)(a.ws + WS_EID); float* wts = (float*)(a.ws + WS_WTS); int* hist = (int*)(a.ws + WS_HIST);
    f32x4 gv[4], bv[4];
#pragma unroll
    for (int j = 0; j < 4; ++j) { gv[j] = ((const f32x4*)lg_)[64 * j + lane]; bv[j] = ((const f32x4*)lb_)[64 * j + lane]; }
    int cnt = 0;
    for (int m = gw; m < T; m += NGW) {
        const f32x4* xr = (const f32x4*)(xin + (size_t)m * D) + lane; const f32x4* mr = (const f32x4*)(mix + (size_t)m * D) + lane;
        f32x4 v[4]; float s = 0.f;
#pragma unroll
        for (int j = 0; j < 4; ++j) { v[j] = xr[64 * j] * DN_ALPHA + mr[64 * j]; s += (v[j].x + v[j].y) + (v[j].z + v[j].w); }
        const float mean = wave_sum(s) * (1.f / D); float s2 = 0.f;
#pragma unroll
        for (int j = 0; j < 4; ++j) { v[j] = v[j] - mean; s2 += (v[j].x * v[j].x + v[j].y * v[j].y) + (v[j].z * v[j].z + v[j].w * v[j].w); }
        const float rstd = 1.f / sqrtf(wave_sum(s2) * (1.f / D) + LN_EPS);
#pragma unroll
        for (int j = 0; j < 4; ++j) v[j] = v[j] * rstd * gv[j] + bv[j];
        f32x4* orow = (f32x4*)(xo + (size_t)m * D) + lane;
#pragma unroll
        for (int j = 0; j < 4; ++j) orow[64 * j] = v[j];
        row_store_bf16(XB + (size_t)m * D, v, lane);
        float ag[4] = {0.f, 0.f, 0.f, 0.f}; float ae[32];
#pragma unroll
        for (int i = 0; i < 32; ++i) ae[i] = 0.f;
#pragma unroll
        for (int j = 0; j < 4; ++j)
#pragma unroll
            for (int c = 0; c < 4; ++c) {
                const int k = 256 * j + 4 * lane + c; const float xv = v[j][c];
                const f32x4 g4 = *(const f32x4*)(wg + (size_t)k * 4);
                ag[0] += xv * g4.x; ag[1] += xv * g4.y; ag[2] += xv * g4.z; ag[3] += xv * g4.w;
#pragma unroll
                for (int q = 0; q < 8; ++q) { const f32x4 e4 = *(const f32x4*)(we + (size_t)k * 32 + 4 * q);
                    ae[4 * q] += xv * e4.x; ae[4 * q + 1] += xv * e4.y; ae[4 * q + 2] += xv * e4.z; ae[4 * q + 3] += xv * e4.w; }
            }
#pragma unroll
        for (int i = 0; i < 4; ++i) ag[i] = wave_sum(ag[i]) + bg[i];
        float mine = 0.f;
#pragma unroll
        for (int i = 0; i < 32; ++i) { const float sr = wave_sum(ae[i]); mine = (lane == i) ? sr : mine; }
        mine += be[lane & 31];
        int gsel = 0; float gm = ag[0];
#pragma unroll
        for (int i = 1; i < 4; ++i) if (ag[i] > gm) { gm = ag[i]; gsel = i; }
        float gs = 0.f;
#pragma unroll
        for (int i = 0; i < 4; ++i) gs += expf(ag[i] - gm);
        const float p_top = 1.0f / gs;
        float le[8];
#pragma unroll
        for (int i = 0; i < 8; ++i) le[i] = __shfl(mine, gsel * 8 + i);
        int i0 = 0; float l0 = le[0];
#pragma unroll
        for (int i = 1; i < 8; ++i) if (le[i] > l0) { l0 = le[i]; i0 = i; }
        int i1 = -1; float l1 = -3.0e38f;
#pragma unroll
        for (int i = 0; i < 8; ++i) if (i != i0 && le[i] > l1) { l1 = le[i]; i1 = i; }
        const float ex = expf(l1 - l0); const float w0 = p_top / (1.0f + ex), w1 = p_top * ex / (1.0f + ex);
        const int e0 = gsel * 8 + i0, e1 = gsel * 8 + i1;
        if (lane == 0) { eid[2 * m] = e0; eid[2 * m + 1] = e1; wts[2 * m] = w0; wts[2 * m + 1] = w1; }
        cnt += (lane == e0) ? 1 : 0; cnt += (lane == e1) ? 1 : 0;
    }
    if (lane < 32) hist[gw * 32 + lane] = cnt;
}

__device__ __forceinline__ void phase_slots(const Args& a, LAS unsigned char* lds, int gw, int NGW, int wave, int lane, int tid) {
    LAS int* red = (LAS int*)lds;
    LAS int* tot = red + 1024;
    LAS int* bef = tot + 32;
    LAS int* pst = bef + 32;
    LAS int* base = pst + 64;
    const int* hist = (const int*)(a.ws + WS_HIST);
    const int nwv = NGW;
    const int wg0 = gw - wave;
    {
        const int e = tid & 31, part = tid >> 5;
        const int per = (nwv + 15) / 16; const int lo = part * per, hi = (lo + per < nwv) ? lo + per : nwv;
        int st = 0, sb = 0;
        for (int g = lo; g < hi; ++g) { const int v = hist[g * 32 + e]; st += v; sb += (g < wg0) ? v : 0; }
        red[part * 32 + e] = st; red[512 + part * 32 + e] = sb;
    }
    __syncthreads();
    if (tid < 32) { int st = 0, sb = 0; for (int p = 0; p < 16; ++p) { st += red[p * 32 + tid]; sb += red[512 + p * 32 + tid]; } tot[tid] = st; bef[tid] = sb; }
    __syncthreads();
    if (tid == 0) { int acc = 0; for (int e = 0; e < 32; ++e) { pst[e] = acc; acc += (tot[e] + MOE_BLOCK - 1) / MOE_BLOCK * MOE_BLOCK; } pst[32] = acc; }
    __syncthreads();
    if (tid < 32) { int acc = pst[tid] + bef[tid]; for (int w = 0; w < NWAVES; ++w) { base[w * 32 + tid] = acc; acc += hist[(wg0 + w) * 32 + tid]; } }
    __syncthreads();
    if (blockIdx.x == 0) {
        int* blk_e = (int*)(a.ws + WS_BLKE);
        const int nblk = pst[32] / MOE_BLOCK;
        if (tid == 0) blk_e[1023] = nblk;
        for (int b = tid; b < nblk; b += NTHR) { int e = 0; for (int q = 0; q < 32; ++q) if (pst[q] <= b * MOE_BLOCK) e = q; blk_e[b] = e; }
    }
    const int* eid = (const int*)(a.ws + WS_EID); int* slot = (int*)(a.ws + WS_SLOT);
    const bf16_t* XB = (const bf16_t*)(a.ws + WS_XB); bf16_t* xg = (bf16_t*)(a.ws + WS_XG);
    int cnt = (lane < 32) ? base[wave * 32 + lane] : 0;
    for (int m = gw; m < T; m += NGW) {
        const int e0 = eid[2 * m], e1 = eid[2 * m + 1];
        const int s0 = __shfl(cnt, e0); cnt += (lane == e0) ? 1 : 0;
        const int s1 = __shfl(cnt, e1); cnt += (lane == e1) ? 1 : 0;
        if (lane == 0) { slot[2 * m] = s0; slot[2 * m + 1] = s1; }
        const u32x4* src = (const u32x4*)(XB + (size_t)m * D) + lane;
        const u32x4 p0 = src[0], p1 = src[64];
        u32x4* d0 = (u32x4*)(xg + (size_t)s0 * D) + lane; u32x4* d1 = (u32x4*)(xg + (size_t)s1 * D) + lane;
        d0[0] = p0; d0[64] = p1; d1[0] = p0; d1[64] = p1;
    }
    __syncthreads();
}

__device__ __forceinline__ void phase_ln2(const Args& a, LAS unsigned char* lds, int layer, int gw, int NGW, int lane, int tid) {
    LAS float* wbd = (LAS float*)(lds);
    const bool has_next = (layer + 1 < DEPTH);
    if (has_next) stage_wbd(a.in[1] + (size_t)(layer + 1) * D * D_IN, wbd, tid);
    float* xo = a.out; bf16_t* XB = (bf16_t*)(a.ws + WS_XB); float* bdl = (float*)(a.ws + WS_BDL);
    const bf16_t* ymoe = (const bf16_t*)(a.ws + WS_YMOE);
    const int* slot = (const int*)(a.ws + WS_SLOT); const float* wts = (const float*)(a.ws + WS_WTS);
    const float* lg_ = a.in[23] + (size_t)layer * D; const float* lb_ = a.in[24] + (size_t)layer * D;
    f32x4 gv[4], bv[4];
#pragma unroll
    for (int j = 0; j < 4; ++j) { gv[j] = ((const f32x4*)lg_)[64 * j + lane]; bv[j] = ((const f32x4*)lb_)[64 * j + lane]; }
    for (int m = gw; m < T; m += NGW) {
        const int s0 = slot[2 * m], s1 = slot[2 * m + 1]; const float w0 = wts[2 * m], w1 = wts[2 * m + 1];
        const f32x4* xr = (const f32x4*)(xo + (size_t)m * D) + lane;
        const unsigned long long* y0 = (const unsigned long long*)(ymoe + (size_t)s0 * D) + lane; const unsigned long long* y1 = (const unsigned long long*)(ymoe + (size_t)s1 * D) + lane;
        f32x4 v[4]; float s = 0.f;
#pragma unroll
        for (int j = 0; j < 4; ++j) {
            const unsigned long long p = y0[64 * j], q = y1[64 * j];
            f32x4 f; f.x = w0 * bflo((unsigned)p) + w1 * bflo((unsigned)q); f.y = w0 * bfhi((unsigned)p) + w1 * bfhi((unsigned)q);
            f.z = w0 * bflo((unsigned)(p >> 32)) + w1 * bflo((unsigned)(q >> 32)); f.w = w0 * bfhi((unsigned)(p >> 32)) + w1 * bfhi((unsigned)(q >> 32));
            v[j] = xr[64 * j] * DN_ALPHA + f; s += (v[j].x + v[j].y) + (v[j].z + v[j].w);
        }
        const float mean = wave_sum(s) * (1.f / D); float s2 = 0.f;
#pragma unroll
        for (int j = 0; j < 4; ++j) { v[j] = v[j] - mean; s2 += (v[j].x * v[j].x + v[j].y * v[j].y) + (v[j].z * v[j].z + v[j].w * v[j].w); }
        const float rstd = 1.f / sqrtf(wave_sum(s2) * (1.f / D) + LN_EPS);
#pragma unroll
        for (int j = 0; j < 4; ++j) v[j] = v[j] * rstd * gv[j] + bv[j];
        f32x4* orow = (f32x4*)(xo + (size_t)m * D) + lane;
#pragma unroll
        for (int j = 0; j < 4; ++j) orow[64 * j] = v[j];
        if (has_next) { row_store_bf16(XB + (size_t)m * D, v, lane); row_bd_logits(v, wbd, bdl + (size_t)m * 8, lane); }
    }
    __syncthreads();
}

__global__ void __launch_bounds__(NTHR, 2) mk(Args a) {
    extern __shared__ __attribute__((aligned(16))) unsigned char lds_raw[];
    LAS unsigned char* lds = (LAS unsigned char*)lds_raw;
    const int tid = threadIdx.x, lane = tid & 63, wave = __builtin_amdgcn_readfirstlane(tid >> 6);
    const int G = gridDim.x, gw = blockIdx.x * NWAVES + wave, NGW = G * NWAVES, gtid = blockIdx.x * NTHR + tid, GT = G * NTHR;
    const int layer = a.layer;
#define IN(k) (a.ph_lo <= (k) && (k) < a.ph_hi)
    if (IN(PH_CONVERT)) { phase_convert(a, lds, layer, gw, NGW, wave, lane, tid, gtid, GT); if (layer == 0) { __syncthreads(); phase_xconv(a, lds, gw, NGW, lane, tid); } }
    if (IN(PH_POOL)) phase_pool(a, gw, NGW, lane);
    if (IN(PH_LN1)) phase_ln1(a, layer, gw, NGW, lane);
    if (IN(PH_SLOTS)) phase_slots(a, lds, gw, NGW, wave, lane, tid);
    if (IN(PH_LN2)) phase_ln2(a, lds, layer, gw, NGW, lane, tid);
#undef IN
}

template <class Epi, int MODE> __global__ void __launch_bounds__(256) k_gemm_naive(const bf16_t* A, const bf16_t* Bt, int K, int NE, Epi E, const int* blk_e) {
    const int lane = threadIdx.x & 63, wave = threadIdx.x >> 6;
    const int row0 = blockIdx.y * 64 + wave * 16, col0 = blockIdx.x * 64;
    size_t brow = col0;
    if (MODE != 0) { const int nblk = blk_e[1023]; const int b = (blockIdx.y * 64) / MOE_BLOCK; if (b >= nblk) return; const int e = blk_e[b];
        if (MODE == 1) brow = (size_t)e * NE + col0; else brow = (size_t)e * NE + (col0 / 128) * 256 + (col0 % 128); }
    f32x4 acc[4], acc2[4];
#pragma unroll
    for (int n = 0; n < 4; ++n) { acc[n] = (f32x4){0.f, 0.f, 0.f, 0.f}; acc2[n] = (f32x4){0.f, 0.f, 0.f, 0.f}; }
    const bf16_t* ap = A + (size_t)(row0 + (lane & 15)) * K + 8 * (lane >> 4);
    const bf16_t* bp = Bt + (brow + (lane & 15)) * K + 8 * (lane >> 4);
    for (int k0 = 0; k0 < K; k0 += 32) {
        const bf16x8 af = *(const bf16x8*)(ap + k0);
#pragma unroll
        for (int n = 0; n < 4; ++n) {
            const bf16x8 bf = *(const bf16x8*)(bp + (size_t)n * 16 * K + k0);
            acc[n] = __builtin_amdgcn_mfma_f32_16x16x32_bf16(bf, af, acc[n], 0, 0, 0);
            if (MODE == 2) { const bf16x8 bf2 = *(const bf16x8*)(bp + (size_t)(n * 16 + 128) * K + k0); acc2[n] = __builtin_amdgcn_mfma_f32_16x16x32_bf16(bf2, af, acc2[n], 0, 0, 0); }
        }
    }
    const int row = row0 + (lane & 15);
#pragma unroll
    for (int n = 0; n < 4; ++n) { const int col = col0 + n * 16 + 4 * (lane >> 4); if (MODE == 2) E.pair(row, col, acc[n], acc2[n]); else E(row, col, acc[n]); }
}
__device__ __forceinline__ void st_bf16x4(bf16_t* p, f32x4 v) { u32x2 w; w.x = pk2(v.x, v.y); w.y = pk2(v.z, v.w); *(u32x2*)p = w; }
struct EpiProj1 { unsigned char* ws;
    __device__ __forceinline__ void operator()(int row, int col, f32x4 v) const {
        bf16_t* p;
        if (col < 512) p = (bf16_t*)(ws + WS_QA) + (size_t)row * 512 + col;
        else if (col < 1024) p = (bf16_t*)(ws + WS_KA) + (size_t)row * 512 + (col - 512);
        else if (col < 2560) p = (bf16_t*)(ws + WS_QKVB) + (size_t)row * 1536 + (col - 1024);
        else if (col < 3072) p = (bf16_t*)(ws + WS_GATEB) + (size_t)row * 512 + (col - 2560);
        else p = (bf16_t*)(ws + WS_POOL) + (size_t)row * 512 + (col - 3072);
        st_bf16x4(p, v); }
    __device__ __forceinline__ void pair(int, int, f32x4, f32x4) const {} };
struct EpiBf16Plain { bf16_t* O; int ldc, pad;
    __device__ __forceinline__ void operator()(int row, int col, f32x4 v) const { st_bf16x4(O + (size_t)row * ldc + col, v); }
    __device__ __forceinline__ void pair(int, int, f32x4, f32x4) const {} };
struct EpiGates { bf16_t* O; const float* gb;
    __device__ __forceinline__ void operator()(int row, int col, f32x4 v) const { const f32x4 b = *(const f32x4*)(gb + col);
        f32x4 r; r.x = sigmoidf_(v.x + b.x); r.y = sigmoidf_(v.y + b.y); r.z = sigmoidf_(v.z + b.z); r.w = sigmoidf_(v.w + b.w); st_bf16x4(O + (size_t)row * 3072 + col, r); }
    __device__ __forceinline__ void pair(int, int, f32x4, f32x4) const {} };
struct EpiBranch { bf16_t* Y; const bf16_t* gates; int which, pad;
    __device__ __forceinline__ void operator()(int row, int col, f32x4 v) const {
        const u32x2 g = *(const u32x2*)(gates + (size_t)row * 3072 + which * 1024 + col);
        f32x4 r; r.x = bflo(g.x) * v.x; r.y = bfhi(g.x) * v.y; r.z = bflo(g.y) * v.z; r.w = bfhi(g.y) * v.w;
        bf16_t* yp = Y + (size_t)row * 1024 + col;
        if (which > 0) { const u32x2 o = *(const u32x2*)yp; r.x += bflo(o.x); r.y += bfhi(o.x); r.z += bflo(o.y); r.w += bfhi(o.y); }
        st_bf16x4(yp, r); }
    __device__ __forceinline__ void pair(int, int, f32x4, f32x4) const {} };
struct EpiF32Plain { float* O; int ldc, pad;
    __device__ __forceinline__ void operator()(int row, int col, f32x4 v) const { *(f32x4*)(O + (size_t)row * ldc + col) = v; }
    __device__ __forceinline__ void pair(int, int, f32x4, f32x4) const {} };
struct EpiHdn { bf16_t* H;
    __device__ __forceinline__ void operator()(int, int, f32x4) const {}
    __device__ __forceinline__ void pair(int row, int col, f32x4 x, f32x4 y) const { f32x4 r; r.x = siluf_(x.x) * y.x; r.y = siluf_(x.y) * y.y; r.z = siluf_(x.z) * y.z; r.w = siluf_(x.w) * y.w; st_bf16x4(H + (size_t)row * 512 + col, r); } };

__global__ void __launch_bounds__(64) k_attn_naive(const bf16_t* qA, const bf16_t* kA, const bf16_t* vT, const float* relb, bf16_t* oA) {
    const int h = blockIdx.x & 7, ci = (blockIdx.x >> 3) & 31, b = blockIdx.x >> 8, r = threadIdx.x;
    const size_t tok = (size_t)b * SEQ + ci * CHUNK + r;
    float q[64], o[64];
#pragma unroll
    for (int d = 0; d < 64; ++d) { q[d] = bf2f(qA[tok * 512 + h * 64 + d]); o[d] = 0.f; }
    float mx = -3.0e38f, l = 0.f;
    for (int m = 0; m < A_BAND; ++m) {
        const int kp = ci * CHUNK - 512 + m; if (kp < 0) continue;
        const size_t kt = (size_t)b * SEQ + kp;
        float s = 0.f;
#pragma unroll
        for (int d = 0; d < 64; ++d) s += q[d] * bf2f(kA[kt * 512 + h * 64 + d]);
        int dist = r + 512 - m; dist = dist < -63 ? -63 : (dist > A_CLIP ? A_CLIP : dist);
        s = s * 0.125f + relb[h * A_NREL + dist + 63];
        const float nm = fmaxf(mx, s), sc = expf(mx - nm), p = expf(s - nm);
        l = l * sc + p; mx = nm;
#pragma unroll
        for (int d = 0; d < 64; ++d) o[d] = o[d] * sc + p * bf2f(vT[(size_t)(h * 64 + d) * T + kt]);
    }
    const float inv = 1.0f / l;
#pragma unroll
    for (int d = 0; d < 64; ++d) oA[tok * 512 + h * 64 + d] = (bf16_t)f2bf(o[d] * inv);
}

__global__ void __launch_bounds__(128) k_gdn_naive(const bf16_t* qkvB, const float* bdl, const bf16_t* gateB, const float* convw, const float* a_log, const float* dt_bias, const float* norm_g, bf16_t* oB) {
    __shared__ float sk[128], sq[128], red[8];
    const int b = blockIdx.x >> 2, h = blockIdx.x & 3, j = threadIdx.x, wv = j >> 6, lane = j & 63;
    float S[128];
#pragma unroll
    for (int k = 0; k < 128; ++k) S[k] = 0.f;
    const int cq = h * 128 + j, ck = 512 + cq, cv = 1024 + cq;
    float wq[4], wk[4], wvv[4];
#pragma unroll
    for (int i = 0; i < 4; ++i) { wq[i] = convw[i * 1536 + cq]; wk[i] = convw[i * 1536 + ck]; wvv[i] = convw[i * 1536 + cv]; }
    float hq[3] = {0.f, 0.f, 0.f}, hk[3] = {0.f, 0.f, 0.f}, hv[3] = {0.f, 0.f, 0.f};
    const float Aexp = expf(a_log[h]), dtb = dt_bias[h], ng = norm_g[j];
    for (int t = 0; t < SEQ; ++t) {
        const size_t row = (size_t)b * SEQ + t;
        const float rq = bf2f(qkvB[row * 1536 + cq]), rk = bf2f(qkvB[row * 1536 + ck]), rv = bf2f(qkvB[row * 1536 + cv]);
        float q = wq[0] * hq[0] + wq[1] * hq[1] + wq[2] * hq[2] + wq[3] * rq;
        float k = wk[0] * hk[0] + wk[1] * hk[1] + wk[2] * hk[2] + wk[3] * rk;
        float v = wvv[0] * hv[0] + wvv[1] * hv[1] + wvv[2] * hv[2] + wvv[3] * rv;
        hq[0] = hq[1]; hq[1] = hq[2]; hq[2] = rq; hk[0] = hk[1]; hk[1] = hk[2]; hk[2] = rk; hv[0] = hv[1]; hv[1] = hv[2]; hv[2] = rv;
        q = siluf_(q); k = siluf_(k); v = siluf_(v);
        const float sq2 = wave_sum(q * q), sk2 = wave_sum(k * k);
        if (lane == 0) { red[wv] = sq2; red[2 + wv] = sk2; }
        __syncthreads();
        const float nq = red[0] + red[1], nk = red[2] + red[3];
        q = q * rsqrtf(nq + RMS_EPS) * 0.08838834764831845f; k = k * rsqrtf(nk + RMS_EPS);
        sk[j] = k; sq[j] = q;
        const float beta = sigmoidf_(bdl[row * 8 + h]);
        const float g = -Aexp * softplusf_(bdl[row * 8 + 4 + h] + dtb), aa = expf(g);
        __syncthreads();
        float dot = 0.f;
#pragma unroll
        for (int kk = 0; kk < 128; ++kk) dot += sk[kk] * S[kk];
        const float coef = beta * (v - aa * dot);
        float o = 0.f;
#pragma unroll
        for (int kk = 0; kk < 128; ++kk) { S[kk] = aa * S[kk] + sk[kk] * coef; o += sq[kk] * S[kk]; }
        const float so = wave_sum(o * o);
        if (lane == 0) red[4 + wv] = so;
        __syncthreads();
        const float ms = (red[4] + red[5]) * (1.0f / 128.0f);
        const float gt = bf2f(gateB[row * 512 + h * 128 + j]);
        oB[row * 512 + h * 128 + j] = (bf16_t)f2bf(o * rsqrtf(ms + RMS_EPS) * ng * siluf_(gt));
    }
}

extern "C" void kernel_launch(void* const* d_in, const int* in_sizes, int n_in, void* d_out, int out_size, void* d_ws, size_t ws_size, hipStream_t stream) {
    static int grid = 0;
    if (grid == 0) {
        if (n_in != 25 || in_sizes[0] != T * D || out_size != T * D || ws_size < WS_END) { fprintf(stderr, "kernel_launch: unexpected shapes (n_in %d, in0 %d, out %d, ws %zu < %zu)\n", n_in, n_in > 0 ? in_sizes[0] : -1, out_size, ws_size, (size_t)WS_END); grid = -1; return; }
        int dev = 0, cus = 0;
        if (hipGetDevice(&dev) != hipSuccess || hipDeviceGetAttribute(&cus, hipDeviceAttributeMultiprocessorCount, dev) != hipSuccess) { grid = -1; return; }
        if (hipFuncSetAttribute((const void*)mk, hipFuncAttributeMaxDynamicSharedMemorySize, LDS_BYTES) != hipSuccess) { fprintf(stderr, "kernel_launch: hipFuncSetAttribute failed\n"); grid = -1; return; }
        grid = cus;
    }
    if (grid < 0) return;
    unsigned char* ws = (unsigned char*)d_ws;
    (void)hipMemsetAsync(ws + WS_CTL, 0, 1 * MiB, stream);
    Args a{};
    for (int i = 0; i < 25; ++i) a.in[i] = (const float*)d_in[i];
    a.out = (float*)d_out; a.ws = ws;
    auto run = [&](int layer, int ph) { a.layer = layer; a.ph_lo = ph; a.ph_hi = ph + 1; hipLaunchKernelGGL(mk, dim3(grid), dim3(NTHR), LDS_BYTES, stream, a); };
    const bf16_t* XB = (const bf16_t*)(ws + WS_XB);
    int* blk_e = (int*)(ws + WS_BLKE);
    for (int layer = 0; layer < DEPTH; ++layer) {
        run(layer, PH_CONVERT);
        hipLaunchKernelGGL((k_gemm_naive<EpiProj1, 0>), dim3(N1 / 64, T / 64), dim3(256), 0, stream, XB, (const bf16_t*)(ws + WS_WIN1), 1024, 0, EpiProj1{ws}, (const int*)nullptr);
        hipLaunchKernelGGL((k_gemm_naive<EpiBf16Plain, 0>), dim3(T / 64, 512 / 64), dim3(256), 0, stream, (const bf16_t*)(ws + WS_WV), XB, 1024, 0, EpiBf16Plain{(bf16_t*)(ws + WS_VT), T, 0}, (const int*)nullptr);
        hipLaunchKernelGGL(k_attn_naive, dim3(BATCH * NCH * A_HEADS), dim3(64), 0, stream, (const bf16_t*)(ws + WS_QA), (const bf16_t*)(ws + WS_KA), (const bf16_t*)(ws + WS_VT), (const float*)d_in[2] + (size_t)layer * A_HEADS * A_NREL, (bf16_t*)(ws + WS_OA));
        hipLaunchKernelGGL(k_gdn_naive, dim3(BATCH * B_HEADS), dim3(128), 0, stream, (const bf16_t*)(ws + WS_QKVB), (const float*)(ws + WS_BDL), (const bf16_t*)(ws + WS_GATEB), (const float*)d_in[3] + (size_t)layer * 4 * 1536,
                           (const float*)d_in[4] + layer * 4, (const float*)d_in[5] + layer * 4, (const float*)d_in[6] + layer * 128, (bf16_t*)(ws + WS_OB));
        run(layer, PH_POOL);
        hipLaunchKernelGGL((k_gemm_naive<EpiGates, 0>), dim3(3072 / 64, T / 64), dim3(256), 0, stream, XB, (const bf16_t*)(ws + WS_WG), 1024, 0, EpiGates{(bf16_t*)(ws + WS_GATES), (const float*)d_in[12] + (size_t)layer * 3072}, (const int*)nullptr);
        for (int i = 0; i < 3; ++i) {
            const bf16_t* Ai = (const bf16_t*)(ws + (i == 0 ? WS_OA : (i == 1 ? WS_OB : WS_PLD)));
            hipLaunchKernelGGL((k_gemm_naive<EpiBranch, 0>), dim3(1024 / 64, T / 64), dim3(256), 0, stream, Ai, (const bf16_t*)(ws + WS_WBR) + (size_t)i * 1024 * 512, 512, 0, EpiBranch{(bf16_t*)(ws + WS_Y), (const bf16_t*)(ws + WS_GATES), i, 0}, (const int*)nullptr);
        }
        hipLaunchKernelGGL((k_gemm_naive<EpiF32Plain, 0>), dim3(1024 / 64, T / 64), dim3(256), 0, stream, (const bf16_t*)(ws + WS_Y), (const bf16_t*)(ws + WS_WOUT), 1024, 0, EpiF32Plain{(float*)(ws + WS_MIX), 1024, 0}, (const int*)nullptr);
        run(layer, PH_LN1);
        run(layer, PH_SLOTS);
        hipLaunchKernelGGL((k_gemm_naive<EpiHdn, 2>), dim3(512 / 64, CAP / 64), dim3(256), 0, stream, (const bf16_t*)(ws + WS_XG), (const bf16_t*)(ws + WS_W13), 1024, 1024, EpiHdn{(bf16_t*)(ws + WS_HDN)}, (const int*)blk_e);
        hipLaunchKernelGGL((k_gemm_naive<EpiBf16Plain, 1>), dim3(1024 / 64, CAP / 64), dim3(256), 0, stream, (const bf16_t*)(ws + WS_HDN), (const bf16_t*)(ws + WS_W2), 512, 1024, EpiBf16Plain{(bf16_t*)(ws + WS_YMOE), 1024, 0}, (const int*)blk_e);
        run(layer, PH_LN2);
    }
}
```

```cpp
#include <hip/hip_runtime.h>
#include <cstdio>
#include <cstdint>
#ifndef GDN_EXP
#define GDN_EXP 0
#endif
#ifndef GDN_TEST
#define GDN_TEST 0
#endif
#ifndef DIAG_N
#define DIAG_N 1
#endif
#ifndef DIAG_THR
#define DIAG_THR 0.05f
#endif
#ifndef ATT_QUEUE
#define ATT_QUEUE 0
#endif
#ifndef FAST_MASK
#define FAST_MASK 255
#endif

#define GAS __attribute__((address_space(1)))
#define LAS __attribute__((address_space(3)))
typedef unsigned short bf16_t;
typedef short bf16x8 __attribute__((ext_vector_type(8)));
typedef float f32x4 __attribute__((ext_vector_type(4)));
typedef float f32x2 __attribute__((ext_vector_type(2)));
typedef unsigned u32x4 __attribute__((ext_vector_type(4)));
typedef unsigned u32x2 __attribute__((ext_vector_type(2)));

namespace pg8 {
#define PG8_LAS __attribute__((address_space(3)))
typedef unsigned short bf16_t;
typedef short bf16x8 __attribute__((ext_vector_type(8)));
typedef float f32x4 __attribute__((ext_vector_type(4)));
typedef unsigned u32x4 __attribute__((ext_vector_type(4)));
constexpr int BM = 256, BK = 64, HALF = 128, HTB = HALF * BK * 2  , STAGE_BYTES = 8 * HTB, NXCD = 8, WGM = 8;

__host__ __device__ __forceinline__ int lds_byte(int r, int c) { const int st = (r >> 4) * 2 + (c >> 5), rr = r & 15, cc = c & 31, ob = rr * 64 + cc * 2; return st * 1024 + (ob ^ (((ob >> 9) & 1) << 5)); }
__host__ __device__ __forceinline__ void stage_rc(int b, int& R, int& C) { const int st = b / 1024, sb = b % 1024, swz = sb ^ (((sb >> 9) & 1) << 5); R = (st >> 1) * 16 + swz / 64; C = (st & 1) * 32 + (swz % 64) / 2; }
__host__ __device__ __forceinline__ int perm32(int rho) { const int n = rho >> 4, i = rho & 15; return 8 * (i >> 2) + 4 * n + (i & 3); }

struct Unit { int pm, pn; };
struct Gemm { const bf16_t* A; const bf16_t* Bt; int M, N, K; };

struct StaticOrder {
    int nM, nN, nwg, G, c;
    __host__ __device__ void init(int M, int N, int G_, int c_) { nM = M / BM; nN = N / BM; nwg = nM * nN; G = G_; c = c_; }
    __host__ __device__ bool next(int i, Unit& u) const {
        const long L = (long)i * G + c; if (L >= nwg) return false;
        int wgid = (int)L; { const int q = nwg / NXCD, r = nwg % NXCD, xcd = wgid % NXCD, off = wgid / NXCD; wgid = (xcd < r ? xcd * (q + 1) : r * (q + 1) + (xcd - r) * q) + off; }
        const int nig = WGM * nN, gid = wgid / nig, fm = gid * WGM, gsz = (nM - fm) < WGM ? (nM - fm) : WGM;
        u.pm = fm + ((wgid % nig) % gsz); u.pn = (wgid % nig) / gsz; return true;
    }
    __device__ __forceinline__ void a_ready(const Unit&) const {}
    __device__ __forceinline__ void done(const Unit&) const {}
};
typedef float f32x2_ __attribute__((ext_vector_type(2)));
typedef __bf16 bf16x2_ __attribute__((ext_vector_type(2)));
__device__ __forceinline__ unsigned cvt_pk_bf16(float lo, float hi) { const f32x2_ v = {lo, hi}; return __builtin_bit_cast(unsigned, __builtin_convertvector(v, bf16x2_)); }
template <class Epi, class Sched, bool ALIGN_EPI = false, bool SP2 = false>
__device__ __forceinline__ void gemm_phase(PG8_LAS unsigned char* lds, const Gemm g, const Sched& S, const Epi& E) {
    const int tid = threadIdx.x, wid = __builtin_amdgcn_readfirstlane(tid >> 6), lane = tid & 63, wr = wid >> 2, wc = wid & 3, fr = lane & 15, fq = lane >> 4;
    const int K = g.K, nt = K / BK;
    unsigned voffA[2], voffB[2];
#pragma unroll
    for (int i = 0; i < 2; ++i) { int R, C; stage_rc(tid * 16 + i * 8192, R, C); const int Rb = Epi::PERM ? ((R & ~31) + perm32(R & 31)) : R;
        voffA[i] = (unsigned)(R * K + C) * 2u; voffB[i] = (unsigned)(Rb * K + C) * 2u; }
    const size_t kstep = (size_t)(BK * 2);
    const size_t hstep = (size_t)HALF * K * 2;
    const size_t tstep = 2 * hstep;
    const unsigned ldsw = (unsigned)wid * 1024u;
    const int aoff = lds_byte(wr * 64 + fr, fq * 8), boff = lds_byte(wc * 32 + fr, fq * 8);
#define PG8_SA(b, h) (((b) * 2 + (h)) * HTB)
#define PG8_SB(b, h) ((4 + (b) * 2 + (h)) * HTB)
#define PG8_STAGE(bufoff, gbase, voff) do { _Pragma("unroll") for (int _i = 0; _i < 2; ++_i) \
        __builtin_amdgcn_global_load_lds((const unsigned*)((const char*)(gbase) + (voff)[_i]), (PG8_LAS unsigned*)(lds + (bufoff) + ldsw + _i * 8192), 16, 0, 0); } while (0)
#define PG8_LDA(dst, b, h) do { _Pragma("unroll") for (int m = 0; m < 4; ++m) _Pragma("unroll") for (int k = 0; k < 2; ++k) dst[m][k] = *(const PG8_LAS bf16x8*)(lds + PG8_SA(b, h) + aoff + m * 2048 + k * 1024); } while (0)
#define PG8_LDB(dst, b, h) do { _Pragma("unroll") for (int n = 0; n < 2; ++n) _Pragma("unroll") for (int k = 0; k < 2; ++k) dst[n][k] = *(const PG8_LAS bf16x8*)(lds + PG8_SB(b, h) + boff + n * 2048 + k * 1024); } while (0)
#define PG8_MMA(ai, bj, At, Bt) do { __builtin_amdgcn_s_setprio(1); _Pragma("unroll") for (int m = 0; m < 4; ++m) _Pragma("unroll") for (int n = 0; n < 2; ++n) _Pragma("unroll") for (int k = 0; k < 2; ++k) \
        acc[ai][bj][m][n] = __builtin_amdgcn_mfma_f32_16x16x32_bf16(Bt[n][k], At[m][k], acc[ai][bj][m][n], 0, 0, 0); __builtin_amdgcn_s_setprio(0); } while (0)
#define PG8_WAIT_V(n) asm volatile("s_waitcnt vmcnt(" #n ")" ::: "memory")
#define PG8_WAIT_L(n) asm volatile("s_waitcnt lgkmcnt(" #n ")" ::: "memory")
#define PG8_BAR __builtin_amdgcn_s_barrier()
#define PG8_SCHED __builtin_amdgcn_sched_barrier(0)
    Unit cur, nxt; int ui = 0;
    if (!S.next(0, cur)) return;
    f32x4 acc[2][2][4][2];
#pragma unroll
    for (int a = 0; a < 2; ++a)
#pragma unroll
        for (int b = 0; b < 2; ++b)
#pragma unroll
            for (int m = 0; m < 4; ++m)
#pragma unroll
                for (int n = 0; n < 2; ++n) acc[a][b][m][n] = (f32x4){0.f, 0.f, 0.f, 0.f};
    bf16x8 At[4][2], B0[2][2], B1[2][2];
    const char* cA = (const char*)g.A + (size_t)cur.pm * tstep; const char* cB = (const char*)g.Bt + (size_t)cur.pn * tstep;
    S.a_ready(cur);
    if constexpr (SP2) {
        PG8_STAGE(PG8_SB(0, 0), cB, voffB); PG8_STAGE(PG8_SB(0, 1), cB + hstep, voffB); PG8_STAGE(PG8_SA(0, 0), cA, voffA); PG8_STAGE(PG8_SA(0, 1), cA + hstep, voffA);
        if (wr == 1) PG8_BAR;
        PG8_WAIT_V(2); PG8_BAR;
        PG8_STAGE(PG8_SB(1, 0), cB + kstep, voffB); PG8_STAGE(PG8_SA(1, 0), cA + kstep, voffA); PG8_STAGE(PG8_SB(1, 1), cB + hstep + kstep, voffB);
        PG8_WAIT_V(6); PG8_BAR;
    } else {
        PG8_STAGE(PG8_SB(0, 0), cB, voffB); PG8_STAGE(PG8_SA(0, 0), cA, voffA); PG8_STAGE(PG8_SB(0, 1), cB + hstep, voffB); PG8_STAGE(PG8_SA(0, 1), cA + hstep, voffA);
        if (wr == 1) PG8_BAR;
        PG8_WAIT_V(4); PG8_BAR;
        PG8_STAGE(PG8_SB(1, 0), cB + kstep, voffB); PG8_STAGE(PG8_SA(1, 0), cA + kstep, voffA); PG8_STAGE(PG8_SB(1, 1), cB + hstep + kstep, voffB);
        PG8_WAIT_V(6); PG8_BAR;
    }
    for (;;) {
        const bool has_next = S.next(ui + 1, nxt);
        const char* nA = has_next ? (const char*)g.A + (size_t)nxt.pm * tstep : cA; const char* nB = has_next ? (const char*)g.Bt + (size_t)nxt.pn * tstep : cB;
        for (int t = 0; t < nt; t += 2) {
            const bool last = (t == nt - 2);
            const char* a1 = cA + (size_t)(t + 1) * kstep;
            const char* a2 = last ? nA : cA + (size_t)(t + 2) * kstep; const char* b2 = last ? nB : cB + (size_t)(t + 2) * kstep;
            const char* a3 = a2 + kstep; const char* b3 = b2 + kstep;
            if (last && has_next) S.a_ready(nxt);
            if constexpr (SP2) {
            PG8_LDB(B0, 0, 0); PG8_LDB(B1, 0, 1); PG8_SCHED; PG8_LDA(At, 0, 0); PG8_STAGE(PG8_SA(1, 1), a1 + hstep, voffA);
            PG8_WAIT_V(8); PG8_WAIT_L(0); PG8_BAR; PG8_MMA(0, 0, At, B0); PG8_MMA(0, 1, At, B1); PG8_BAR; PG8_SCHED;
            PG8_LDA(At, 0, 1); PG8_STAGE(PG8_SB(0, 0), b2, voffB); PG8_STAGE(PG8_SB(0, 1), b2 + hstep, voffB); PG8_STAGE(PG8_SA(0, 0), a2, voffA);
            PG8_WAIT_V(8); PG8_WAIT_L(0); PG8_BAR; PG8_MMA(1, 0, At, B0); PG8_MMA(1, 1, At, B1); PG8_BAR; PG8_SCHED;
            PG8_LDB(B0, 1, 0); PG8_LDB(B1, 1, 1); PG8_SCHED; PG8_LDA(At, 1, 0); PG8_STAGE(PG8_SA(0, 1), a2 + hstep, voffA);
            PG8_WAIT_V(8); PG8_WAIT_L(0); PG8_BAR; PG8_MMA(0, 0, At, B0); PG8_MMA(0, 1, At, B1); PG8_BAR; PG8_SCHED;
            PG8_LDA(At, 1, 1); PG8_STAGE(PG8_SB(1, 0), b3, voffB); PG8_STAGE(PG8_SB(1, 1), b3 + hstep, voffB); PG8_STAGE(PG8_SA(1, 0), a3, voffA);
            PG8_WAIT_V(8); PG8_WAIT_L(0); PG8_BAR; PG8_MMA(1, 0, At, B0); PG8_MMA(1, 1, At, B1); PG8_BAR; PG8_SCHED;
            } else {
            PG8_LDB(B0, 0, 0); PG8_SCHED; PG8_LDA(At, 0, 0); PG8_STAGE(PG8_SA(1, 1), a1 + hstep, voffA);
            PG8_WAIT_L(8); PG8_BAR; PG8_WAIT_L(0); PG8_MMA(0, 0, At, B0); PG8_BAR; PG8_SCHED;
            PG8_LDB(B1, 0, 1); PG8_STAGE(PG8_SB(0, 0), b2, voffB);
            PG8_BAR; PG8_WAIT_L(0); PG8_MMA(0, 1, At, B1); PG8_BAR;
            PG8_LDA(At, 0, 1); PG8_STAGE(PG8_SA(0, 0), a2, voffA);
            PG8_BAR; PG8_WAIT_L(0); PG8_MMA(1, 0, At, B0); PG8_BAR; PG8_SCHED;
            PG8_STAGE(PG8_SB(0, 1), b2 + hstep, voffB);
            PG8_WAIT_V(6); PG8_BAR; PG8_MMA(1, 1, At, B1); PG8_BAR;
            PG8_LDB(B0, 1, 0); PG8_SCHED; PG8_LDA(At, 1, 0); PG8_STAGE(PG8_SA(0, 1), a2 + hstep, voffA);
            PG8_WAIT_L(8); PG8_BAR; PG8_WAIT_L(0); PG8_MMA(0, 0, At, B0); PG8_BAR; PG8_SCHED;
            PG8_LDB(B1, 1, 1); PG8_STAGE(PG8_SB(1, 0), b3, voffB);
            PG8_BAR; PG8_WAIT_L(0); PG8_MMA(0, 1, At, B1); PG8_BAR;
            PG8_LDA(At, 1, 1); PG8_STAGE(PG8_SA(1, 0), a3, voffA);
            PG8_BAR; PG8_WAIT_L(0); PG8_MMA(1, 0, At, B0); PG8_BAR; PG8_SCHED;
            PG8_STAGE(PG8_SB(1, 1), b3 + hstep, voffB);
            PG8_WAIT_V(6); PG8_BAR; PG8_MMA(1, 1, At, B1); PG8_BAR;
            }
        }
        if constexpr (ALIGN_EPI) { if (wr == 0) PG8_BAR; }
        if constexpr (!Epi::AFTER_DRAIN) { E(acc, cur, wr, wc, fr, fq); S.done(cur); }
        if (!has_next) break;
#pragma unroll
        for (int a = 0; a < 2; ++a)
#pragma unroll
            for (int b = 0; b < 2; ++b)
#pragma unroll
                for (int m = 0; m < 4; ++m)
#pragma unroll
                    for (int n = 0; n < 2; ++n) acc[a][b][m][n] = (f32x4){0.f, 0.f, 0.f, 0.f};
        cur = nxt; cA = nA; cB = nB; ++ui;
        if constexpr (ALIGN_EPI) { if (wr == 1) PG8_BAR; }
    }
    PG8_WAIT_V(0);
    if constexpr (!ALIGN_EPI) { if (wr == 0) PG8_BAR; }
    PG8_BAR;
    if constexpr (Epi::AFTER_DRAIN) { E.fused(acc, cur, wr, wc, fr, fq, lds, wid, lane); S.done(cur); }
#undef PG8_SA
#undef PG8_SB
#undef PG8_STAGE
#undef PG8_LDA
#undef PG8_LDB
#undef PG8_MMA
#undef PG8_WAIT_V
#undef PG8_WAIT_L
#undef PG8_BAR
#undef PG8_SCHED
}
}

constexpr int BATCH = 32, SEQ = 2048, D = 1024, T = BATCH * SEQ, DEPTH = 2, CHUNK = 64, NCH = SEQ / CHUNK;
constexpr int A_HEADS = 8, A_HD = 64, A_W = 512, A_LEFT = 8, A_BAND = 576, A_CLIP = 256, A_NREL = 320;
constexpr int B_HEADS = 4, B_HD = 128, B_W = 512;
constexpr int C_W = 512;
constexpr int D_IN = 7176;
constexpr int OFF_QA = 0, OFF_KA = 512, OFF_VA = 1024, OFF_QKVB = 1536, OFF_BETA = 3072, OFF_DEC = 3076, OFF_GATEB = 3080, OFF_POOL = 3592, OFF_GATES = 4104;
constexpr int NEXP = 32, MOE_FF = 512, MOE_BLOCK = 256;
constexpr int NPAIR = 2 * T, NBLK_MAX = NPAIR / MOE_BLOCK + NEXP, CAP = NBLK_MAX * MOE_BLOCK;
constexpr float DN_ALPHA = 1.4142135623730951f;
constexpr float LN_EPS = 1e-5f, RMS_EPS = 1e-6f;
constexpr int N1 = 3584;

constexpr size_t MiB = 1ull << 20, U = 128 * MiB;
constexpr size_t WS_CTL = 0;
constexpr size_t WS_WIN1 = 1 * MiB, WS_WV = 8 * MiB, WS_WG = 9 * MiB, WS_WBR = 15 * MiB, WS_WOUT = 18 * MiB, WS_W13 = 20 * MiB, WS_W2 = 84 * MiB;
constexpr size_t WS_XB = U;
constexpr size_t WS_P = 2 * U;
constexpr size_t WS_QA = WS_P, WS_KA = WS_P + U / 2, WS_VT = WS_P + U, WS_QKVB = WS_P + 3 * U / 2, WS_GATEB = WS_P + 3 * U, WS_POOL = WS_P + 7 * U / 2;
constexpr size_t WS_OA = WS_P + 4 * U, WS_OB = WS_P + 9 * U / 2, WS_PLD = WS_P + 5 * U;
constexpr size_t WS_SM = 116 * MiB;
constexpr size_t WS_BDL = WS_SM, WS_EID = WS_SM + 2 * MiB, WS_WTS = WS_SM + 5 * MiB / 2, WS_SLOT = WS_SM + 3 * MiB, WS_HIST = WS_SM + 7 * MiB / 2, WS_BLKE = WS_SM + 15 * MiB / 4, WS_GC = WS_SM + 4 * MiB;
constexpr size_t WS_TMU = WS_P + 11 * U / 2, WS_TMW = WS_TMU + 32 * MiB;
constexpr size_t WS_GATES = WS_P, WS_Y = WS_P + 3 * U, WS_MIX = WS_P;
constexpr size_t WS_XG = WS_P, WS_HDN = WS_P + (size_t)CAP * 2048, WS_YMOE = WS_HDN + (size_t)CAP * 1024;
constexpr size_t WS_END = 8 * U;
static_assert(WS_YMOE + (size_t)CAP * 2048 <= WS_TMU, "moe buffers");
static_assert(WS_GC + 1 * MiB <= U, "small tables");
static_assert(WS_W2 + 32 * MiB <= U, "weights");

__device__ __forceinline__ unsigned f2bf(float f) { unsigned u = __builtin_bit_cast(unsigned, f); return (u + 0x7fffu + ((u >> 16) & 1u)) >> 16; }
__device__ __forceinline__ unsigned pk2(float lo, float hi) { return f2bf(lo) | (f2bf(hi) << 16); }
__device__ __forceinline__ float bf2f(unsigned short b) { return __builtin_bit_cast(float, ((unsigned)b) << 16); }
__device__ __forceinline__ float bflo(unsigned w) { return __builtin_bit_cast(float, w << 16); }
__device__ __forceinline__ float bfhi(unsigned w) { return __builtin_bit_cast(float, w & 0xffff0000u); }
__device__ __forceinline__ float wave_sum(float v) {
#pragma unroll
    for (int o = 1; o < 64; o <<= 1) v += __shfl_xor(v, o);
    return v;
}
__device__ __forceinline__ float sigmoidf_(float x) { return 1.0f / (1.0f + __expf(-x)); }
__device__ __forceinline__ float siluf_(float x) { return x / (1.0f + __expf(-x)); }
__device__ __forceinline__ float softplusf_(float x) { return x > 20.f ? x : log1pf(expf(x)); }

struct Args { const float* in[25]; float* out; unsigned char* ws; int layer, ph_lo, ph_hi, pad; };

enum Phase { PH_CONVERT = 0, PH_PROJ1 = 1, PH_PRE = 2, PH_MIX = 3, PH_GATES = 4, PH_BRANCH = 5, PH_OUT = 6, PH_LN1 = 7, PH_SLOTS = 8, PH_MOE1 = 9, PH_MOE2 = 10, PH_LN2 = 11, PH_COUNT = 12 };

constexpr int NWAVES = 8, NTHR = 512;
constexpr int LDS_BYTES = 163840;

__device__ __forceinline__ void transpose_item(const float* W, int ldw, int col0, int K, bf16_t* WT, int row0, LAS float* scr, int kb, int nb, int lane) {
    const int k0 = 64 * kb, n0 = 32 * nb;
#pragma unroll 8
    for (int i = 0; i < 32; ++i) { const int kk = 2 * i + (lane >> 5); scr[kk * 33 + (lane & 31)] = W[(size_t)(k0 + kk) * ldw + col0 + n0 + (lane & 31)]; }
    asm volatile("s_waitcnt lgkmcnt(0)" ::: "memory");
    const int c = lane & 7;
#pragma unroll
    for (int j = 0; j < 4; ++j) { const int n = (lane >> 3) + 8 * j; const LAS float* s = scr + (8 * c) * 33 + n;
        u32x4 o; o.x = pk2(s[0 * 33], s[1 * 33]); o.y = pk2(s[2 * 33], s[3 * 33]); o.z = pk2(s[4 * 33], s[5 * 33]); o.w = pk2(s[6 * 33], s[7 * 33]);
        *(u32x4*)(WT + (size_t)(row0 + n0 + n) * K + k0 + 8 * c) = o; }
    asm volatile("s_waitcnt lgkmcnt(0)" ::: "memory");
}

__device__ __forceinline__ void phase_convert(const Args& a, LAS unsigned char* lds, int layer, int gw, int NGW, int wave, int lane, int tid, int gtid, int GT) {
    LAS float* scr = (LAS float*)(lds + wave * 16384);
    unsigned char* ws = a.ws;
    const float* w_in = a.in[1] + (size_t)layer * D * D_IN;
    constexpr int NJ = 7;
#define JC0(q) ((q) == 0 ? OFF_QA : (q) == 1 ? OFF_KA : (q) == 2 ? OFF_QKVB : (q) == 3 ? OFF_GATEB : (q) == 4 ? OFF_POOL : (q) == 5 ? OFF_VA : OFF_GATES)
#define JN(q)  ((q) == 2 ? 1536 : (q) == 6 ? 3072 : 512)
#define JR0(q) ((q) == 1 ? 512 : (q) == 2 ? 1024 : (q) == 3 ? 2560 : (q) == 4 ? 3072 : 0)
#define JD(q)  ((q) == 5 ? WS_WV : (q) == 6 ? WS_WG : WS_WIN1)
    constexpr int I_IN = 224 * 16;
    constexpr int I_BR = 2 * (1024 / 32) * (512 / 64);
    constexpr int I_OUT = (1024 / 32) * (1024 / 64);
    constexpr int I_W13 = NEXP * 2 * (512 / 32) * (1024 / 64);
    constexpr int I_W2 = NEXP * (1024 / 32) * (512 / 64);
    constexpr int NITEMS = I_IN + I_BR + I_OUT + I_W13 + I_W2;
    for (int it = gw; it < NITEMS; it += NGW) {
        int r = it;
        if (r < I_IN) {
            const int kb = r & 15; int nbg = r >> 4;
            int j = 0, nb = nbg;
#pragma unroll
            for (int q = 0; q < NJ; ++q) { if (j == q && nb >= JN(q) / 32) { nb -= JN(q) / 32; j = q + 1; } }
            int c0 = 0, r0 = 0; size_t dd = 0;
#pragma unroll
            for (int q = 0; q < NJ; ++q) if (j == q) { c0 = JC0(q); r0 = JR0(q); dd = JD(q); }
            transpose_item(w_in, D_IN, c0, 1024, (bf16_t*)(ws + dd), r0, scr, kb, nb, lane);
            continue;
        }
        r -= I_IN;
        if (r < I_BR) {
            const int which = r / 256, rr = r % 256, kb = rr & 7, nb = rr >> 3;
            const float* W = (which == 0 ? a.in[9] : a.in[10]) + (size_t)layer * 512 * 1024;
            transpose_item(W, 1024, 0, 512, (bf16_t*)(ws + WS_WBR) + (size_t)which * 1024 * 512, 0, scr, kb, nb, lane);
            continue;
        }
        r -= I_BR;
        if (r < I_OUT) {
            const int kb = r & 15, nb = r >> 4;
            transpose_item(a.in[13] + (size_t)layer * 1024 * 1024, 1024, 0, 1024, (bf16_t*)(ws + WS_WOUT), 0, scr, kb, nb, lane);
            continue;
        }
        r -= I_OUT;
        if (r < I_W13) {
            const int e = r / 512, rr = r % 512, half = rr / 256, r2 = rr % 256, kb = r2 & 15, nb = r2 >> 4;
            const float* W = (half == 0 ? a.in[20] : a.in[21]) + ((size_t)layer * NEXP + e) * 1024 * 512;
            const int f0 = 32 * nb, jt = f0 / 128, cc = f0 % 128;
            transpose_item(W, 512, f0, 1024, (bf16_t*)(ws + WS_W13), e * 1024 + jt * 256 + half * 128 + cc - 0, scr, kb, 0, lane);
            continue;
        }
        r -= I_W13;
        {
            const int e = r / 256, rr = r % 256, kb = rr & 7, nb = rr >> 3;
            const float* W = a.in[22] + ((size_t)layer * NEXP + e) * 512 * 1024;
            transpose_item(W, 1024, 0, 512, (bf16_t*)(ws + WS_W2), e * 1024, scr, kb, nb, lane);
        }
    }
    {
        const float* pw = a.in[7] + (size_t)layer * 4 * 128 * 128;
        const float* ps = a.in[8] + (size_t)layer * 512;
        const float* wc = a.in[11] + (size_t)layer * 512 * 1024;
        bf16_t* dst = (bf16_t*)(ws + WS_WBR) + (size_t)2 * 1024 * 512;
        for (int i = gtid; i < 512 * 1024; i += GT) {
            const int d = i & 1023, gc = i >> 10, g = gc >> 7;
            float s = 0.f;
            for (int c2 = 0; c2 < 128; ++c2) s += pw[(size_t)gc * 128 + c2] * ps[g * 128 + c2] * wc[(size_t)(g * 128 + c2) * 1024 + d];
            dst[(size_t)d * 512 + gc] = (bf16_t)f2bf(s);
        }
    }
}

__device__ __forceinline__ void row_store_bf16(bf16_t* dst_row, const f32x4 (&v)[4], int lane) {
    unsigned long long* o8 = (unsigned long long*)dst_row + lane;
#pragma unroll
    for (int j = 0; j < 4; ++j) o8[64 * j] = (unsigned long long)pk2(v[j].x, v[j].y) | ((unsigned long long)pk2(v[j].z, v[j].w) << 32);
}
__device__ __forceinline__ void row_bd_logits(const f32x4 (&v)[4], const LAS float* wbd, float* bdl_row, int lane) {
    float acc[8];
#pragma unroll
    for (int i = 0; i < 8; ++i) acc[i] = 0.f;
#pragma unroll
    for (int j = 0; j < 4; ++j)
#pragma unroll
        for (int c = 0; c < 4; ++c) {
            const int k = 256 * j + 4 * lane + c; const float xv = v[j][c];
            const f32x4 w0 = *(const LAS f32x4*)(wbd + k * 8), w1 = *(const LAS f32x4*)(wbd + k * 8 + 4);
            acc[0] += xv * w0.x; acc[1] += xv * w0.y; acc[2] += xv * w0.z; acc[3] += xv * w0.w;
            acc[4] += xv * w1.x; acc[5] += xv * w1.y; acc[6] += xv * w1.z; acc[7] += xv * w1.w;
        }
    float r = 0.f;
#pragma unroll
    for (int i = 0; i < 8; ++i) { const float s = wave_sum(acc[i]); r = (lane == i) ? s : r; }
    if (lane < 8) bdl_row[lane] = r;
}
__device__ __forceinline__ void stage_wbd(const float* w_in_layer, LAS float* wbd, int tid) {
    for (int k = tid; k < 1024; k += NTHR) {
        const f32x4 a0 = *(const f32x4*)(w_in_layer + (size_t)k * D_IN + OFF_BETA), a1 = *(const f32x4*)(w_in_layer + (size_t)k * D_IN + OFF_BETA + 4);
        *(LAS f32x4*)(wbd + k * 8) = a0; *(LAS f32x4*)(wbd + k * 8 + 4) = a1;
    }
    __syncthreads();
}

__device__ __forceinline__ void phase_xconv(const Args& a, LAS unsigned char* lds, int gw, int NGW, int lane, int tid) {
    LAS float* wbd = (LAS float*)(lds);
    stage_wbd(a.in[1], wbd, tid);
    const float* x = a.in[0]; bf16_t* XB = (bf16_t*)(a.ws + WS_XB); float* bdl = (float*)(a.ws + WS_BDL);
    for (int m = gw; m < T; m += NGW) {
        const f32x4* xr = (const f32x4*)(x + (size_t)m * D) + lane;
        f32x4 v[4];
#pragma unroll
        for (int j = 0; j < 4; ++j) v[j] = xr[64 * j];
        row_store_bf16(XB + (size_t)m * D, v, lane);
        row_bd_logits(v, wbd, bdl + (size_t)m * 8, lane);
    }
    __syncthreads();
}

__device__ __forceinline__ void phase_pool(const Args& a, int gw, int NGW, int lane) {
    const bf16_t* pool = (const bf16_t*)(a.ws + WS_POOL); bf16_t* pld = (bf16_t*)(a.ws + WS_PLD);
    const int g = lane >> 4, win = 2 << g;
    for (int m = gw; m < T; m += NGW) {
        const int tl = m & (SEQ - 1);
        const int n = (tl + 1 < win) ? tl + 1 : win;
        float s[8];
#pragma unroll
        for (int i = 0; i < 8; ++i) s[i] = 0.f;
        u32x4 cur = {0u, 0u, 0u, 0u};
        for (int q = 0; q < n; ++q) {
            const u32x4 w = *(const u32x4*)(pool + (size_t)(m - q) * 512 + 8 * lane);
            if (q == 0) cur = w;
            s[0] += bflo(w.x); s[1] += bfhi(w.x); s[2] += bflo(w.y); s[3] += bfhi(w.y); s[4] += bflo(w.z); s[5] += bfhi(w.z); s[6] += bflo(w.w); s[7] += bfhi(w.w);
        }
        const float inv = 1.0f / (float)n;
        u32x4 o;
        o.x = pk2(s[0] * inv - bflo(cur.x), s[1] * inv - bfhi(cur.x)); o.y = pk2(s[2] * inv - bflo(cur.y), s[3] * inv - bfhi(cur.y));
        o.z = pk2(s[4] * inv - bflo(cur.z), s[5] * inv - bfhi(cur.z)); o.w = pk2(s[6] * inv - bflo(cur.w), s[7] * inv - bfhi(cur.w));
        *(u32x4*)(pld + (size_t)m * 512 + 8 * lane) = o;
    }
}

__device__ __forceinline__ void phase_ln1(const Args& a, int layer, int gw, int NGW, int lane) {
    const float* xin = (layer == 0) ? a.in[0] : a.out;
    const float* mix = (const float*)(a.ws + WS_MIX);
    float* xo = a.out; bf16_t* XB = (bf16_t*)(a.ws + WS_XB);
    const float* lg_ = a.in[14] + (size_t)layer * D; const float* lb_ = a.in[15] + (size_t)layer * D;
    const float* wg = a.in[16] + (size_t)layer * D * 4; const float* bg = a.in[17] + (size_t)layer * 4;
    const float* we = a.in[18] + (size_t)layer * D * 32; const float* be = a.in[19] + (size_t)layer * 32;
    int* eid = (int*)(a.ws + WS_EID); float* wts = (float*)(a.ws + WS_WTS); int* hist = (int*)(a.ws + WS_HIST);
    f32x4 gv[4], bv[4];
#pragma unroll
    for (int j = 0; j < 4; ++j) { gv[j] = ((const f32x4*)lg_)[64 * j + lane]; bv[j] = ((const f32x4*)lb_)[64 * j + lane]; }
    int cnt = 0;
    for (int m = gw; m < T; m += NGW) {
        const f32x4* xr = (const f32x4*)(xin + (size_t)m * D) + lane; const f32x4* mr = (const f32x4*)(mix + (size_t)m * D) + lane;
        f32x4 v[4]; float s = 0.f;
#pragma unroll
        for (int j = 0; j < 4; ++j) { v[j] = xr[64 * j] * DN_ALPHA + mr[64 * j]; s += (v[j].x + v[j].y) + (v[j].z + v[j].w); }
        const float mean = wave_sum(s) * (1.f / D); float s2 = 0.f;
#pragma unroll
        for (int j = 0; j < 4; ++j) { v[j] = v[j] - mean; s2 += (v[j].x * v[j].x + v[j].y * v[j].y) + (v[j].z * v[j].z + v[j].w * v[j].w); }
        const float rstd = 1.f / sqrtf(wave_sum(s2) * (1.f / D) + LN_EPS);
#pragma unroll
        for (int j = 0; j < 4; ++j) v[j] = v[j] * rstd * gv[j] + bv[j];
        f32x4* orow = (f32x4*)(xo + (size_t)m * D) + lane;
#pragma unroll
        for (int j = 0; j < 4; ++j) orow[64 * j] = v[j];
        row_store_bf16(XB + (size_t)m * D, v, lane);
        float ag[4] = {0.f, 0.f, 0.f, 0.f}; float ae[32];
#pragma unroll
        for (int i = 0; i < 32; ++i) ae[i] = 0.f;
#pragma unroll
        for (int j = 0; j < 4; ++j)
#pragma unroll
            for (int c = 0; c < 4; ++c) {
                const int k = 256 * j + 4 * lane + c; const float xv = v[j][c];
                const f32x4 g4 = *(const f32x4*)(wg + (size_t)k * 4);
                ag[0] += xv * g4.x; ag[1] += xv * g4.y; ag[2] += xv * g4.z; ag[3] += xv * g4.w;
#pragma unroll
                for (int q = 0; q < 8; ++q) { const f32x4 e4 = *(const f32x4*)(we + (size_t)k * 32 + 4 * q);
                    ae[4 * q] += xv * e4.x; ae[4 * q + 1] += xv * e4.y; ae[4 * q + 2] += xv * e4.z; ae[4 * q + 3] += xv * e4.w; }
            }
#pragma unroll
        for (int i = 0; i < 4; ++i) ag[i] = wave_sum(ag[i]) + bg[i];
        float mine = 0.f;
#pragma unroll
        for (int i = 0; i < 32; ++i) { const float sr = wave_sum(ae[i]); mine = (lane == i) ? sr : mine; }
        mine += be[lane & 31];
        int gsel = 0; float gm = ag[0];
#pragma unroll
        for (int i = 1; i < 4; ++i) if (ag[i] > gm) { gm = ag[i]; gsel = i; }
        float gs = 0.f;
#pragma unroll
        for (int i = 0; i < 4; ++i) gs += expf(ag[i] - gm);
        const float p_top = 1.0f / gs;
        float le[8];
#pragma unroll
        for (int i = 0; i < 8; ++i) le[i] = __shfl(mine, gsel * 8 + i);
        int i0 = 0; float l0 = le[0];
#pragma unroll
        for (int i = 1; i < 8; ++i) if (le[i] > l0) { l0 = le[i]; i0 = i; }
        int i1 = -1; float l1 = -3.0e38f;
#pragma unroll
        for (int i = 0; i < 8; ++i) if (i != i0 && le[i] > l1) { l1 = le[i]; i1 = i; }
        const float ex = expf(l1 - l0); const float w0 = p_top / (1.0f + ex), w1 = p_top * ex / (1.0f + ex);
        const int e0 = gsel * 8 + i0, e1 = gsel * 8 + i1;
        if (lane == 0) { eid[2 * m] = e0; eid[2 * m + 1] = e1; wts[2 * m] = w0; wts[2 * m + 1] = w1; }
        cnt += (lane == e0) ? 1 : 0; cnt += (lane == e1) ? 1 : 0;
    }
    if (lane < 32) hist[gw * 32 + lane] = cnt;
}

__device__ __forceinline__ void phase_slots(const Args& a, LAS unsigned char* lds, int gw, int NGW, int wave, int lane, int tid) {
    LAS int* red = (LAS int*)lds;
    LAS int* tot = red + 1024;
    LAS int* bef = tot + 32;
    LAS int* pst = bef + 32;
    LAS int* base = pst + 64;
    const int* hist = (const int*)(a.ws + WS_HIST);
    const int nwv = NGW;
    const int wg0 = gw - wave;
    {
        const int e = tid & 31, part = tid >> 5;
        const int per = (nwv + 15) / 16; const int lo = part * per, hi = (lo + per < nwv) ? lo + per : nwv;
        int st = 0, sb = 0;
        for (int g = lo; g < hi; ++g) { const int v = hist[g * 32 + e]; st += v; sb += (g < wg0) ? v : 0; }
        red[part * 32 + e] = st; red[512 + part * 32 + e] = sb;
    }
    __syncthreads();
    if (tid < 32) { int st = 0, sb = 0; for (int p = 0; p < 16; ++p) { st += red[p * 32 + tid]; sb += red[512 + p * 32 + tid]; } tot[tid] = st; bef[tid] = sb; }
    __syncthreads();
    if (tid == 0) { int acc = 0; for (int e = 0; e < 32; ++e) { pst[e] = acc; acc += (tot[e] + MOE_BLOCK - 1) / MOE_BLOCK * MOE_BLOCK; } pst[32] = acc; }
    __syncthreads();
    if (tid < 32) { int acc = pst[tid] + bef[tid]; for (int w = 0; w < NWAVES; ++w) { base[w * 32 + tid] = acc; acc += hist[(wg0 + w) * 32 + tid]; } }
    __syncthreads();
    if (blockIdx.x == 0) {
        int* blk_e = (int*)(a.ws + WS_BLKE);
        const int nblk = pst[32] / MOE_BLOCK;
        if (tid == 0) blk_e[1023] = nblk;
        for (int b = tid; b < nblk; b += NTHR) { int e = 0; for (int q = 0; q < 32; ++q) if (pst[q] <= b * MOE_BLOCK) e = q; blk_e[b] = e; }
    }
    const int* eid = (const int*)(a.ws + WS_EID); int* slot = (int*)(a.ws + WS_SLOT);
    const bf16_t* XB = (const bf16_t*)(a.ws + WS_XB); bf16_t* xg = (bf16_t*)(a.ws + WS_XG);
    int cnt = (lane < 32) ? base[wave * 32 + lane] : 0;
    for (int m = gw; m < T; m += NGW) {
        const int e0 = eid[2 * m], e1 = eid[2 * m + 1];
        const int s0 = __shfl(cnt, e0); cnt += (lane == e0) ? 1 : 0;
        const int s1 = __shfl(cnt, e1); cnt += (lane == e1) ? 1 : 0;
        if (lane == 0) { slot[2 * m] = s0; slot[2 * m + 1] = s1; }
        const u32x4* src = (const u32x4*)(XB + (size_t)m * D) + lane;
        const u32x4 p0 = src[0], p1 = src[64];
        u32x4* d0 = (u32x4*)(xg + (size_t)s0 * D) + lane; u32x4* d1 = (u32x4*)(xg + (size_t)s1 * D) + lane;
        d0[0] = p0; d0[64] = p1; d1[0] = p0; d1[64] = p1;
    }
    __syncthreads();
}

__device__ __forceinline__ void phase_ln2(const Args& a, LAS unsigned char* lds, int layer, int gw, int NGW, int lane, int tid) {
    LAS float* wbd = (LAS float*)(lds);
    const bool has_next = (layer + 1 < DEPTH);
    if (has_next) stage_wbd(a.in[1] + (size_t)(layer + 1) * D * D_IN, wbd, tid);
    float* xo = a.out; bf16_t* XB = (bf16_t*)(a.ws + WS_XB); float* bdl = (float*)(a.ws + WS_BDL);
    const bf16_t* ymoe = (const bf16_t*)(a.ws + WS_YMOE);
    const int* slot = (const int*)(a.ws + WS_SLOT); const float* wts = (const float*)(a.ws + WS_WTS);
    const float* lg_ = a.in[23] + (size_t)layer * D; const float* lb_ = a.in[24] + (size_t)layer * D;
    f32x4 gv[4], bv[4];
#pragma unroll
    for (int j = 0; j < 4; ++j) { gv[j] = ((const f32x4*)lg_)[64 * j + lane]; bv[j] = ((const f32x4*)lb_)[64 * j + lane]; }
    for (int m = gw; m < T; m += NGW) {
        const int s0 = slot[2 * m], s1 = slot[2 * m + 1]; const float w0 = wts[2 * m], w1 = wts[2 * m + 1];
        const f32x4* xr = (const f32x4*)(xo + (size_t)m * D) + lane;
        const unsigned long long* y0 = (const unsigned long long*)(ymoe + (size_t)s0 * D) + lane; const unsigned long long* y1 = (const unsigned long long*)(ymoe + (size_t)s1 * D) + lane;
        f32x4 v[4]; float s = 0.f;
#pragma unroll
        for (int j = 0; j < 4; ++j) {
            const unsigned long long p = y0[64 * j], q = y1[64 * j];
            f32x4 f; f.x = w0 * bflo((unsigned)p) + w1 * bflo((unsigned)q); f.y = w0 * bfhi((unsigned)p) + w1 * bfhi((unsigned)q);
            f.z = w0 * bflo((unsigned)(p >> 32)) + w1 * bflo((unsigned)(q >> 32)); f.w = w0 * bfhi((unsigned)(p >> 32)) + w1 * bfhi((unsigned)(q >> 32));
            v[j] = xr[64 * j] * DN_ALPHA + f; s += (v[j].x + v[j].y) + (v[j].z + v[j].w);
        }
        const float mean = wave_sum(s) * (1.f / D); float s2 = 0.f;
#pragma unroll
        for (int j = 0; j < 4; ++j) { v[j] = v[j] - mean; s2 += (v[j].x * v[j].x + v[j].y * v[j].y) + (v[j].z * v[j].z + v[j].w * v[j].w); }
        const float rstd = 1.f / sqrtf(wave_sum(s2) * (1.f / D) + LN_EPS);
#pragma unroll
        for (int j = 0; j < 4; ++j) v[j] = v[j] * rstd * gv[j] + bv[j];
        f32x4* orow = (f32x4*)(xo + (size_t)m * D) + lane;
#pragma unroll
        for (int j = 0; j < 4; ++j) orow[64 * j] = v[j];
        if (has_next) { row_store_bf16(XB + (size_t)m * D, v, lane); row_bd_logits(v, wbd, bdl + (size_t)m * 8, lane); }
    }
    __syncthreads();
}


template <class F> struct EpiP8 { static constexpr bool PERM = true, AFTER_DRAIN = false; F f;
    __device__ __forceinline__ void operator()(const f32x4 (&acc)[2][2][4][2], const pg8::Unit& u, int wr, int wc, int fr, int fq) const {
        const int row0 = u.pm * 256 + wr * 64 + fr, col0 = u.pn * 256 + wc * 32 + 8 * fq;
#pragma unroll
        for (int ai = 0; ai < 2; ++ai)
#pragma unroll
            for (int m = 0; m < 4; ++m)
#pragma unroll
                for (int bj = 0; bj < 2; ++bj) f(row0 + ai * 128 + m * 16, col0 + bj * 128, acc[ai][bj][m][0], acc[ai][bj][m][1]);
    } };
template <class F> struct EpiPair { static constexpr bool PERM = true, AFTER_DRAIN = false; F f;
    __device__ __forceinline__ void operator()(const f32x4 (&acc)[2][2][4][2], const pg8::Unit& u, int wr, int wc, int fr, int fq) const {
        const int row0 = u.pm * 256 + wr * 64 + fr, col0 = u.pn * 256 + wc * 32 + 8 * fq;
#pragma unroll
        for (int ai = 0; ai < 2; ++ai)
#pragma unroll
            for (int m = 0; m < 4; ++m) f(row0 + ai * 128 + m * 16, col0, acc[ai][0][m][0], acc[ai][0][m][1], acc[ai][1][m][0], acc[ai][1][m][1]);
    } };
template <class F> struct EpiP4 { static constexpr bool PERM = false, AFTER_DRAIN = false; F f;
    __device__ __forceinline__ void operator()(const f32x4 (&acc)[2][2][4][2], const pg8::Unit& u, int wr, int wc, int fr, int fq) const {
        const int row0 = u.pm * 256 + wr * 64 + fr, col0 = u.pn * 256 + wc * 32 + 4 * fq;
#pragma unroll
        for (int ai = 0; ai < 2; ++ai)
#pragma unroll
            for (int m = 0; m < 4; ++m)
#pragma unroll
                for (int bj = 0; bj < 2; ++bj)
#pragma unroll
                    for (int n = 0; n < 2; ++n) f(row0 + ai * 128 + m * 16, col0 + bj * 128 + n * 16, acc[ai][bj][m][n]);
    } };
__device__ __forceinline__ u32x4 pack8(f32x4 a, f32x4 b) { u32x4 w; w.x = pg8::cvt_pk_bf16(a.x, a.y); w.y = pg8::cvt_pk_bf16(a.z, a.w); w.z = pg8::cvt_pk_bf16(b.x, b.y); w.w = pg8::cvt_pk_bf16(b.z, b.w); return w; }
__device__ __forceinline__ float fsig(float x) { return __builtin_amdgcn_rcpf(1.0f + __expf(-x)); }
struct F_Proj1 { unsigned char* ws;
    __device__ __forceinline__ void operator()(int row, int col, f32x4 a, f32x4 b) const {
        bf16_t* p;
        if (col < 512) p = (bf16_t*)(ws + WS_QA) + (size_t)row * 512 + col;
        else if (col < 1024) p = (bf16_t*)(ws + WS_KA) + (size_t)row * 512 + (col - 512);
        else if (col < 2560) p = (bf16_t*)(ws + WS_QKVB) + (size_t)row * 1536 + (col - 1024);
        else if (col < 3072) p = (bf16_t*)(ws + WS_GATEB) + (size_t)row * 512 + (col - 2560);
        else p = (bf16_t*)(ws + WS_POOL) + (size_t)row * 512 + (col - 3072);
        *(u32x4*)p = pack8(a, b); } };
struct F_Bf16 { bf16_t* O; int ldc, cmask;
    __device__ __forceinline__ void operator()(int row, int col, f32x4 a, f32x4 b) const { *(u32x4*)(O + (size_t)row * ldc + (col & cmask)) = pack8(a, b); } };
struct F_Gates { bf16_t* O; const float* gb;
    __device__ __forceinline__ void operator()(int row, int col, f32x4 a, f32x4 b) const { const f32x4 b0 = *(const f32x4*)(gb + col), b1 = *(const f32x4*)(gb + col + 4);
        a = a + b0; b = b + b1; a.x = fsig(a.x); a.y = fsig(a.y); a.z = fsig(a.z); a.w = fsig(a.w); b.x = fsig(b.x); b.y = fsig(b.y); b.z = fsig(b.z); b.w = fsig(b.w);
        *(u32x4*)(O + (size_t)row * 3072 + col) = pack8(a, b); } };
template <int WHICH> struct F_Branch { bf16_t* Y; const bf16_t* gates;
    __device__ __forceinline__ void operator()(int row, int col, f32x4 a, f32x4 b) const {
        const u32x4 g = *(const u32x4*)(gates + (size_t)row * 3072 + WHICH * 1024 + col);
        a.x *= bflo(g.x); a.y *= bfhi(g.x); a.z *= bflo(g.y); a.w *= bfhi(g.y); b.x *= bflo(g.z); b.y *= bfhi(g.z); b.z *= bflo(g.w); b.w *= bfhi(g.w);
        bf16_t* yp = Y + (size_t)row * 1024 + col;
        if (WHICH > 0) { const u32x4 o = *(const u32x4*)yp; a.x += bflo(o.x); a.y += bfhi(o.x); a.z += bflo(o.y); a.w += bfhi(o.y); b.x += bflo(o.z); b.y += bfhi(o.z); b.z += bflo(o.w); b.w += bfhi(o.w); }
        *(u32x4*)yp = pack8(a, b); } };
struct F_F32 { float* O; int ldc;
    __device__ __forceinline__ void operator()(int row, int col, f32x4 v) const { *(f32x4*)(O + (size_t)row * ldc + col) = v; } };
struct F_Hdn { bf16_t* H;
    __device__ __forceinline__ void operator()(int row, int col, f32x4 a0, f32x4 a1, f32x4 b0, f32x4 b1) const {
        const int hc = ((col >> 8) & 3) * 128 + (col & 127);
        a0.x = a0.x * fsig(a0.x) * b0.x; a0.y = a0.y * fsig(a0.y) * b0.y; a0.z = a0.z * fsig(a0.z) * b0.z; a0.w = a0.w * fsig(a0.w) * b0.w;
        a1.x = a1.x * fsig(a1.x) * b1.x; a1.y = a1.y * fsig(a1.y) * b1.y; a1.z = a1.z * fsig(a1.z) * b1.z; a1.w = a1.w * fsig(a1.w) * b1.w;
        *(u32x4*)(H + (size_t)row * 512 + hc) = pack8(a0, a1); } };
struct MoeOrder { const LAS int* tab; int nunits, G, c;
    __device__ __forceinline__ bool next(int i, pg8::Unit& u) const { const int L = i * G + c; if (L >= nunits) return false; const int blk = L >> 2; u.pm = blk; u.pn = tab[blk] * 4 + (L & 3); return true; }
    __device__ __forceinline__ void a_ready(const pg8::Unit&) const {}
    __device__ __forceinline__ void done(const pg8::Unit&) const {} };
constexpr int LDS_TAB_OFF = 131072;

__device__ __forceinline__ void phase_g_proj1(const Args& a, LAS unsigned char* lds, int G, int c) {
    const bf16_t* XB = (const bf16_t*)(a.ws + WS_XB);
    { pg8::Gemm g{XB, (const bf16_t*)(a.ws + WS_WIN1), T, N1, 1024}; pg8::StaticOrder S; S.init(T, N1, G, c); EpiP8<F_Proj1> E{F_Proj1{a.ws}};
      pg8::gemm_phase<EpiP8<F_Proj1>, pg8::StaticOrder, true, true>(lds, g, S, E); }
    { pg8::Gemm g{(const bf16_t*)(a.ws + WS_WV), XB, 512, T, 1024}; pg8::StaticOrder S; S.init(512, T, G, c); EpiP8<F_Bf16> E{F_Bf16{(bf16_t*)(a.ws + WS_VT), T, 0x7fffffff}};
      pg8::gemm_phase<EpiP8<F_Bf16>, pg8::StaticOrder, true, true>(lds, g, S, E); }
}
__device__ __forceinline__ void phase_g_gates(const Args& a, LAS unsigned char* lds, int layer, int G, int c) {
    pg8::Gemm g{(const bf16_t*)(a.ws + WS_XB), (const bf16_t*)(a.ws + WS_WG), T, 3072, 1024}; pg8::StaticOrder S; S.init(T, 3072, G, c);
    EpiP8<F_Gates> E{F_Gates{(bf16_t*)(a.ws + WS_GATES), a.in[12] + (size_t)layer * 3072}};
    pg8::gemm_phase<EpiP8<F_Gates>, pg8::StaticOrder, true, true>(lds, g, S, E);
}
__device__ __forceinline__ void phase_g_branch(const Args& a, LAS unsigned char* lds, int G, int c) {
    bf16_t* Y = (bf16_t*)(a.ws + WS_Y); const bf16_t* gates = (const bf16_t*)(a.ws + WS_GATES); const bf16_t* W = (const bf16_t*)(a.ws + WS_WBR);
    pg8::StaticOrder S; S.init(T, 1024, G, c);
    { pg8::Gemm g{(const bf16_t*)(a.ws + WS_OA), W, T, 1024, 512}; EpiP8<F_Branch<0>> E{F_Branch<0>{Y, gates}}; pg8::gemm_phase<EpiP8<F_Branch<0>>, pg8::StaticOrder, true, true>(lds, g, S, E); }
    { pg8::Gemm g{(const bf16_t*)(a.ws + WS_OB), W + (size_t)1024 * 512, T, 1024, 512}; EpiP8<F_Branch<1>> E{F_Branch<1>{Y, gates}}; pg8::gemm_phase<EpiP8<F_Branch<1>>, pg8::StaticOrder, true, true>(lds, g, S, E); }
    { pg8::Gemm g{(const bf16_t*)(a.ws + WS_PLD), W + (size_t)2 * 1024 * 512, T, 1024, 512}; EpiP8<F_Branch<2>> E{F_Branch<2>{Y, gates}}; pg8::gemm_phase<EpiP8<F_Branch<2>>, pg8::StaticOrder, true, true>(lds, g, S, E); }
}
__device__ __forceinline__ void phase_g_out(const Args& a, LAS unsigned char* lds, int G, int c) {
    pg8::Gemm g{(const bf16_t*)(a.ws + WS_Y), (const bf16_t*)(a.ws + WS_WOUT), T, 1024, 1024}; pg8::StaticOrder S; S.init(T, 1024, G, c);
    EpiP4<F_F32> E{F_F32{(float*)(a.ws + WS_MIX), 1024}};
    pg8::gemm_phase<EpiP4<F_F32>, pg8::StaticOrder, true, true>(lds, g, S, E);
}
__device__ __forceinline__ void moe_table(const Args& a, LAS unsigned char* lds, MoeOrder& S, int G, int c, int tid) {
    const int* blk_e = (const int*)(a.ws + WS_BLKE); LAS int* tab = (LAS int*)(lds + LDS_TAB_OFF);
    const int nblk = blk_e[1023];
    for (int i = tid; i < nblk; i += NTHR) tab[i] = blk_e[i];
    __syncthreads();
    S.tab = tab; S.nunits = nblk * 4; S.G = G; S.c = c;
}
__device__ __forceinline__ void phase_moe1(const Args& a, LAS unsigned char* lds, int G, int c, int tid) {
    MoeOrder S; moe_table(a, lds, S, G, c, tid);
    pg8::Gemm g{(const bf16_t*)(a.ws + WS_XG), (const bf16_t*)(a.ws + WS_W13), CAP, NEXP * 1024, 1024};
    EpiPair<F_Hdn> E{F_Hdn{(bf16_t*)(a.ws + WS_HDN)}};
    pg8::gemm_phase<EpiPair<F_Hdn>, MoeOrder, true, true>(lds, g, S, E);
}
__device__ __forceinline__ void phase_moe2(const Args& a, LAS unsigned char* lds, int G, int c, int tid) {
    MoeOrder S; moe_table(a, lds, S, G, c, tid);
    pg8::Gemm g{(const bf16_t*)(a.ws + WS_HDN), (const bf16_t*)(a.ws + WS_W2), CAP, NEXP * 1024, 512};
    EpiP8<F_Bf16> E{F_Bf16{(bf16_t*)(a.ws + WS_YMOE), 1024, 1023}};
    pg8::gemm_phase<EpiP8<F_Bf16>, MoeOrder, true, true>(lds, g, S, E);
}


__device__ __forceinline__ void attn_stage_bias(const Args& a, LAS unsigned char* lds, int layer, int tid) {
    LAS float* rb = (LAS float*)lds;
    const float* relb = a.in[2] + (size_t)layer * A_HEADS * A_NREL;
    for (int i = tid; i < A_HEADS * A_NREL; i += NTHR) rb[i] = relb[i] * 1.4426950408889634f;
    __syncthreads();
}
__device__ __forceinline__ void attn_item(const Args& a, const LAS float* rb, int item, int lane) {
    const bf16_t* qA = (const bf16_t*)(a.ws + WS_QA); const bf16_t* kA = (const bf16_t*)(a.ws + WS_KA); const bf16_t* vT = (const bf16_t*)(a.ws + WS_VT); bf16_t* oA = (bf16_t*)(a.ws + WS_OA);
    const int fr = lane & 15, fq = lane >> 4;
    const int hq = item & 1, ci = (item >> 1) & 31, h = (item >> 6) & 7, b = item >> 9;
    const size_t tokq = (size_t)b * SEQ + ci * 64 + hq * 32;
    bf16x8 Bq[2][2];
#pragma unroll
    for (int qt = 0; qt < 2; ++qt)
#pragma unroll
        for (int ks = 0; ks < 2; ++ks) Bq[qt][ks] = *(const bf16x8*)(qA + (tokq + qt * 16 + fr) * 512 + h * 64 + ks * 32 + 8 * fq);
    f32x4 O[4][2];
#pragma unroll
    for (int dt = 0; dt < 4; ++dt) { O[dt][0] = (f32x4){0.f, 0.f, 0.f, 0.f}; O[dt][1] = (f32x4){0.f, 0.f, 0.f, 0.f}; }
    float mrun[2] = {-1.0e30f, -1.0e30f}, lrun[2] = {0.f, 0.f};
    const LAS float* rbh = rb + h * A_NREL;
    const float SC = 0.125f * 1.4426950408889634f;
    const int kc_lo = ci >= 8 ? ci - 8 : 0;
    for (int kc = kc_lo; kc <= ci; ++kc) {
        const int t = ci - kc;
        const size_t tokk = (size_t)b * SEQ + kc * 64;
        f32x4 S[4][2];
#pragma unroll
        for (int kt = 0; kt < 4; ++kt) {
            const bf16_t* kp = kA + (tokk + kt * 16 + fr) * 512 + h * 64 + 8 * fq;
            const bf16x8 Ak0 = *(const bf16x8*)kp, Ak1 = *(const bf16x8*)(kp + 32);
#pragma unroll
            for (int qt = 0; qt < 2; ++qt) {
                f32x4 z = (f32x4){0.f, 0.f, 0.f, 0.f};
                z = __builtin_amdgcn_mfma_f32_16x16x32_bf16(Ak0, Bq[qt][0], z, 0, 0, 0);
                S[kt][qt] = __builtin_amdgcn_mfma_f32_16x16x32_bf16(Ak1, Bq[qt][1], z, 0, 0, 0);
            }
        }
        if (t >= 5) {
            const float cb = rbh[319];
#pragma unroll
            for (int kt = 0; kt < 4; ++kt)
#pragma unroll
                for (int qt = 0; qt < 2; ++qt) S[kt][qt] = S[kt][qt] * SC + cb;
        } else {
#pragma unroll
            for (int kt = 0; kt < 4; ++kt)
#pragma unroll
                for (int qt = 0; qt < 2; ++qt)
#pragma unroll
                    for (int r = 0; r < 4; ++r) {
                        int dist = (hq * 32 + qt * 16 + fr) - (kt * 16 + 4 * fq + r) + 64 * t; dist = dist > A_CLIP ? A_CLIP : dist;
                        S[kt][qt][r] = S[kt][qt][r] * SC + rbh[dist + 63];
                    }
        }
#pragma unroll
        for (int qt = 0; qt < 2; ++qt) {
            float mx = S[0][qt][0];
#pragma unroll
            for (int kt = 0; kt < 4; ++kt)
#pragma unroll
                for (int r = 0; r < 4; ++r) mx = fmaxf(mx, S[kt][qt][r]);
            mx = fmaxf(mx, __shfl_xor(mx, 16)); mx = fmaxf(mx, __shfl_xor(mx, 32));
            const float mn = fmaxf(mrun[qt], mx), al = __builtin_amdgcn_exp2f(mrun[qt] - mn); mrun[qt] = mn;
            float ps = 0.f;
#pragma unroll
            for (int kt = 0; kt < 4; ++kt)
#pragma unroll
                for (int r = 0; r < 4; ++r) { const float p = __builtin_amdgcn_exp2f(S[kt][qt][r] - mn); S[kt][qt][r] = p; ps += p; }
            lrun[qt] = lrun[qt] * al + ps;
#pragma unroll
            for (int dt = 0; dt < 4; ++dt) O[dt][qt] = O[dt][qt] * al;
        }
        bf16x8 Bp[2][2];
#pragma unroll
        for (int qt = 0; qt < 2; ++qt)
#pragma unroll
            for (int s2 = 0; s2 < 2; ++s2) { const u32x4 w = pack8(S[2 * s2][qt], S[2 * s2 + 1][qt]); Bp[qt][s2] = __builtin_bit_cast(bf16x8, w); }
#pragma unroll
        for (int dt = 0; dt < 4; ++dt)
#pragma unroll
            for (int s2 = 0; s2 < 2; ++s2) {
                const bf16_t* vp = vT + (size_t)(h * 64 + dt * 16 + fr) * T + tokk + 32 * s2 + 4 * fq;
                const u32x2 lo = *(const u32x2*)vp, hi = *(const u32x2*)(vp + 16);
                const u32x4 w = {lo.x, lo.y, hi.x, hi.y}; const bf16x8 Av = __builtin_bit_cast(bf16x8, w);
#pragma unroll
                for (int qt = 0; qt < 2; ++qt) O[dt][qt] = __builtin_amdgcn_mfma_f32_16x16x32_bf16(Av, Bp[qt][s2], O[dt][qt], 0, 0, 0);
            }
    }
#pragma unroll
    for (int qt = 0; qt < 2; ++qt) {
        float l = lrun[qt]; l += __shfl_xor(l, 16); l += __shfl_xor(l, 32);
        const float inv = 1.0f / l;
#pragma unroll
        for (int dt = 0; dt < 4; ++dt) {
            const f32x4 o = O[dt][qt] * inv; u32x2 w; w.x = pg8::cvt_pk_bf16(o.x, o.y); w.y = pg8::cvt_pk_bf16(o.z, o.w);
            *(u32x2*)(oA + (tokq + qt * 16 + fr) * 512 + h * 64 + dt * 16 + 4 * fq) = w;
        }
    }
}
__device__ __forceinline__ void phase_attn(const Args& a, LAS unsigned char* lds, int layer, int wave, int lane, int tid, int G) {
    attn_stage_bias(a, lds, layer, tid);
    const LAS float* rb = (const LAS float*)lds;
    constexpr int NGRP = BATCH * A_HEADS * NCH / 4;
    const int per = (NGRP + G - 1) / G;
    for (int gi = 0; gi < per; ++gi) {
        const int grp = blockIdx.x * per + gi; if (grp >= NGRP) break;
        attn_item(a, rb, grp * 8 + wave, lane);
    }
    __syncthreads();
}


constexpr int PKR = 272, PKT = 144;
constexpr int G1_KR = 0, G1_LB = 4 * 64 * PKR, G1_CW = G1_LB + 65536, G1_GB = G1_CW + 8192, G1_BB = G1_GB + 1024, G1_GC = G1_BB + 1024, G1_END = G1_GC + 1024;
constexpr int G2_KR = 0, G2_QS = 17408, G2_KT = 34816, G2_VT = 53248, G2_VN = 71680, G2_QK = 90112, G2_ST = 99328, G2_CW = 134144, G2_SM = 140288, G2_WN = G2_SM + 2048, G2_END = G2_WN + 17408;
static_assert(G1_END <= LDS_BYTES && G2_END <= LDS_BYTES, "gdn LDS maps");
#define MFMA16(a_, b_, c_) __builtin_amdgcn_mfma_f32_16x16x32_bf16((a_), (b_), (c_), 0, 0, 0)
#define LDSF(off) (*(const LAS bf16x8*)(lds + (off)))

__device__ __forceinline__ void gdn_pre_stage(const Args& a, LAS unsigned char* lds, int layer, int tid) {
    LAS float* cw = (LAS float*)(lds + G1_CW);
    const float* cwg = a.in[3] + (size_t)layer * 4 * 1536;
    for (int i = tid; i < 4 * 512; i += NTHR) cw[i] = cwg[(i >> 9) * 1536 + 512 + (i & 511)];
    __syncthreads();
}
__device__ __forceinline__ void gdn_pre_item(const Args& a, LAS unsigned char* lds, int layer, int item, int wave, int lane, int tid) {
    const int b = item >> 5, n = item & 31;
    const bf16_t* qkvB = (const bf16_t*)(a.ws + WS_QKVB); const float* bdl = (const float*)(a.ws + WS_BDL); float* gcg = (float*)(a.ws + WS_GC);
    const LAS float* cw = (const LAS float*)(lds + G1_CW); LAS float* gb = (LAS float*)(lds + G1_GB); LAS float* bb = (LAS float*)(lds + G1_BB); LAS float* gcb = (LAS float*)(lds + G1_GC);
    {
        const int tk = tid >> 3, cgp = tid & 7, hh = cgp >> 1, half = cgp & 1;
        const int tl = n * 64 + tk; const size_t r = (size_t)b * SEQ + tl;
        const int cbase = hh * 128 + half * 64;
        float kv[64];
#pragma unroll
        for (int c = 0; c < 64; ++c) kv[c] = 0.f;
#pragma unroll
        for (int i = 0; i < 4; ++i) {
            if (tl - 3 + i >= 0) {
                const u32x4* src = (const u32x4*)(qkvB + (r - 3 + i) * 1536 + 512 + cbase);
#pragma unroll
                for (int q = 0; q < 8; ++q) { const u32x4 w = src[q]; const LAS float* wp = cw + i * 512 + cbase + 8 * q;
                    const f32x4 w0 = *(const LAS f32x4*)wp, w1 = *(const LAS f32x4*)(wp + 4);
                    kv[8 * q + 0] += w0.x * bflo(w.x); kv[8 * q + 1] += w0.y * bfhi(w.x); kv[8 * q + 2] += w0.z * bflo(w.y); kv[8 * q + 3] += w0.w * bfhi(w.y);
                    kv[8 * q + 4] += w1.x * bflo(w.z); kv[8 * q + 5] += w1.y * bfhi(w.z); kv[8 * q + 6] += w1.z * bflo(w.w); kv[8 * q + 7] += w1.w * bfhi(w.w); }
            }
            asm volatile("" ::: "memory");
        }
        float ss = 0.f;
#pragma unroll
        for (int c = 0; c < 64; ++c) { kv[c] = siluf_(kv[c]); ss += kv[c] * kv[c]; }
        ss += __shfl_xor(ss, 1);
        const float rk = rsqrtf(ss + RMS_EPS);
        LAS unsigned char* dst = lds + G1_KR + hh * (64 * PKR) + tk * PKR + half * 128;
#pragma unroll
        for (int q = 0; q < 8; ++q) { f32x4 x0 = {kv[8 * q] * rk, kv[8 * q + 1] * rk, kv[8 * q + 2] * rk, kv[8 * q + 3] * rk}, x1 = {kv[8 * q + 4] * rk, kv[8 * q + 5] * rk, kv[8 * q + 6] * rk, kv[8 * q + 7] * rk};
            *(LAS u32x4*)(dst + 16 * q) = pack8(x0, x1); }
        if (half == 0) {
            const float Aexp = expf(a.in[4][layer * 4 + hh]), dtb = a.in[5][layer * 4 + hh];
            bb[hh * 64 + tk] = sigmoidf_(bdl[r * 8 + hh]);
            gb[hh * 64 + tk] = -Aexp * softplusf_(bdl[r * 8 + 4 + hh] + dtb);
        }
    }
    __syncthreads();
    {
        const int hh = wave >> 1, fr = lane & 15, fq = lane >> 4;
        float g = gb[hh * 64 + lane];
#pragma unroll
        for (int o = 1; o < 64; o <<= 1) { const float t = __shfl_up(g, o); if (lane >= o) g += t; }
        gcb[hh * 64 + lane] = g;
        if ((wave & 1) == 0) gcg[((size_t)b * SEQ + n * 64 + lane) * 4 + hh] = g;
        asm volatile("s_waitcnt lgkmcnt(0)" ::: "memory");
        const int kr = G1_KR + hh * (64 * PKR);
        LAS float* Lb = (LAS float*)(lds + G1_LB) + hh * 4096;
#pragma unroll
        for (int tt = 0; tt < 2; ++tt) {
            const int ti = 2 * (wave & 1) + tt;
            bf16x8 Af[4];
#pragma unroll
            for (int ks = 0; ks < 4; ++ks) Af[ks] = LDSF(kr + (ti * 16 + fr) * PKR + ks * 64 + fq * 16);
#pragma unroll
            for (int tj = 0; tj < 4; ++tj) {
                f32x4 acc = {0.f, 0.f, 0.f, 0.f};
                if (tj <= ti) {
#pragma unroll
                    for (int ks = 0; ks < 4; ++ks) acc = MFMA16(Af[ks], LDSF(kr + (tj * 16 + fr) * PKR + ks * 64 + fq * 16), acc);
                }
                const int j = tj * 16 + fr; const float gcj = gcb[hh * 64 + j];
#pragma unroll
                for (int rg = 0; rg < 4; ++rg) { const int i = ti * 16 + 4 * fq + rg;
                    Lb[i * 64 + j] = (i > j) ? bb[hh * 64 + i] * acc[rg] * __expf(gcb[hh * 64 + i] - gcj) : 0.f; }
            }
        }
    }
    __syncthreads();
    if (wave < 4) {
        const int hh = wave; const LAS float* Lb = (const LAS float*)(lds + G1_LB) + hh * 4096;
        float Tc[64];
        int ln = lane; asm volatile("" : "+v"(ln));
#pragma unroll
        for (int i = 0; i < 64; ++i) {
            float acc = (ln == i) ? 1.f : 0.f;
#pragma unroll
            for (int j4 = 0; j4 < (i + 3) / 4; ++j4) { const f32x4 l4 = *(const LAS f32x4*)(Lb + i * 64 + 4 * j4);
                if (4 * j4 + 0 < i) acc -= l4.x * Tc[4 * j4 + 0];
                if (4 * j4 + 1 < i) acc -= l4.y * Tc[4 * j4 + 1];
                if (4 * j4 + 2 < i) acc -= l4.z * Tc[4 * j4 + 2];
                if (4 * j4 + 3 < i) acc -= l4.w * Tc[4 * j4 + 3]; }
            Tc[i] = acc;
            if ((i & 3) == 3) asm volatile("" ::: "memory");
        }
        const float bc = bb[hh * 64 + lane], ec = bc * __expf(gcb[hh * 64 + lane]);
        bf16_t* tu = (bf16_t*)(a.ws + WS_TMU) + ((size_t)item * 4 + hh) * 4096; bf16_t* tw = (bf16_t*)(a.ws + WS_TMW) + ((size_t)item * 4 + hh) * 4096;
#pragma unroll
        for (int i = 0; i < 64; ++i) { tu[i * 64 + lane] = (bf16_t)f2bf(Tc[i] * bc); tw[i * 64 + lane] = (bf16_t)f2bf(Tc[i] * ec); }
    }
    __syncthreads();
}

__device__ __forceinline__ void st8(LAS unsigned char* p, f32x4 v) { u32x2 w; w.x = pg8::cvt_pk_bf16(v.x, v.y); w.y = pg8::cvt_pk_bf16(v.z, v.w); *(LAS u32x2*)p = w; }

__device__ __forceinline__ void gdn_scan_item(const Args& a, LAS unsigned char* lds, int layer, int item, int wave, int lane, int tid) {
    const int b = item >> 2, h = item & 3, fr = lane & 15, fq = lane >> 4;
    const bf16_t* qkvB = (const bf16_t*)(a.ws + WS_QKVB); const float* bdl = (const float*)(a.ws + WS_BDL); const float* gcg = (const float*)(a.ws + WS_GC);
    const bf16_t* gateB = (const bf16_t*)(a.ws + WS_GATEB);
#if GDN_TEST == 3
    bf16_t* oB = (bf16_t*)a.out;
#else
    bf16_t* oB = (bf16_t*)(a.ws + WS_OB);
#endif
    LAS float* cwl = (LAS float*)(lds + G2_CW);
    LAS float* gcs = (LAS float*)(lds + G2_SM); LAS float* egc = gcs + 64; LAS float* ekd = gcs + 128; LAS float* ng = gcs + 192; LAS float* red = gcs + 320;
    {
#if GDN_EXP == 6
        for (int i = tid; i < G2_CW / 16; i += NTHR) ((LAS u32x4*)(lds))[i] = (u32x4){0u, 0u, 0u, 0u};
        for (int i = tid; i < (LDS_BYTES - G2_SM) / 16; i += NTHR) ((LAS u32x4*)(lds + G2_SM))[i] = (u32x4){0u, 0u, 0u, 0u};
        __syncthreads();
#endif
        const float* cwg = a.in[3] + (size_t)layer * 4 * 1536;
        for (int i = tid; i < 4 * 384; i += NTHR) { const int tap = i / 384, rem = i % 384, seg = rem >> 7, c = rem & 127; cwl[i] = cwg[tap * 1536 + seg * 512 + h * 128 + c]; }
        for (int i = tid; i < 128; i += NTHR) ng[i] = a.in[6][layer * 128 + i];
        for (int i = tid; i < 34816 / 16; i += NTHR) ((LAS u32x4*)(lds + G2_ST))[i] = (u32x4){0u, 0u, 0u, 0u};
    }
    f32x4 Sacc[8];
#pragma unroll
    for (int i = 0; i < 8; ++i) Sacc[i] = (f32x4){0.f, 0.f, 0.f, 0.f};
    __syncthreads();
    for (int n = 0; n < NCH; ++n) {
        const size_t tok0 = (size_t)b * SEQ + n * 64;
        int zv_ = 0; asm volatile("" : "+v"(zv_));
        const float gcl = gcg[(tok0 + 63) * 4 + h + zv_];
        {
            const int tk = tid >> 3, cgp = tid & 7, c0 = cgp * 16;
            const int tl = n * 64 + tk; const size_t r = tok0 + tk;
            float qkv[3][16];
#pragma unroll
            for (int c = 0; c < 16; ++c) { qkv[0][c] = 0.f; qkv[1][c] = 0.f; qkv[2][c] = 0.f; }
#pragma unroll
            for (int i = 0; i < 4; ++i) {
                if (tl - 3 + i >= 0) {
                    const bf16_t* rowp = qkvB + (r - 3 + i) * 1536 + h * 128 + c0;
#pragma unroll
                    for (int seg = 0; seg < 3; ++seg) {
                        const u32x4 x0 = *(const u32x4*)(rowp + seg * 512), x1 = *(const u32x4*)(rowp + seg * 512 + 8);
                        const LAS float* wp = cwl + i * 384 + seg * 128 + c0;
                        const f32x4 w0 = *(const LAS f32x4*)wp, w1 = *(const LAS f32x4*)(wp + 4), w2 = *(const LAS f32x4*)(wp + 8), w3 = *(const LAS f32x4*)(wp + 12);
                        float (&d)[16] = qkv[seg];
                        d[0] += w0.x * bflo(x0.x); d[1] += w0.y * bfhi(x0.x); d[2] += w0.z * bflo(x0.y); d[3] += w0.w * bfhi(x0.y);
                        d[4] += w1.x * bflo(x0.z); d[5] += w1.y * bfhi(x0.z); d[6] += w1.z * bflo(x0.w); d[7] += w1.w * bfhi(x0.w);
                        d[8] += w2.x * bflo(x1.x); d[9] += w2.y * bfhi(x1.x); d[10] += w2.z * bflo(x1.y); d[11] += w2.w * bfhi(x1.y);
                        d[12] += w3.x * bflo(x1.z); d[13] += w3.y * bfhi(x1.z); d[14] += w3.z * bflo(x1.w); d[15] += w3.w * bfhi(x1.w);
                    }
                }
            }
            float (&q)[16] = qkv[0]; float (&k)[16] = qkv[1]; float (&v)[16] = qkv[2];
            float sq = 0.f, sk = 0.f;
#pragma unroll
            for (int c = 0; c < 16; ++c) { q[c] = siluf_(q[c]); k[c] = siluf_(k[c]); v[c] = siluf_(v[c]); sq += q[c] * q[c]; sk += k[c] * k[c]; }
            sq += __shfl_xor(sq, 1); sk += __shfl_xor(sk, 1); sq += __shfl_xor(sq, 2); sk += __shfl_xor(sk, 2); sq += __shfl_xor(sq, 4); sk += __shfl_xor(sk, 4);
            const float rq = rsqrtf(sq + RMS_EPS) * 0.08838834764831845f, rk = rsqrtf(sk + RMS_EPS);
            const float gc = gcg[r * 4 + h];
            unsigned kb[8], vb[8];
#pragma unroll
            for (int c = 0; c < 8; ++c) { kb[c] = pg8::cvt_pk_bf16(k[2 * c] * rk, k[2 * c + 1] * rk); vb[c] = pg8::cvt_pk_bf16(v[2 * c], v[2 * c + 1]); }
            *(LAS u32x4*)(lds + G2_KR + tk * PKR + c0 * 2) = (u32x4){kb[0], kb[1], kb[2], kb[3]}; *(LAS u32x4*)(lds + G2_KR + tk * PKR + c0 * 2 + 16) = (u32x4){kb[4], kb[5], kb[6], kb[7]};
            {
                f32x4 a0 = {q[0] * rq, q[1] * rq, q[2] * rq, q[3] * rq}, a1 = {q[4] * rq, q[5] * rq, q[6] * rq, q[7] * rq}, a2 = {q[8] * rq, q[9] * rq, q[10] * rq, q[11] * rq}, a3 = {q[12] * rq, q[13] * rq, q[14] * rq, q[15] * rq};
                *(LAS u32x4*)(lds + G2_QS + tk * PKR + c0 * 2) = pack8(a0, a1); *(LAS u32x4*)(lds + G2_QS + tk * PKR + c0 * 2 + 16) = pack8(a2, a3);
            }
            {
                const int odd = tk & 1;
#pragma unroll
                for (int c = 0; c < 8; ++c) {
                    const unsigned pk_ = (unsigned)__shfl_xor((int)kb[c], 8), pv_ = (unsigned)__shfl_xor((int)vb[c], 8);
                    const unsigned wk = odd ? ((pk_ >> 16) | (kb[c] & 0xffff0000u)) : ((kb[c] & 0xffffu) | (pk_ << 16));
                    const unsigned wv = odd ? ((pv_ >> 16) | (vb[c] & 0xffff0000u)) : ((vb[c] & 0xffffu) | (pv_ << 16));
                    *(LAS unsigned*)(lds + G2_KT + (c0 + 2 * c + odd) * PKT + (tk & ~1) * 2) = wk;
                    *(LAS unsigned*)(lds + G2_VT + (c0 + 2 * c + odd) * PKT + (tk & ~1) * 2) = wv;
                }
            }
            if (cgp == 0) { gcs[tk] = gc; egc[tk] = __expf(gc); ekd[tk] = __expf(gcl - gc); }
        }
        const float gl = __expf(gcl);
        const bf16_t* tmu = (const bf16_t*)(a.ws + WS_TMU) + (((size_t)(b * 32 + n)) * 4 + h) * 4096; const bf16_t* tmw = (const bf16_t*)(a.ws + WS_TMW) + (((size_t)(b * 32 + n)) * 4 + h) * 4096;
        __syncthreads();
        {
            const int tj = wave & 3;
#pragma unroll
            for (int tt = 0; tt < 2; ++tt) {
                const int ti = 2 * (wave >> 2) + tt;
                f32x4 acc = {0.f, 0.f, 0.f, 0.f};
                if (ti >= tj) {
#pragma unroll
                    for (int ks = 0; ks < 4; ++ks) acc = MFMA16(LDSF(G2_KR + (tj * 16 + fr) * PKR + ks * 64 + fq * 16), LDSF(G2_QS + (ti * 16 + fr) * PKR + ks * 64 + fq * 16), acc);
                }
                const int i = ti * 16 + fr; const float gci = gcs[i];
                f32x4 o;
#pragma unroll
                for (int rg = 0; rg < 4; ++rg) { const int j = tj * 16 + 4 * fq + rg; o[rg] = (i >= j) ? acc[rg] * __expf(gci - gcs[j]) : 0.f; }
                st8(lds + G2_QK + i * PKT + (tj * 16 + 4 * fq) * 2, o);
            }
        }
        {
            const bf16x8 A0 = LDSF(G2_KT + (wave * 16 + fr) * PKT + fq * 16), A1 = LDSF(G2_KT + (wave * 16 + fr) * PKT + 64 + fq * 16);
#pragma unroll
            for (int it = 0; it < 4; ++it) {
#if GDN_EXP == 4
                bf16x8 B0, B1;
                { const bf16x8 u0 = *(const bf16x8*)(tmu + (it * 16 + fr) * 64 + 8 * fq), u1 = *(const bf16x8*)(tmu + (it * 16 + fr) * 64 + 32 + 8 * fq);
#pragma unroll
                  for (int e = 0; e < 8; ++e) { B0[e] = (short)f2bf(bf2f((unsigned short)u0[e]) * egc[8 * fq + e]); B1[e] = (short)f2bf(bf2f((unsigned short)u1[e]) * egc[32 + 8 * fq + e]); } }
#else
                const bf16x8 B0 = *(const bf16x8*)(tmw + (it * 16 + fr) * 64 + 8 * fq), B1 = *(const bf16x8*)(tmw + (it * 16 + fr) * 64 + 32 + 8 * fq);
#endif
                f32x4 acc = {0.f, 0.f, 0.f, 0.f};
                acc = MFMA16(A0, B0, acc); acc = MFMA16(A1, B1, acc);
                st8(lds + G2_WN + (it * 16 + fr) * PKR + (wave * 16 + 4 * fq) * 2, -acc);
            }
        }
        __syncthreads();
        f32x4 vn[4];
        {
            bf16x8 Bv[2], Bs[4];
#pragma unroll
            for (int ks = 0; ks < 2; ++ks) Bv[ks] = LDSF(G2_VT + (wave * 16 + fr) * PKT + ks * 64 + fq * 16);
#pragma unroll
            for (int ks = 0; ks < 4; ++ks) Bs[ks] = LDSF(G2_ST + (wave * 16 + fr) * PKR + ks * 64 + fq * 16);
#pragma unroll
            for (int it = 0; it < 4; ++it) {
                f32x4 acc = {0.f, 0.f, 0.f, 0.f};
#pragma unroll
                for (int ks = 0; ks < 2; ++ks) acc = MFMA16(*(const bf16x8*)(tmu + (it * 16 + fr) * 64 + ks * 32 + 8 * fq), Bv[ks], acc);
#pragma unroll
                for (int ks = 0; ks < 4; ++ks) { if (GDN_EXP != 7) acc = MFMA16(LDSF(G2_WN + (it * 16 + fr) * PKR + ks * 64 + fq * 16), Bs[ks], acc); }
                vn[it] = acc;
            }
        }
        __syncthreads();
#pragma unroll
        for (int it = 0; it < 4; ++it) {
            st8(lds + G2_VN + (wave * 16 + fr) * PKT + (it * 16 + 4 * fq) * 2, vn[it]);
            const f32x4 e4 = *(const LAS f32x4*)(ekd + it * 16 + 4 * fq);
            st8(lds + G2_VT + (wave * 16 + fr) * PKT + (it * 16 + 4 * fq) * 2, vn[it] * e4);
        }
        __syncthreads();
        {
            const int it = wave & 3, dq = 4 * (wave >> 2);
            const size_t tok = tok0 + it * 16 + fr;
            u32x2 gt[4];
#pragma unroll
            for (int x = 0; x < 4; ++x) gt[x] = *(const u32x2*)(gateB + tok * 512 + h * 128 + (dq + x) * 16 + 4 * fq);
            bf16x8 Bq[4], Bk[2];
#pragma unroll
            for (int ks = 0; ks < 4; ++ks) Bq[ks] = LDSF(G2_QS + (it * 16 + fr) * PKR + ks * 64 + fq * 16);
#pragma unroll
            for (int ks = 0; ks < 2; ++ks) Bk[ks] = LDSF(G2_QK + (it * 16 + fr) * PKT + ks * 64 + fq * 16);
            const float eg = egc[it * 16 + fr];
            f32x4 O[4]; float ss = 0.f;
#pragma unroll
            for (int x = 0; x < 4; ++x) {
                f32x4 acc = {0.f, 0.f, 0.f, 0.f};
#pragma unroll
                for (int ks = 0; ks < 4; ++ks) { if (GDN_EXP != 8) acc = MFMA16(LDSF(G2_ST + ((dq + x) * 16 + fr) * PKR + ks * 64 + fq * 16), Bq[ks], acc); }
                acc = acc * eg;
#pragma unroll
                for (int ks = 0; ks < 2; ++ks) acc = MFMA16(LDSF(G2_VN + ((dq + x) * 16 + fr) * PKT + ks * 64 + fq * 16), Bk[ks], acc);
                O[x] = acc; ss += (acc.x * acc.x + acc.y * acc.y) + (acc.z * acc.z + acc.w * acc.w);
            }
            ss += __shfl_xor(ss, 16); ss += __shfl_xor(ss, 32);
            if (fq == 0) red[(wave >> 2) * 64 + it * 16 + fr] = ss;
            {
                const bf16x8 A0 = LDSF(G2_KT + (wave * 16 + fr) * PKT + fq * 16), A1 = LDSF(G2_KT + (wave * 16 + fr) * PKT + 64 + fq * 16);
#pragma unroll
                for (int dv = 0; dv < 8; ++dv) {
                    f32x4 acc = Sacc[dv] * gl;
#if GDN_EXP == 1
                    acc = acc * 0.f; Sacc[dv] = acc; continue;
#endif
                    acc = MFMA16(A0, LDSF(G2_VT + (dv * 16 + fr) * PKT + fq * 16), acc);
                    acc = MFMA16(A1, LDSF(G2_VT + (dv * 16 + fr) * PKT + 64 + fq * 16), acc);
                    Sacc[dv] = acc;
                }
            }
            __syncthreads();
            const float tot = red[it * 16 + fr] + red[64 + it * 16 + fr];
            const float rstd = rsqrtf(tot * (1.0f / 128.0f) + RMS_EPS);
#pragma unroll
            for (int x = 0; x < 4; ++x) {
                const f32x4 g4 = *(const LAS f32x4*)(ng + (dq + x) * 16 + 4 * fq);
                const float t0 = bflo(gt[x].x), t1 = bfhi(gt[x].x), t2 = bflo(gt[x].y), t3 = bfhi(gt[x].y);
                f32x4 o = O[x] * rstd * g4; o.x *= t0 * fsig(t0); o.y *= t1 * fsig(t1); o.z *= t2 * fsig(t2); o.w *= t3 * fsig(t3);
                u32x2 w; w.x = pg8::cvt_pk_bf16(o.x, o.y); w.y = pg8::cvt_pk_bf16(o.z, o.w);
                *(u32x2*)(oB + tok * 512 + h * 128 + (dq + x) * 16 + 4 * fq) = w;
            }
#pragma unroll
            for (int dv = 0; dv < 8; ++dv) st8(lds + G2_ST + (dv * 16 + fr) * PKR + (wave * 16 + 4 * fq) * 2, Sacc[dv]);
        }
        __syncthreads();
    }
}


constexpr int CW_ATTQ = 65536;
__device__ __forceinline__ void phase_pre(const Args& a, LAS unsigned char* lds, int layer, int gw, int NGW, int wave, int lane, int tid, int G) {
    gdn_pre_stage(a, lds, layer, tid);
    for (int item = blockIdx.x; item < BATCH * NCH; item += G) gdn_pre_item(a, lds, layer, item, wave, lane, tid);
    phase_pool(a, gw, NGW, lane);
}
__device__ __forceinline__ void phase_mix(const Args& a, LAS unsigned char* lds, int layer, int wave, int lane, int tid, int G) {
#if !GDN_TEST || GDN_TEST == 3
    if (GDN_TEST == 0 || layer == 0) for (int item = blockIdx.x; item < BATCH * B_HEADS; item += G) gdn_scan_item(a, lds, layer, item, wave, lane, tid);
#endif
    __syncthreads();
    attn_stage_bias(a, lds, layer, tid);
    const LAS float* rb = (const LAS float*)lds;
#if ATT_QUEUE
    LAS int* qslot = (LAS int*)(lds + 16384);
    unsigned* qctr = (unsigned*)(a.ws + WS_CTL) + CW_ATTQ + layer * 64;
    constexpr int NGRP = BATCH * A_HEADS * NCH / 4;
    for (;;) {
        if (tid == 0) *qslot = (int)__hip_atomic_fetch_add(qctr, 1u, __ATOMIC_RELAXED, __HIP_MEMORY_SCOPE_AGENT);
        __syncthreads();
        const int grp = *qslot;
        __syncthreads();
        if (grp >= NGRP) break;
        attn_item(a, rb, grp * 8 + wave, lane);
    }
#else
    constexpr int NGRP = BATCH * A_HEADS * NCH / 4;
    const int per = (NGRP + G - 1) / G;
    for (int gi = 0; gi < per; ++gi) { const int grp = blockIdx.x * per + gi; if (grp >= NGRP) break; attn_item(a, rb, grp * 8 + wave, lane); }
    __syncthreads();
#endif
}

__global__ void __launch_bounds__(NTHR, 2) mk(Args a) {
    extern __shared__ __attribute__((aligned(16))) unsigned char lds_raw[];
    LAS unsigned char* lds = (LAS unsigned char*)lds_raw;
    const int tid = threadIdx.x, lane = tid & 63, wave = __builtin_amdgcn_readfirstlane(tid >> 6);
    const int G = gridDim.x, gw = blockIdx.x * NWAVES + wave, NGW = G * NWAVES, gtid = blockIdx.x * NTHR + tid, GT = G * NTHR;
    const int layer = a.layer;
#define IN(k) (a.ph_lo <= (k) && (k) < a.ph_hi)
    if (IN(PH_CONVERT)) { phase_convert(a, lds, layer, gw, NGW, wave, lane, tid, gtid, GT); if (layer == 0) { __syncthreads(); phase_xconv(a, lds, gw, NGW, lane, tid); } }
    if (IN(PH_PROJ1)) phase_g_proj1(a, lds, G, (int)blockIdx.x);
#if FAST_MASK & 128
    if (IN(PH_PRE)) phase_pre(a, lds, layer, gw, NGW, wave, lane, tid, G);
    if (IN(PH_MIX)) phase_mix(a, lds, layer, wave, lane, tid, G);
#else
    if (IN(PH_PRE)) phase_pool(a, gw, NGW, lane);
    if (IN(PH_MIX)) phase_attn(a, lds, layer, wave, lane, tid, G);
#endif
    if (IN(PH_GATES)) phase_g_gates(a, lds, layer, G, (int)blockIdx.x);
    if (IN(PH_BRANCH)) phase_g_branch(a, lds, G, (int)blockIdx.x);
    if (IN(PH_OUT)) phase_g_out(a, lds, G, (int)blockIdx.x);
    if (IN(PH_LN1)) phase_ln1(a, layer, gw, NGW, lane);
    if (IN(PH_SLOTS)) phase_slots(a, lds, gw, NGW, wave, lane, tid);
    if (IN(PH_MOE1)) phase_moe1(a, lds, G, (int)blockIdx.x, tid);
    if (IN(PH_MOE2)) phase_moe2(a, lds, G, (int)blockIdx.x, tid);
    if (IN(PH_LN2)) phase_ln2(a, lds, layer, gw, NGW, lane, tid);
#undef IN
}

template <class Epi, int MODE> __global__ void __launch_bounds__(256) k_gemm_naive(const bf16_t* A, const bf16_t* Bt, int K, int NE, Epi E, const int* blk_e) {
    const int lane = threadIdx.x & 63, wave = threadIdx.x >> 6;
    const int row0 = blockIdx.y * 64 + wave * 16, col0 = blockIdx.x * 64;
    size_t brow = col0;
    if (MODE != 0) { const int nblk = blk_e[1023]; const int b = (blockIdx.y * 64) / MOE_BLOCK; if (b >= nblk) return; const int e = blk_e[b];
        if (MODE == 1) brow = (size_t)e * NE + col0; else brow = (size_t)e * NE + (col0 / 128) * 256 + (col0 % 128); }
    f32x4 acc[4], acc2[4];
#pragma unroll
    for (int n = 0; n < 4; ++n) { acc[n] = (f32x4){0.f, 0.f, 0.f, 0.f}; acc2[n] = (f32x4){0.f, 0.f, 0.f, 0.f}; }
    const bf16_t* ap = A + (size_t)(row0 + (lane & 15)) * K + 8 * (lane >> 4);
    const bf16_t* bp = Bt + (brow + (lane & 15)) * K + 8 * (lane >> 4);
    for (int k0 = 0; k0 < K; k0 += 32) {
        const bf16x8 af = *(const bf16x8*)(ap + k0);
#pragma unroll
        for (int n = 0; n < 4; ++n) {
            const bf16x8 bf = *(const bf16x8*)(bp + (size_t)n * 16 * K + k0);
            acc[n] = __builtin_amdgcn_mfma_f32_16x16x32_bf16(bf, af, acc[n], 0, 0, 0);
            if (MODE == 2) { const bf16x8 bf2 = *(const bf16x8*)(bp + (size_t)(n * 16 + 128) * K + k0); acc2[n] = __builtin_amdgcn_mfma_f32_16x16x32_bf16(bf2, af, acc2[n], 0, 0, 0); }
        }
    }
    const int row = row0 + (lane & 15);
#pragma unroll
    for (int n = 0; n < 4; ++n) { const int col = col0 + n * 16 + 4 * (lane >> 4); if (MODE == 2) E.pair(row, col, acc[n], acc2[n]); else E(row, col, acc[n]); }
}
__device__ __forceinline__ void st_bf16x4(bf16_t* p, f32x4 v) { u32x2 w; w.x = pk2(v.x, v.y); w.y = pk2(v.z, v.w); *(u32x2*)p = w; }
struct EpiProj1 { unsigned char* ws;
    __device__ __forceinline__ void operator()(int row, int col, f32x4 v) const {
        bf16_t* p;
        if (col < 512) p = (bf16_t*)(ws + WS_QA) + (size_t)row * 512 + col;
        else if (col < 1024) p = (bf16_t*)(ws + WS_KA) + (size_t)row * 512 + (col - 512);
        else if (col < 2560) p = (bf16_t*)(ws + WS_QKVB) + (size_t)row * 1536 + (col - 1024);
        else if (col < 3072) p = (bf16_t*)(ws + WS_GATEB) + (size_t)row * 512 + (col - 2560);
        else p = (bf16_t*)(ws + WS_POOL) + (size_t)row * 512 + (col - 3072);
        st_bf16x4(p, v); }
    __device__ __forceinline__ void pair(int, int, f32x4, f32x4) const {} };
struct EpiBf16Plain { bf16_t* O; int ldc, pad;
    __device__ __forceinline__ void operator()(int row, int col, f32x4 v) const { st_bf16x4(O + (size_t)row * ldc + col, v); }
    __device__ __forceinline__ void pair(int, int, f32x4, f32x4) const {} };
struct EpiGates { bf16_t* O; const float* gb;
    __device__ __forceinline__ void operator()(int row, int col, f32x4 v) const { const f32x4 b = *(const f32x4*)(gb + col);
        f32x4 r; r.x = sigmoidf_(v.x + b.x); r.y = sigmoidf_(v.y + b.y); r.z = sigmoidf_(v.z + b.z); r.w = sigmoidf_(v.w + b.w); st_bf16x4(O + (size_t)row * 3072 + col, r); }
    __device__ __forceinline__ void pair(int, int, f32x4, f32x4) const {} };
struct EpiBranch { bf16_t* Y; const bf16_t* gates; int which, pad;
    __device__ __forceinline__ void operator()(int row, int col, f32x4 v) const {
        const u32x2 g = *(const u32x2*)(gates + (size_t)row * 3072 + which * 1024 + col);
        f32x4 r; r.x = bflo(g.x) * v.x; r.y = bfhi(g.x) * v.y; r.z = bflo(g.y) * v.z; r.w = bfhi(g.y) * v.w;
        bf16_t* yp = Y + (size_t)row * 1024 + col;
        if (which > 0) { const u32x2 o = *(const u32x2*)yp; r.x += bflo(o.x); r.y += bfhi(o.x); r.z += bflo(o.y); r.w += bfhi(o.y); }
        st_bf16x4(yp, r); }
    __device__ __forceinline__ void pair(int, int, f32x4, f32x4) const {} };
struct EpiF32Plain { float* O; int ldc, pad;
    __device__ __forceinline__ void operator()(int row, int col, f32x4 v) const { *(f32x4*)(O + (size_t)row * ldc + col) = v; }
    __device__ __forceinline__ void pair(int, int, f32x4, f32x4) const {} };
struct EpiHdn { bf16_t* H;
    __device__ __forceinline__ void operator()(int, int, f32x4) const {}
    __device__ __forceinline__ void pair(int row, int col, f32x4 x, f32x4 y) const { f32x4 r; r.x = siluf_(x.x) * y.x; r.y = siluf_(x.y) * y.y; r.z = siluf_(x.z) * y.z; r.w = siluf_(x.w) * y.w; st_bf16x4(H + (size_t)row * 512 + col, r); } };

__global__ void __launch_bounds__(64) k_attn_naive(const bf16_t* qA, const bf16_t* kA, const bf16_t* vT, const float* relb, bf16_t* oA) {
    const int h = blockIdx.x & 7, ci = (blockIdx.x >> 3) & 31, b = blockIdx.x >> 8, r = threadIdx.x;
    const size_t tok = (size_t)b * SEQ + ci * CHUNK + r;
    float q[64], o[64];
#pragma unroll
    for (int d = 0; d < 64; ++d) { q[d] = bf2f(qA[tok * 512 + h * 64 + d]); o[d] = 0.f; }
    float mx = -3.0e38f, l = 0.f;
    for (int m = 0; m < A_BAND; ++m) {
        const int kp = ci * CHUNK - 512 + m; if (kp < 0) continue;
        const size_t kt = (size_t)b * SEQ + kp;
        float s = 0.f;
#pragma unroll
        for (int d = 0; d < 64; ++d) s += q[d] * bf2f(kA[kt * 512 + h * 64 + d]);
        int dist = r + 512 - m; dist = dist < -63 ? -63 : (dist > A_CLIP ? A_CLIP : dist);
        s = s * 0.125f + relb[h * A_NREL + dist + 63];
        const float nm = fmaxf(mx, s), sc = expf(mx - nm), p = expf(s - nm);
        l = l * sc + p; mx = nm;
#pragma unroll
        for (int d = 0; d < 64; ++d) o[d] = o[d] * sc + p * bf2f(vT[(size_t)(h * 64 + d) * T + kt]);
    }
    const float inv = 1.0f / l;
#pragma unroll
    for (int d = 0; d < 64; ++d) oA[tok * 512 + h * 64 + d] = (bf16_t)f2bf(o[d] * inv);
}

__global__ void __launch_bounds__(128) k_gdn_naive(const bf16_t* qkvB, const float* bdl, const bf16_t* gateB, const float* convw, const float* a_log, const float* dt_bias, const float* norm_g, bf16_t* oB) {
    __shared__ float sk[128], sq[128], red[8];
    const int b = blockIdx.x >> 2, h = blockIdx.x & 3, j = threadIdx.x, wv = j >> 6, lane = j & 63;
    float S[128];
#pragma unroll
    for (int k = 0; k < 128; ++k) S[k] = 0.f;
    const int cq = h * 128 + j, ck = 512 + cq, cv = 1024 + cq;
    float wq[4], wk[4], wvv[4];
#pragma unroll
    for (int i = 0; i < 4; ++i) { wq[i] = convw[i * 1536 + cq]; wk[i] = convw[i * 1536 + ck]; wvv[i] = convw[i * 1536 + cv]; }
    float hq[3] = {0.f, 0.f, 0.f}, hk[3] = {0.f, 0.f, 0.f}, hv[3] = {0.f, 0.f, 0.f};
    const float Aexp = expf(a_log[h]), dtb = dt_bias[h], ng = norm_g[j];
    for (int t = 0; t < SEQ; ++t) {
        const size_t row = (size_t)b * SEQ + t;
        const float rq = bf2f(qkvB[row * 1536 + cq]), rk = bf2f(qkvB[row * 1536 + ck]), rv = bf2f(qkvB[row * 1536 + cv]);
        float q = wq[0] * hq[0] + wq[1] * hq[1] + wq[2] * hq[2] + wq[3] * rq;
        float k = wk[0] * hk[0] + wk[1] * hk[1] + wk[2] * hk[2] + wk[3] * rk;
        float v = wvv[0] * hv[0] + wvv[1] * hv[1] + wvv[2] * hv[2] + wvv[3] * rv;
        hq[0] = hq[1]; hq[1] = hq[2]; hq[2] = rq; hk[0] = hk[1]; hk[1] = hk[2]; hk[2] = rk; hv[0] = hv[1]; hv[1] = hv[2]; hv[2] = rv;
        q = siluf_(q); k = siluf_(k); v = siluf_(v);
        const float sq2 = wave_sum(q * q), sk2 = wave_sum(k * k);
        if (lane == 0) { red[wv] = sq2; red[2 + wv] = sk2; }
        __syncthreads();
        const float nq = red[0] + red[1], nk = red[2] + red[3];
        q = q * rsqrtf(nq + RMS_EPS) * 0.08838834764831845f; k = k * rsqrtf(nk + RMS_EPS);
        sk[j] = k; sq[j] = q;
        const float beta = sigmoidf_(bdl[row * 8 + h]);
        const float g = -Aexp * softplusf_(bdl[row * 8 + 4 + h] + dtb), aa = expf(g);
        __syncthreads();
        float dot = 0.f;
#pragma unroll
        for (int kk = 0; kk < 128; ++kk) dot += sk[kk] * S[kk];
        const float coef = beta * (v - aa * dot);
        float o = 0.f;
#pragma unroll
        for (int kk = 0; kk < 128; ++kk) { S[kk] = aa * S[kk] + sk[kk] * coef; o += sq[kk] * S[kk]; }
        const float so = wave_sum(o * o);
        if (lane == 0) red[4 + wv] = so;
        __syncthreads();
        const float ms = (red[4] + red[5]) * (1.0f / 128.0f);
        const float gt = bf2f(gateB[row * 512 + h * 128 + j]);
        oB[row * 512 + h * 128 + j] = (bf16_t)f2bf(o * rsqrtf(ms + RMS_EPS) * ng * siluf_(gt));
    }
}


#if GDN_TEST == 2
__global__ void k_tm_checksum(const bf16_t* tmu, const bf16_t* tmw, const float* gc, bf16_t* oB) {
    const int ih = blockIdx.x;
    const int item = ih >> 2, h = ih & 3, b = item >> 5, n = item & 31, lane = threadIdx.x;
    float s = 0.f;
    for (int i = lane; i < 4096; i += 64) s += bf2f(tmu[(size_t)ih * 4096 + i]) + 0.5f * bf2f(tmw[(size_t)ih * 4096 + i]);
    s += gc[((size_t)b * SEQ + n * 64 + lane) * 4 + h];
    s = wave_sum(s);
    if (lane == 0) { bf16_t* p = oB + ((size_t)b * SEQ + n * 64) * 512 + h * 128; *p = (bf16_t)f2bf(bf2f(*p) + 1e-3f * s); }
}
#endif

#if GDN_TEST == 3
constexpr int CW_DIAG = 131072;
__global__ void k_cmp(const bf16_t* ref, const bf16_t* alt, unsigned* ctl) {
    const int bhn = blockIdx.x, n = bhn & 31, h = (bhn >> 5) & 3, b = bhn >> 7, lane = threadIdx.x;
    float sd = 0.f, sr = 0.f;
    for (int t = 0; t < 64; ++t) { const size_t o = ((size_t)b * SEQ + n * 64 + t) * 512 + h * 128;
        for (int c = lane; c < 128; c += 64) { const float r = bf2f(ref[o + c]), x = bf2f(alt[o + c]); float d = x - r; if (!(d == d)) d = 1e10f; sd += d * d; sr += r * r; } }
    sd = wave_sum(sd); sr = wave_sum(sr);
    if (lane == 0) { const float rel = sqrtf(sd / (sr + 1e-20f)); atomicMax(ctl + CW_DIAG + n, __float_as_uint(rel)); }
}
__global__ void k_encode(float* out, const unsigned* ctl) {
    float r0 = __uint_as_float(ctl[CW_DIAG + DIAG_N]); r0 = r0 > 3.f ? 3.f : r0;
    const float c = 1.0f + r0;
    for (size_t i = (size_t)blockIdx.x * blockDim.x + threadIdx.x; i < (size_t)T * D; i += (size_t)gridDim.x * blockDim.x) out[i] *= c;
}
#endif
extern "C" void kernel_launch(void* const* d_in, const int* in_sizes, int n_in, void* d_out, int out_size, void* d_ws, size_t ws_size, hipStream_t stream) {
    static int grid = 0;
    if (grid == 0) {
        if (n_in != 25 || in_sizes[0] != T * D || out_size != T * D || ws_size < WS_END) { fprintf(stderr, "kernel_launch: unexpected shapes (n_in %d, in0 %d, out %d, ws %zu < %zu)\n", n_in, n_in > 0 ? in_sizes[0] : -1, out_size, ws_size, (size_t)WS_END); grid = -1; return; }
        int dev = 0, cus = 0;
        if (hipGetDevice(&dev) != hipSuccess || hipDeviceGetAttribute(&cus, hipDeviceAttributeMultiprocessorCount, dev) != hipSuccess) { grid = -1; return; }
        if (hipFuncSetAttribute((const void*)mk, hipFuncAttributeMaxDynamicSharedMemorySize, LDS_BYTES) != hipSuccess) { fprintf(stderr, "kernel_launch: hipFuncSetAttribute failed\n"); grid = -1; return; }
        grid = cus;
    }
    if (grid < 0) return;
    unsigned char* ws = (unsigned char*)d_ws;
    (void)hipMemsetAsync(ws + WS_CTL, 0, 1 * MiB, stream);
#if GDN_EXP == 5
    (void)hipMemsetAsync(ws + WS_TMU, 0, 64 * MiB, stream); (void)hipMemsetAsync(ws + WS_SM, 0, 5 * MiB, stream);
#endif
    Args a{};
    for (int i = 0; i < 25; ++i) a.in[i] = (const float*)d_in[i];
    a.out = (float*)d_out; a.ws = ws;
    auto run = [&](int layer, int ph) { a.layer = layer; a.ph_lo = ph; a.ph_hi = ph + 1; hipLaunchKernelGGL(mk, dim3(grid), dim3(NTHR), LDS_BYTES, stream, a); };
    const bf16_t* XB = (const bf16_t*)(ws + WS_XB);
    int* blk_e = (int*)(ws + WS_BLKE);
    for (int layer = 0; layer < DEPTH; ++layer) {
        run(layer, PH_CONVERT);
#if FAST_MASK & 1
        run(layer, PH_PROJ1);
#else
        hipLaunchKernelGGL((k_gemm_naive<EpiProj1, 0>), dim3(N1 / 64, T / 64), dim3(256), 0, stream, XB, (const bf16_t*)(ws + WS_WIN1), 1024, 0, EpiProj1{ws}, (const int*)nullptr);
        hipLaunchKernelGGL((k_gemm_naive<EpiBf16Plain, 0>), dim3(T / 64, 512 / 64), dim3(256), 0, stream, (const bf16_t*)(ws + WS_WV), XB, 1024, 0, EpiBf16Plain{(bf16_t*)(ws + WS_VT), T, 0}, (const int*)nullptr);
#endif
#if FAST_MASK & 128
        run(layer, PH_PRE);
        run(layer, PH_MIX);
#if GDN_TEST
        hipLaunchKernelGGL(k_gdn_naive, dim3(BATCH * B_HEADS), dim3(128), 0, stream, (const bf16_t*)(ws + WS_QKVB), (const float*)(ws + WS_BDL), (const bf16_t*)(ws + WS_GATEB), (const float*)d_in[3] + (size_t)layer * 4 * 1536,
                           (const float*)d_in[4] + layer * 4, (const float*)d_in[5] + layer * 4, (const float*)d_in[6] + layer * 128, (bf16_t*)(ws + WS_OB));
#if GDN_TEST == 3
        if (layer == 0) hipLaunchKernelGGL(k_cmp, dim3(4096), dim3(64), 0, stream, (const bf16_t*)(ws + WS_OB), (const bf16_t*)d_out, (unsigned*)(ws + WS_CTL));
#endif
#if GDN_TEST == 2
        hipLaunchKernelGGL(k_tm_checksum, dim3(4096), dim3(64), 0, stream, (const bf16_t*)(ws + WS_TMU), (const bf16_t*)(ws + WS_TMW), (const float*)(ws + WS_GC), (bf16_t*)(ws + WS_OB));
#endif
#endif
#else
#if FAST_MASK & 64
        run(layer, PH_MIX);
#else
        hipLaunchKernelGGL(k_attn_naive, dim3(BATCH * NCH * A_HEADS), dim3(64), 0, stream, (const bf16_t*)(ws + WS_QA), (const bf16_t*)(ws + WS_KA), (const bf16_t*)(ws + WS_VT), (const float*)d_in[2] + (size_t)layer * A_HEADS * A_NREL, (bf16_t*)(ws + WS_OA));
#endif
        hipLaunchKernelGGL(k_gdn_naive, dim3(BATCH * B_HEADS), dim3(128), 0, stream, (const bf16_t*)(ws + WS_QKVB), (const float*)(ws + WS_BDL), (const bf16_t*)(ws + WS_GATEB), (const float*)d_in[3] + (size_t)layer * 4 * 1536,
                           (const float*)d_in[4] + layer * 4, (const float*)d_in[5] + layer * 4, (const float*)d_in[6] + layer * 128, (bf16_t*)(ws + WS_OB));
        run(layer, PH_PRE);
#endif
#if FAST_MASK & 2
        run(layer, PH_GATES);
#else
        hipLaunchKernelGGL((k_gemm_naive<EpiGates, 0>), dim3(3072 / 64, T / 64), dim3(256), 0, stream, XB, (const bf16_t*)(ws + WS_WG), 1024, 0, EpiGates{(bf16_t*)(ws + WS_GATES), (const float*)d_in[12] + (size_t)layer * 3072}, (const int*)nullptr);
#endif
#if FAST_MASK & 4
        run(layer, PH_BRANCH);
#else
        for (int i = 0; i < 3; ++i) {
            const bf16_t* Ai = (const bf16_t*)(ws + (i == 0 ? WS_OA : (i == 1 ? WS_OB : WS_PLD)));
            hipLaunchKernelGGL((k_gemm_naive<EpiBranch, 0>), dim3(1024 / 64, T / 64), dim3(256), 0, stream, Ai, (const bf16_t*)(ws + WS_WBR) + (size_t)i * 1024 * 512, 512, 0, EpiBranch{(bf16_t*)(ws + WS_Y), (const bf16_t*)(ws + WS_GATES), i, 0}, (const int*)nullptr);
        }
#endif
#if FAST_MASK & 8
        run(layer, PH_OUT);
#else
        hipLaunchKernelGGL((k_gemm_naive<EpiF32Plain, 0>), dim3(1024 / 64, T / 64), dim3(256), 0, stream, (const bf16_t*)(ws + WS_Y), (const bf16_t*)(ws + WS_WOUT), 1024, 0, EpiF32Plain{(float*)(ws + WS_MIX), 1024, 0}, (const int*)nullptr);
#endif
        run(layer, PH_LN1);
        run(layer, PH_SLOTS);
#if FAST_MASK & 16
        run(layer, PH_MOE1);
#else
        hipLaunchKernelGGL((k_gemm_naive<EpiHdn, 2>), dim3(512 / 64, CAP / 64), dim3(256), 0, stream, (const bf16_t*)(ws + WS_XG), (const bf16_t*)(ws + WS_W13), 1024, 1024, EpiHdn{(bf16_t*)(ws + WS_HDN)}, (const int*)blk_e);
#endif
#if FAST_MASK & 32
        run(layer, PH_MOE2);
#else
        hipLaunchKernelGGL((k_gemm_naive<EpiBf16Plain, 1>), dim3(1024 / 64, CAP / 64), dim3(256), 0, stream, (const bf16_t*)(ws + WS_HDN), (const bf16_t*)(ws + WS_W2), 512, 1024, EpiBf16Plain{(bf16_t*)(ws + WS_YMOE), 1024, 0}, (const int*)blk_e);
#endif
        run(layer, PH_LN2);
    }
#if GDN_TEST == 3
    hipLaunchKernelGGL(k_encode, dim3(1024), dim3(256), 0, stream, (float*)d_out, (const unsigned*)(ws + WS_CTL));
#endif
}
```

```cpp
#include <hip/hip_runtime.h>
#include <cstdio>
#include <cstdint>
#ifndef MK_N_LAUNCHES
#define MK_N_LAUNCHES 1
#endif

#define GAS __attribute__((address_space(1)))
#define LAS __attribute__((address_space(3)))
typedef unsigned short bf16_t;
typedef short bf16x8 __attribute__((ext_vector_type(8)));
typedef float f32x4 __attribute__((ext_vector_type(4)));
typedef float f32x2 __attribute__((ext_vector_type(2)));
typedef unsigned u32x4 __attribute__((ext_vector_type(4)));
typedef unsigned u32x2 __attribute__((ext_vector_type(2)));

namespace pg8 {
#define PG8_LAS __attribute__((address_space(3)))
typedef unsigned short bf16_t;
typedef short bf16x8 __attribute__((ext_vector_type(8)));
typedef float f32x4 __attribute__((ext_vector_type(4)));
typedef unsigned u32x4 __attribute__((ext_vector_type(4)));
constexpr int BM = 256, BK = 64, HALF = 128, HTB = HALF * BK * 2  , STAGE_BYTES = 8 * HTB, NXCD = 8, WGM = 8;

__host__ __device__ __forceinline__ int lds_byte(int r, int c) { const int st = (r >> 4) * 2 + (c >> 5), rr = r & 15, cc = c & 31, ob = rr * 64 + cc * 2; return st * 1024 + (ob ^ (((ob >> 9) & 1) << 5)); }
__host__ __device__ __forceinline__ void stage_rc(int b, int& R, int& C) { const int st = b / 1024, sb = b % 1024, swz = sb ^ (((sb >> 9) & 1) << 5); R = (st >> 1) * 16 + swz / 64; C = (st & 1) * 32 + (swz % 64) / 2; }
__host__ __device__ __forceinline__ int perm32(int rho) { const int n = rho >> 4, i = rho & 15; return 8 * (i >> 2) + 4 * n + (i & 3); }

struct Unit { int pm, pn; };
struct Gemm { const bf16_t* A; const bf16_t* Bt; int M, N, K; };

struct StaticOrder {
    int nM, nN, nwg, G, c;
    __host__ __device__ void init(int M, int N, int G_, int c_) { nM = M / BM; nN = N / BM; nwg = nM * nN; G = G_; c = c_; }
    __host__ __device__ bool next(int i, Unit& u) const {
        const long L = (long)i * G + c; if (L >= nwg) return false;
        int wgid = (int)L; { const int q = nwg / NXCD, r = nwg % NXCD, xcd = wgid % NXCD, off = wgid / NXCD; wgid = (xcd < r ? xcd * (q + 1) : r * (q + 1) + (xcd - r) * q) + off; }
        const int nig = WGM * nN, gid = wgid / nig, fm = gid * WGM, gsz = (nM - fm) < WGM ? (nM - fm) : WGM;
        u.pm = fm + ((wgid % nig) % gsz); u.pn = (wgid % nig) / gsz; return true;
    }
    __device__ __forceinline__ void a_ready(const Unit&) const {}
    __device__ __forceinline__ void done(const Unit&) const {}
};
typedef float f32x2_ __attribute__((ext_vector_type(2)));
typedef __bf16 bf16x2_ __attribute__((ext_vector_type(2)));
__device__ __forceinline__ unsigned cvt_pk_bf16(float lo, float hi) { const f32x2_ v = {lo, hi}; return __builtin_bit_cast(unsigned, __builtin_convertvector(v, bf16x2_)); }
template <class Epi, class Sched, bool ALIGN_EPI = false, bool SP2 = false>
__device__ __forceinline__ void gemm_phase(PG8_LAS unsigned char* lds, const Gemm g, const Sched& S, const Epi& E) {
    const int tid = threadIdx.x, wid = __builtin_amdgcn_readfirstlane(tid >> 6), lane = tid & 63, wr = wid >> 2, wc = wid & 3, fr = lane & 15, fq = lane >> 4;
    const int K = g.K, nt = K / BK;
    unsigned voffA[2], voffB[2];
#pragma unroll
    for (int i = 0; i < 2; ++i) { int R, C; stage_rc(tid * 16 + i * 8192, R, C); const int Rb = Epi::PERM ? ((R & ~31) + perm32(R & 31)) : R;
        voffA[i] = (unsigned)(R * K + C) * 2u; voffB[i] = (unsigned)(Rb * K + C) * 2u; }
    const size_t kstep = (size_t)(BK * 2);
    const size_t hstep = (size_t)HALF * K * 2;
    const size_t tstep = 2 * hstep;
    const unsigned ldsw = (unsigned)wid * 1024u;
    const int aoff = lds_byte(wr * 64 + fr, fq * 8), boff = lds_byte(wc * 32 + fr, fq * 8);
#define PG8_SA(b, h) (((b) * 2 + (h)) * HTB)
#define PG8_SB(b, h) ((4 + (b) * 2 + (h)) * HTB)
#define PG8_STAGE(bufoff, gbase, voff) do { _Pragma("unroll") for (int _i = 0; _i < 2; ++_i) \
        __builtin_amdgcn_global_load_lds((const unsigned*)((const char*)(gbase) + (voff)[_i]), (PG8_LAS unsigned*)(lds + (bufoff) + ldsw + _i * 8192), 16, 0, 0); } while (0)
#define PG8_LDA(dst, b, h) do { _Pragma("unroll") for (int m = 0; m < 4; ++m) _Pragma("unroll") for (int k = 0; k < 2; ++k) dst[m][k] = *(const PG8_LAS bf16x8*)(lds + PG8_SA(b, h) + aoff + m * 2048 + k * 1024); } while (0)
#define PG8_LDB(dst, b, h) do { _Pragma("unroll") for (int n = 0; n < 2; ++n) _Pragma("unroll") for (int k = 0; k < 2; ++k) dst[n][k] = *(const PG8_LAS bf16x8*)(lds + PG8_SB(b, h) + boff + n * 2048 + k * 1024); } while (0)
#define PG8_MMA(ai, bj, At, Bt) do { __builtin_amdgcn_s_setprio(1); _Pragma("unroll") for (int m = 0; m < 4; ++m) _Pragma("unroll") for (int n = 0; n < 2; ++n) _Pragma("unroll") for (int k = 0; k < 2; ++k) \
        acc[ai][bj][m][n] = __builtin_amdgcn_mfma_f32_16x16x32_bf16(Bt[n][k], At[m][k], acc[ai][bj][m][n], 0, 0, 0); __builtin_amdgcn_s_setprio(0); } while (0)
#define PG8_WAIT_V(n) asm volatile("s_waitcnt vmcnt(" #n ")" ::: "memory")
#define PG8_WAIT_L(n) asm volatile("s_waitcnt lgkmcnt(" #n ")" ::: "memory")
#define PG8_BAR __builtin_amdgcn_s_barrier()
#define PG8_SCHED __builtin_amdgcn_sched_barrier(0)
    Unit cur, nxt; int ui = 0;
    if (!S.next(0, cur)) return;
    f32x4 acc[2][2][4][2];
#pragma unroll
    for (int a = 0; a < 2; ++a)
#pragma unroll
        for (int b = 0; b < 2; ++b)
#pragma unroll
            for (int m = 0; m < 4; ++m)
#pragma unroll
                for (int n = 0; n < 2; ++n) acc[a][b][m][n] = (f32x4){0.f, 0.f, 0.f, 0.f};
    bf16x8 At[4][2], B0[2][2], B1[2][2];
    const char* cA = (const char*)g.A + (size_t)cur.pm * tstep; const char* cB = (const char*)g.Bt + (size_t)cur.pn * tstep;
    S.a_ready(cur);
    if constexpr (SP2) {
        PG8_STAGE(PG8_SB(0, 0), cB, voffB); PG8_STAGE(PG8_SB(0, 1), cB + hstep, voffB); PG8_STAGE(PG8_SA(0, 0), cA, voffA); PG8_STAGE(PG8_SA(0, 1), cA + hstep, voffA);
        if (wr == 1) PG8_BAR;
        PG8_WAIT_V(2); PG8_BAR;
        PG8_STAGE(PG8_SB(1, 0), cB + kstep, voffB); PG8_STAGE(PG8_SA(1, 0), cA + kstep, voffA); PG8_STAGE(PG8_SB(1, 1), cB + hstep + kstep, voffB);
        PG8_WAIT_V(6); PG8_BAR;
    } else {
        PG8_STAGE(PG8_SB(0, 0), cB, voffB); PG8_STAGE(PG8_SA(0, 0), cA, voffA); PG8_STAGE(PG8_SB(0, 1), cB + hstep, voffB); PG8_STAGE(PG8_SA(0, 1), cA + hstep, voffA);
        if (wr == 1) PG8_BAR;
        PG8_WAIT_V(4); PG8_BAR;
        PG8_STAGE(PG8_SB(1, 0), cB + kstep, voffB); PG8_STAGE(PG8_SA(1, 0), cA + kstep, voffA); PG8_STAGE(PG8_SB(1, 1), cB + hstep + kstep, voffB);
        PG8_WAIT_V(6); PG8_BAR;
    }
    for (;;) {
        const bool has_next = S.next(ui + 1, nxt);
        const char* nA = has_next ? (const char*)g.A + (size_t)nxt.pm * tstep : cA; const char* nB = has_next ? (const char*)g.Bt + (size_t)nxt.pn * tstep : cB;
        for (int t = 0; t < nt; t += 2) {
            const bool last = (t == nt - 2);
            const char* a1 = cA + (size_t)(t + 1) * kstep;
            const char* a2 = last ? nA : cA + (size_t)(t + 2) * kstep; const char* b2 = last ? nB : cB + (size_t)(t + 2) * kstep;
            const char* a3 = a2 + kstep; const char* b3 = b2 + kstep;
            if (last && has_next) S.a_ready(nxt);
            if constexpr (SP2) {
            PG8_LDB(B0, 0, 0); PG8_LDB(B1, 0, 1); PG8_SCHED; PG8_LDA(At, 0, 0); PG8_STAGE(PG8_SA(1, 1), a1 + hstep, voffA);
            PG8_WAIT_V(8); PG8_WAIT_L(0); PG8_BAR; PG8_MMA(0, 0, At, B0); PG8_MMA(0, 1, At, B1); PG8_BAR; PG8_SCHED;
            PG8_LDA(At, 0, 1); PG8_STAGE(PG8_SB(0, 0), b2, voffB); PG8_STAGE(PG8_SB(0, 1), b2 + hstep, voffB); PG8_STAGE(PG8_SA(0, 0), a2, voffA);
            PG8_WAIT_V(8); PG8_WAIT_L(0); PG8_BAR; PG8_MMA(1, 0, At, B0); PG8_MMA(1, 1, At, B1); PG8_BAR; PG8_SCHED;
            PG8_LDB(B0, 1, 0); PG8_LDB(B1, 1, 1); PG8_SCHED; PG8_LDA(At, 1, 0); PG8_STAGE(PG8_SA(0, 1), a2 + hstep, voffA);
            PG8_WAIT_V(8); PG8_WAIT_L(0); PG8_BAR; PG8_MMA(0, 0, At, B0); PG8_MMA(0, 1, At, B1); PG8_BAR; PG8_SCHED;
            PG8_LDA(At, 1, 1); PG8_STAGE(PG8_SB(1, 0), b3, voffB); PG8_STAGE(PG8_SB(1, 1), b3 + hstep, voffB); PG8_STAGE(PG8_SA(1, 0), a3, voffA);
            PG8_WAIT_V(8); PG8_WAIT_L(0); PG8_BAR; PG8_MMA(1, 0, At, B0); PG8_MMA(1, 1, At, B1); PG8_BAR; PG8_SCHED;
            } else {
            PG8_LDB(B0, 0, 0); PG8_SCHED; PG8_LDA(At, 0, 0); PG8_STAGE(PG8_SA(1, 1), a1 + hstep, voffA);
            PG8_WAIT_L(8); PG8_BAR; PG8_WAIT_L(0); PG8_MMA(0, 0, At, B0); PG8_BAR; PG8_SCHED;
            PG8_LDB(B1, 0, 1); PG8_STAGE(PG8_SB(0, 0), b2, voffB);
            PG8_BAR; PG8_WAIT_L(0); PG8_MMA(0, 1, At, B1); PG8_BAR;
            PG8_LDA(At, 0, 1); PG8_STAGE(PG8_SA(0, 0), a2, voffA);
            PG8_BAR; PG8_WAIT_L(0); PG8_MMA(1, 0, At, B0); PG8_BAR; PG8_SCHED;
            PG8_STAGE(PG8_SB(0, 1), b2 + hstep, voffB);
            PG8_WAIT_V(6); PG8_BAR; PG8_MMA(1, 1, At, B1); PG8_BAR;
            PG8_LDB(B0, 1, 0); PG8_SCHED; PG8_LDA(At, 1, 0); PG8_STAGE(PG8_SA(0, 1), a2 + hstep, voffA);
            PG8_WAIT_L(8); PG8_BAR; PG8_WAIT_L(0); PG8_MMA(0, 0, At, B0); PG8_BAR; PG8_SCHED;
            PG8_LDB(B1, 1, 1); PG8_STAGE(PG8_SB(1, 0), b3, voffB);
            PG8_BAR; PG8_WAIT_L(0); PG8_MMA(0, 1, At, B1); PG8_BAR;
            PG8_LDA(At, 1, 1); PG8_STAGE(PG8_SA(1, 0), a3, voffA);
            PG8_BAR; PG8_WAIT_L(0); PG8_MMA(1, 0, At, B0); PG8_BAR; PG8_SCHED;
            PG8_STAGE(PG8_SB(1, 1), b3 + hstep, voffB);
            PG8_WAIT_V(6); PG8_BAR; PG8_MMA(1, 1, At, B1); PG8_BAR;
            }
        }
        if constexpr (ALIGN_EPI) { if (wr == 0) PG8_BAR; }
        if constexpr (!Epi::AFTER_DRAIN) { E(acc, cur, wr, wc, fr, fq); S.done(cur); }
        if (!has_next) break;
#pragma unroll
        for (int a = 0; a < 2; ++a)
#pragma unroll
            for (int b = 0; b < 2; ++b)
#pragma unroll
                for (int m = 0; m < 4; ++m)
#pragma unroll
                    for (int n = 0; n < 2; ++n) acc[a][b][m][n] = (f32x4){0.f, 0.f, 0.f, 0.f};
        cur = nxt; cA = nA; cB = nB; ++ui;
        if constexpr (ALIGN_EPI) { if (wr == 1) PG8_BAR; }
    }
    PG8_WAIT_V(0);
    if constexpr (!ALIGN_EPI) { if (wr == 0) PG8_BAR; }
    PG8_BAR;
    if constexpr (Epi::AFTER_DRAIN) { E.fused(acc, cur, wr, wc, fr, fq, lds, wid, lane); S.done(cur); }
#undef PG8_SA
#undef PG8_SB
#undef PG8_STAGE
#undef PG8_LDA
#undef PG8_LDB
#undef PG8_MMA
#undef PG8_WAIT_V
#undef PG8_WAIT_L
#undef PG8_BAR
#undef PG8_SCHED
}
}

constexpr int BATCH = 32, SEQ = 2048, D = 1024, T = BATCH * SEQ, DEPTH = 2, CHUNK = 64, NCH = SEQ / CHUNK;
constexpr int A_HEADS = 8, A_HD = 64, A_W = 512, A_LEFT = 8, A_BAND = 576, A_CLIP = 256, A_NREL = 320;
constexpr int B_HEADS = 4, B_HD = 128, B_W = 512;
constexpr int C_W = 512;
constexpr int D_IN = 7176;
constexpr int OFF_QA = 0, OFF_KA = 512, OFF_VA = 1024, OFF_QKVB = 1536, OFF_BETA = 3072, OFF_DEC = 3076, OFF_GATEB = 3080, OFF_POOL = 3592, OFF_GATES = 4104;
constexpr int NEXP = 32, MOE_FF = 512, MOE_BLOCK = 256;
constexpr int NPAIR = 2 * T, NBLK_MAX = NPAIR / MOE_BLOCK + NEXP, CAP = NBLK_MAX * MOE_BLOCK;
constexpr float DN_ALPHA = 1.4142135623730951f;
constexpr float LN_EPS = 1e-5f, RMS_EPS = 1e-6f;
constexpr int N1 = 3584;

constexpr size_t MiB = 1ull << 20, U = 128 * MiB;
constexpr size_t WS_CTL = 0;
constexpr size_t WS_WIN1 = 1 * MiB, WS_WV = 8 * MiB, WS_WG = 9 * MiB, WS_WBR = 15 * MiB, WS_WOUT = 18 * MiB, WS_W13 = 20 * MiB, WS_W2 = 84 * MiB;
constexpr size_t WS_XB = U;
constexpr size_t WS_P = 2 * U;
constexpr size_t WS_QA = WS_P, WS_KA = WS_P + U / 2, WS_VT = WS_P + U, WS_QKVB = WS_P + 3 * U / 2, WS_GATEB = WS_P + 3 * U, WS_POOL = WS_P + 7 * U / 2;
constexpr size_t WS_OA = WS_P + 4 * U, WS_OB = WS_P + 9 * U / 2, WS_PLD = WS_P + 5 * U;
constexpr size_t WS_SM = 116 * MiB;
constexpr size_t WS_BDL = WS_SM, WS_EID = WS_SM + 2 * MiB, WS_WTS = WS_SM + 5 * MiB / 2, WS_SLOT = WS_SM + 3 * MiB, WS_HIST = WS_SM + 7 * MiB / 2, WS_BLKE = WS_SM + 15 * MiB / 4, WS_GC = WS_SM + 4 * MiB;
constexpr size_t WS_TMU = WS_P + 11 * U / 2, WS_TMW = WS_TMU + 32 * MiB;
constexpr size_t WS_GATES = WS_P, WS_Y = WS_P + 3 * U, WS_MIX = WS_P;
constexpr size_t WS_XG = WS_P, WS_HDN = WS_P + (size_t)CAP * 2048, WS_YMOE = WS_HDN + (size_t)CAP * 1024;
constexpr size_t WS_END = 8 * U;
static_assert(WS_YMOE + (size_t)CAP * 2048 <= WS_TMU, "moe buffers");
static_assert(WS_GC + 1 * MiB <= U, "small tables");
static_assert(WS_W2 + 32 * MiB <= U, "weights");

__device__ __forceinline__ unsigned f2bf(float f) { unsigned u = __builtin_bit_cast(unsigned, f); return (u + 0x7fffu + ((u >> 16) & 1u)) >> 16; }
__device__ __forceinline__ unsigned pk2(float lo, float hi) { return f2bf(lo) | (f2bf(hi) << 16); }
__device__ __forceinline__ float bf2f(unsigned short b) { return __builtin_bit_cast(float, ((unsigned)b) << 16); }
__device__ __forceinline__ float bflo(unsigned w) { return __builtin_bit_cast(float, w << 16); }
__device__ __forceinline__ float bfhi(unsigned w) { return __builtin_bit_cast(float, w & 0xffff0000u); }
__device__ __forceinline__ float wave_sum(float v) {
#pragma unroll
    for (int o = 1; o < 64; o <<= 1) v += __shfl_xor(v, o);
    return v;
}
__device__ __forceinline__ float sigmoidf_(float x) { return 1.0f / (1.0f + __expf(-x)); }
__device__ __forceinline__ float siluf_(float x) { return x / (1.0f + __expf(-x)); }
__device__ __forceinline__ float softplusf_(float x) { return x > 20.f ? x : log1pf(expf(x)); }

struct Args { const float* in[25]; float* out; unsigned char* ws; int lay_lo, lay_hi, ph_lo, ph_hi; };

enum Phase { PH_CONVERT = 0, PH_PROJ1 = 1, PH_PRE = 2, PH_MIX = 3, PH_GATES = 4, PH_BRANCH = 5, PH_OUT = 6, PH_LN1 = 7, PH_SLOTS = 8, PH_MOE1 = 9, PH_MOE2 = 10, PH_LN2 = 11, PH_COUNT = 12 };

constexpr int NWAVES = 8, NTHR = 512;
constexpr int LDS_BYTES = 163840;

__device__ __forceinline__ void transpose_item(const float* W, int ldw, int col0, int K, bf16_t* WT, int row0, LAS float* scr, int kb, int nb, int lane) {
    const int k0 = 64 * kb, n0 = 32 * nb;
#pragma unroll 8
    for (int i = 0; i < 32; ++i) { const int kk = 2 * i + (lane >> 5); scr[kk * 33 + (lane & 31)] = W[(size_t)(k0 + kk) * ldw + col0 + n0 + (lane & 31)]; }
    asm volatile("s_waitcnt lgkmcnt(0)" ::: "memory");
    const int c = lane & 7;
#pragma unroll
    for (int j = 0; j < 4; ++j) { const int n = (lane >> 3) + 8 * j; const LAS float* s = scr + (8 * c) * 33 + n;
        u32x4 o; o.x = pk2(s[0 * 33], s[1 * 33]); o.y = pk2(s[2 * 33], s[3 * 33]); o.z = pk2(s[4 * 33], s[5 * 33]); o.w = pk2(s[6 * 33], s[7 * 33]);
        *(u32x4*)(WT + (size_t)(row0 + n0 + n) * K + k0 + 8 * c) = o; }
    asm volatile("s_waitcnt lgkmcnt(0)" ::: "memory");
}

__device__ __forceinline__ void phase_convert(const Args& a, LAS unsigned char* lds, int layer, int gw, int NGW, int wave, int lane, int tid, int gtid, int GT) {
    LAS float* scr = (LAS float*)(lds + wave * 16384);
    unsigned char* ws = a.ws;
    const float* w_in = a.in[1] + (size_t)layer * D * D_IN;
    constexpr int NJ = 7;
#define JC0(q) ((q) == 0 ? OFF_QA : (q) == 1 ? OFF_KA : (q) == 2 ? OFF_QKVB : (q) == 3 ? OFF_GATEB : (q) == 4 ? OFF_POOL : (q) == 5 ? OFF_VA : OFF_GATES)
#define JN(q)  ((q) == 2 ? 1536 : (q) == 6 ? 3072 : 512)
#define JR0(q) ((q) == 1 ? 512 : (q) == 2 ? 1024 : (q) == 3 ? 2560 : (q) == 4 ? 3072 : 0)
#define JD(q)  ((q) == 5 ? WS_WV : (q) == 6 ? WS_WG : WS_WIN1)
    constexpr int I_IN = 224 * 16;
    constexpr int I_BR = 2 * (1024 / 32) * (512 / 64);
    constexpr int I_OUT = (1024 / 32) * (1024 / 64);
    constexpr int I_W13 = NEXP * 2 * (512 / 32) * (1024 / 64);
    constexpr int I_W2 = NEXP * (1024 / 32) * (512 / 64);
    constexpr int NITEMS = I_IN + I_BR + I_OUT + I_W13 + I_W2;
    for (int it = gw; it < NITEMS; it += NGW) {
        int r = it;
        if (r < I_IN) {
            const int kb = r & 15; int nbg = r >> 4;
            int j = 0, nb = nbg;
#pragma unroll
            for (int q = 0; q < NJ; ++q) { if (j == q && nb >= JN(q) / 32) { nb -= JN(q) / 32; j = q + 1; } }
            int c0 = 0, r0 = 0; size_t dd = 0;
#pragma unroll
            for (int q = 0; q < NJ; ++q) if (j == q) { c0 = JC0(q); r0 = JR0(q); dd = JD(q); }
            transpose_item(w_in, D_IN, c0, 1024, (bf16_t*)(ws + dd), r0, scr, kb, nb, lane);
            continue;
        }
        r -= I_IN;
        if (r < I_BR) {
            const int which = r / 256, rr = r % 256, kb = rr & 7, nb = rr >> 3;
            const float* W = (which == 0 ? a.in[9] : a.in[10]) + (size_t)layer * 512 * 1024;
            transpose_item(W, 1024, 0, 512, (bf16_t*)(ws + WS_WBR) + (size_t)which * 1024 * 512, 0, scr, kb, nb, lane);
            continue;
        }
        r -= I_BR;
        if (r < I_OUT) {
            const int kb = r & 15, nb = r >> 4;
            transpose_item(a.in[13] + (size_t)layer * 1024 * 1024, 1024, 0, 1024, (bf16_t*)(ws + WS_WOUT), 0, scr, kb, nb, lane);
            continue;
        }
        r -= I_OUT;
        if (r < I_W13) {
            const int e = r / 512, rr = r % 512, half = rr / 256, r2 = rr % 256, kb = r2 & 15, nb = r2 >> 4;
            const float* W = (half == 0 ? a.in[20] : a.in[21]) + ((size_t)layer * NEXP + e) * 1024 * 512;
            const int f0 = 32 * nb, jt = f0 / 128, cc = f0 % 128;
            transpose_item(W, 512, f0, 1024, (bf16_t*)(ws + WS_W13), e * 1024 + jt * 256 + half * 128 + cc - 0, scr, kb, 0, lane);
            continue;
        }
        r -= I_W13;
        {
            const int e = r / 256, rr = r % 256, kb = rr & 7, nb = rr >> 3;
            const float* W = a.in[22] + ((size_t)layer * NEXP + e) * 512 * 1024;
            transpose_item(W, 1024, 0, 512, (bf16_t*)(ws + WS_W2), e * 1024, scr, kb, nb, lane);
        }
    }
    {
        const float* pw = a.in[7] + (size_t)layer * 4 * 128 * 128;
        const float* ps = a.in[8] + (size_t)layer * 512;
        const float* wc = a.in[11] + (size_t)layer * 512 * 1024;
        bf16_t* dst = (bf16_t*)(ws + WS_WBR) + (size_t)2 * 1024 * 512;
        for (int i = gtid; i < 512 * 1024; i += GT) {
            const int d = i & 1023, gc = i >> 10, g = gc >> 7;
            float s = 0.f;
            for (int c2 = 0; c2 < 128; ++c2) s += pw[(size_t)gc * 128 + c2] * ps[g * 128 + c2] * wc[(size_t)(g * 128 + c2) * 1024 + d];
            dst[(size_t)d * 512 + gc] = (bf16_t)f2bf(s);
        }
    }
}

__device__ __forceinline__ void row_store_bf16(bf16_t* dst_row, const f32x4 (&v)[4], int lane) {
    unsigned long long* o8 = (unsigned long long*)dst_row + lane;
#pragma unroll
    for (int j = 0; j < 4; ++j) o8[64 * j] = (unsigned long long)pk2(v[j].x, v[j].y) | ((unsigned long long)pk2(v[j].z, v[j].w) << 32);
}
__device__ __forceinline__ void row_bd_logits(const f32x4 (&v)[4], const LAS float* wbd, float* bdl_row, int lane) {
    float acc[8];
#pragma unroll
    for (int i = 0; i < 8; ++i) acc[i] = 0.f;
#pragma unroll
    for (int j = 0; j < 4; ++j)
#pragma unroll
        for (int c = 0; c < 4; ++c) {
            const int k = 256 * j + 4 * lane + c; const float xv = v[j][c];
            const f32x4 w0 = *(const LAS f32x4*)(wbd + k * 8), w1 = *(const LAS f32x4*)(wbd + k * 8 + 4);
            acc[0] += xv * w0.x; acc[1] += xv * w0.y; acc[2] += xv * w0.z; acc[3] += xv * w0.w;
            acc[4] += xv * w1.x; acc[5] += xv * w1.y; acc[6] += xv * w1.z; acc[7] += xv * w1.w;
        }
    float r = 0.f;
#pragma unroll
    for (int i = 0; i < 8; ++i) { const float s = wave_sum(acc[i]); r = (lane == i) ? s : r; }
    if (lane < 8) bdl_row[lane] = r;
}
__device__ __forceinline__ void stage_wbd(const float* w_in_layer, LAS float* wbd, int tid) {
    for (int k = tid; k < 1024; k += NTHR) {
        const f32x4 a0 = *(const f32x4*)(w_in_layer + (size_t)k * D_IN + OFF_BETA), a1 = *(const f32x4*)(w_in_layer + (size_t)k * D_IN + OFF_BETA + 4);
        *(LAS f32x4*)(wbd + k * 8) = a0; *(LAS f32x4*)(wbd + k * 8 + 4) = a1;
    }
    __syncthreads();
}

__device__ __forceinline__ void phase_xconv(const Args& a, LAS unsigned char* lds, int gw, int NGW, int lane, int tid) {
    LAS float* wbd = (LAS float*)(lds);
    stage_wbd(a.in[1], wbd, tid);
    const float* x = a.in[0]; bf16_t* XB = (bf16_t*)(a.ws + WS_XB); float* bdl = (float*)(a.ws + WS_BDL);
    for (int m = gw; m < T; m += NGW) {
        const f32x4* xr = (const f32x4*)(x + (size_t)m * D) + lane;
        f32x4 v[4];
#pragma unroll
        for (int j = 0; j < 4; ++j) v[j] = xr[64 * j];
        row_store_bf16(XB + (size_t)m * D, v, lane);
        row_bd_logits(v, wbd, bdl + (size_t)m * 8, lane);
    }
    __syncthreads();
}

__device__ __forceinline__ void phase_pool(const Args& a, int gw, int NGW, int lane) {
    const bf16_t* pool = (const bf16_t*)(a.ws + WS_POOL); bf16_t* pld = (bf16_t*)(a.ws + WS_PLD);
    const int g = lane >> 4, win = 2 << g;
    for (int m = gw; m < T; m += NGW) {
        const int tl = m & (SEQ - 1);
        const int n = (tl + 1 < win) ? tl + 1 : win;
        float s[8];
#pragma unroll
        for (int i = 0; i < 8; ++i) s[i] = 0.f;
        u32x4 cur = {0u, 0u, 0u, 0u};
        for (int q = 0; q < n; ++q) {
            const u32x4 w = *(const u32x4*)(pool + (size_t)(m - q) * 512 + 8 * lane);
            if (q == 0) cur = w;
            s[0] += bflo(w.x); s[1] += bfhi(w.x); s[2] += bflo(w.y); s[3] += bfhi(w.y); s[4] += bflo(w.z); s[5] += bfhi(w.z); s[6] += bflo(w.w); s[7] += bfhi(w.w);
        }
        const float inv = 1.0f / (float)n;
        u32x4 o;
        o.x = pk2(s[0] * inv - bflo(cur.x), s[1] * inv - bfhi(cur.x)); o.y = pk2(s[2] * inv - bflo(cur.y), s[3] * inv - bfhi(cur.y));
        o.z = pk2(s[4] * inv - bflo(cur.z), s[5] * inv - bfhi(cur.z)); o.w = pk2(s[6] * inv - bflo(cur.w), s[7] * inv - bfhi(cur.w));
        *(u32x4*)(pld + (size_t)m * 512 + 8 * lane) = o;
    }
}

__device__ __forceinline__ void phase_ln1(const Args& a, int layer, int gw, int NGW, int lane) {
    const float* xin = (layer == 0) ? a.in[0] : a.out;
    const float* mix = (const float*)(a.ws + WS_MIX);
    float* xo = a.out; bf16_t* XB = (bf16_t*)(a.ws + WS_XB);
    const float* lg_ = a.in[14] + (size_t)layer * D; const float* lb_ = a.in[15] + (size_t)layer * D;
    const float* wg = a.in[16] + (size_t)layer * D * 4; const float* bg = a.in[17] + (size_t)layer * 4;
    const float* we = a.in[18] + (size_t)layer * D * 32; const float* be = a.in[19] + (size_t)layer * 32;
    int* eid = (int*)(a.ws + WS_EID); float* wts = (float*)(a.ws + WS_WTS); int* hist = (int*)(a.ws + WS_HIST);
    f32x4 gv[4], bv[4];
#pragma unroll
    for (int j = 0; j < 4; ++j) { gv[j] = ((const f32x4*)lg_)[64 * j + lane]; bv[j] = ((const f32x4*)lb_)[64 * j + lane]; }
    int cnt = 0;
    for (int m = gw; m < T; m += NGW) {
        const f32x4* xr = (const f32x4*)(xin + (size_t)m * D) + lane; const f32x4* mr = (const f32x4*)(mix + (size_t)m * D) + lane;
        f32x4 v[4]; float s = 0.f;
#pragma unroll
        for (int j = 0; j < 4; ++j) { v[j] = xr[64 * j] * DN_ALPHA + mr[64 * j]; s += (v[j].x + v[j].y) + (v[j].z + v[j].w); }
        const float mean = wave_sum(s) * (1.f / D); float s2 = 0.f;
#pragma unroll
        for (int j = 0; j < 4; ++j) { v[j] = v[j] - mean; s2 += (v[j].x * v[j].x + v[j].y * v[j].y) + (v[j].z * v[j].z + v[j].w * v[j].w); }
        const float rstd = 1.f / sqrtf(wave_sum(s2) * (1.f / D) + LN_EPS);
#pragma unroll
        for (int j = 0; j < 4; ++j) v[j] = v[j] * rstd * gv[j] + bv[j];
        f32x4* orow = (f32x4*)(xo + (size_t)m * D) + lane;
#pragma unroll
        for (int j = 0; j < 4; ++j) orow[64 * j] = v[j];
        row_store_bf16(XB + (size_t)m * D, v, lane);
        float ag[4] = {0.f, 0.f, 0.f, 0.f}; float ae[32];
#pragma unroll
        for (int i = 0; i < 32; ++i) ae[i] = 0.f;
#pragma unroll
        for (int j = 0; j < 4; ++j)
#pragma unroll
            for (int c = 0; c < 4; ++c) {
                const int k = 256 * j + 4 * lane + c; const float xv = v[j][c];
                const f32x4 g4 = *(const f32x4*)(wg + (size_t)k * 4);
                ag[0] += xv * g4.x; ag[1] += xv * g4.y; ag[2] += xv * g4.z; ag[3] += xv * g4.w;
#pragma unroll
                for (int q = 0; q < 8; ++q) { const f32x4 e4 = *(const f32x4*)(we + (size_t)k * 32 + 4 * q);
                    ae[4 * q] += xv * e4.x; ae[4 * q + 1] += xv * e4.y; ae[4 * q + 2] += xv * e4.z; ae[4 * q + 3] += xv * e4.w; }
            }
#pragma unroll
        for (int i = 0; i < 4; ++i) ag[i] = wave_sum(ag[i]) + bg[i];
        float mine = 0.f;
#pragma unroll
        for (int i = 0; i < 32; ++i) { const float sr = wave_sum(ae[i]); mine = (lane == i) ? sr : mine; }
        mine += be[lane & 31];
        int gsel = 0; float gm = ag[0];
#pragma unroll
        for (int i = 1; i < 4; ++i) if (ag[i] > gm) { gm = ag[i]; gsel = i; }
        float gs = 0.f;
#pragma unroll
        for (int i = 0; i < 4; ++i) gs += expf(ag[i] - gm);
        const float p_top = 1.0f / gs;
        float le[8];
#pragma unroll
        for (int i = 0; i < 8; ++i) le[i] = __shfl(mine, gsel * 8 + i);
        int i0 = 0; float l0 = le[0];
#pragma unroll
        for (int i = 1; i < 8; ++i) if (le[i] > l0) { l0 = le[i]; i0 = i; }
        int i1 = -1; float l1 = -3.0e38f;
#pragma unroll
        for (int i = 0; i < 8; ++i) if (i != i0 && le[i] > l1) { l1 = le[i]; i1 = i; }
        const float ex = expf(l1 - l0); const float w0 = p_top / (1.0f + ex), w1 = p_top * ex / (1.0f + ex);
        const int e0 = gsel * 8 + i0, e1 = gsel * 8 + i1;
        if (lane == 0) { eid[2 * m] = e0; eid[2 * m + 1] = e1; wts[2 * m] = w0; wts[2 * m + 1] = w1; }
        cnt += (lane == e0) ? 1 : 0; cnt += (lane == e1) ? 1 : 0;
    }
    if (lane < 32) hist[gw * 32 + lane] = cnt;
}

__device__ __forceinline__ void phase_slots(const Args& a, LAS unsigned char* lds, int gw, int NGW, int wave, int lane, int tid) {
    LAS int* red = (LAS int*)lds;
    LAS int* tot = red + 1024;
    LAS int* bef = tot + 32;
    LAS int* pst = bef + 32;
    LAS int* base = pst + 64;
    const int* hist = (const int*)(a.ws + WS_HIST);
    const int nwv = NGW;
    const int wg0 = gw - wave;
    {
        const int e = tid & 31, part = tid >> 5;
        const int per = (nwv + 15) / 16; const int lo = part * per, hi = (lo + per < nwv) ? lo + per : nwv;
        int st = 0, sb = 0;
        for (int g = lo; g < hi; ++g) { const int v = hist[g * 32 + e]; st += v; sb += (g < wg0) ? v : 0; }
        red[part * 32 + e] = st; red[512 + part * 32 + e] = sb;
    }
    __syncthreads();
    if (tid < 32) { int st = 0, sb = 0; for (int p = 0; p < 16; ++p) { st += red[p * 32 + tid]; sb += red[512 + p * 32 + tid]; } tot[tid] = st; bef[tid] = sb; }
    __syncthreads();
    if (tid == 0) { int acc = 0; for (int e = 0; e < 32; ++e) { pst[e] = acc; acc += (tot[e] + MOE_BLOCK - 1) / MOE_BLOCK * MOE_BLOCK; } pst[32] = acc; }
    __syncthreads();
    if (tid < 32) { int acc = pst[tid] + bef[tid]; for (int w = 0; w < NWAVES; ++w) { base[w * 32 + tid] = acc; acc += hist[(wg0 + w) * 32 + tid]; } }
    __syncthreads();
    if (blockIdx.x == 0) {
        int* blk_e = (int*)(a.ws + WS_BLKE);
        const int nblk = pst[32] / MOE_BLOCK;
        if (tid == 0) blk_e[1023] = nblk;
        for (int b = tid; b < nblk; b += NTHR) { int e = 0; for (int q = 0; q < 32; ++q) if (pst[q] <= b * MOE_BLOCK) e = q; blk_e[b] = e; }
    }
    const int* eid = (const int*)(a.ws + WS_EID); int* slot = (int*)(a.ws + WS_SLOT);
    const bf16_t* XB = (const bf16_t*)(a.ws + WS_XB); bf16_t* xg = (bf16_t*)(a.ws + WS_XG);
    int cnt = (lane < 32) ? base[wave * 32 + lane] : 0;
    for (int m = gw; m < T; m += NGW) {
        const int e0 = eid[2 * m], e1 = eid[2 * m + 1];
        const int s0 = __shfl(cnt, e0); cnt += (lane == e0) ? 1 : 0;
        const int s1 = __shfl(cnt, e1); cnt += (lane == e1) ? 1 : 0;
        if (lane == 0) { slot[2 * m] = s0; slot[2 * m + 1] = s1; }
        const u32x4* src = (const u32x4*)(XB + (size_t)m * D) + lane;
        const u32x4 p0 = src[0], p1 = src[64];
        u32x4* d0 = (u32x4*)(xg + (size_t)s0 * D) + lane; u32x4* d1 = (u32x4*)(xg + (size_t)s1 * D) + lane;
        d0[0] = p0; d0[64] = p1; d1[0] = p0; d1[64] = p1;
    }
    __syncthreads();
}

__device__ __forceinline__ void phase_ln2(const Args& a, LAS unsigned char* lds, int layer, int gw, int NGW, int lane, int tid) {
    LAS float* wbd = (LAS float*)(lds);
    const bool has_next = (layer + 1 < DEPTH);
    if (has_next) stage_wbd(a.in[1] + (size_t)(layer + 1) * D * D_IN, wbd, tid);
    float* xo = a.out; bf16_t* XB = (bf16_t*)(a.ws + WS_XB); float* bdl = (float*)(a.ws + WS_BDL);
    const bf16_t* ymoe = (const bf16_t*)(a.ws + WS_YMOE);
    const int* slot = (const int*)(a.ws + WS_SLOT); const float* wts = (const float*)(a.ws + WS_WTS);
    const float* lg_ = a.in[23] + (size_t)layer * D; const float* lb_ = a.in[24] + (size_t)layer * D;
    f32x4 gv[4], bv[4];
#pragma unroll
    for (int j = 0; j < 4; ++j) { gv[j] = ((const f32x4*)lg_)[64 * j + lane]; bv[j] = ((const f32x4*)lb_)[64 * j + lane]; }
    for (int m = gw; m < T; m += NGW) {
        const int s0 = slot[2 * m], s1 = slot[2 * m + 1]; const float w0 = wts[2 * m], w1 = wts[2 * m + 1];
        const f32x4* xr = (const f32x4*)(xo + (size_t)m * D) + lane;
        const unsigned long long* y0 = (const unsigned long long*)(ymoe + (size_t)s0 * D) + lane; const unsigned long long* y1 = (const unsigned long long*)(ymoe + (size_t)s1 * D) + lane;
        f32x4 v[4]; float s = 0.f;
#pragma unroll
        for (int j = 0; j < 4; ++j) {
            const unsigned long long p = y0[64 * j], q = y1[64 * j];
            f32x4 f; f.x = w0 * bflo((unsigned)p) + w1 * bflo((unsigned)q); f.y = w0 * bfhi((unsigned)p) + w1 * bfhi((unsigned)q);
            f.z = w0 * bflo((unsigned)(p >> 32)) + w1 * bflo((unsigned)(q >> 32)); f.w = w0 * bfhi((unsigned)(p >> 32)) + w1 * bfhi((unsigned)(q >> 32));
            v[j] = xr[64 * j] * DN_ALPHA + f; s += (v[j].x + v[j].y) + (v[j].z + v[j].w);
        }
        const float mean = wave_sum(s) * (1.f / D); float s2 = 0.f;
#pragma unroll
        for (int j = 0; j < 4; ++j) { v[j] = v[j] - mean; s2 += (v[j].x * v[j].x + v[j].y * v[j].y) + (v[j].z * v[j].z + v[j].w * v[j].w); }
        const float rstd = 1.f / sqrtf(wave_sum(s2) * (1.f / D) + LN_EPS);
#pragma unroll
        for (int j = 0; j < 4; ++j) v[j] = v[j] * rstd * gv[j] + bv[j];
        f32x4* orow = (f32x4*)(xo + (size_t)m * D) + lane;
#pragma unroll
        for (int j = 0; j < 4; ++j) orow[64 * j] = v[j];
        if (has_next) { row_store_bf16(XB + (size_t)m * D, v, lane); row_bd_logits(v, wbd, bdl + (size_t)m * 8, lane); }
    }
    __syncthreads();
}


template <class F> struct EpiP8 { static constexpr bool PERM = true, AFTER_DRAIN = false; F f;
    __device__ __forceinline__ void operator()(const f32x4 (&acc)[2][2][4][2], const pg8::Unit& u, int wr, int wc, int fr, int fq) const {
        const int row0 = u.pm * 256 + wr * 64 + fr, col0 = u.pn * 256 + wc * 32 + 8 * fq;
#pragma unroll
        for (int ai = 0; ai < 2; ++ai)
#pragma unroll
            for (int m = 0; m < 4; ++m)
#pragma unroll
                for (int bj = 0; bj < 2; ++bj) f(row0 + ai * 128 + m * 16, col0 + bj * 128, acc[ai][bj][m][0], acc[ai][bj][m][1]);
    } };
template <class F> struct EpiPair { static constexpr bool PERM = true, AFTER_DRAIN = false; F f;
    __device__ __forceinline__ void operator()(const f32x4 (&acc)[2][2][4][2], const pg8::Unit& u, int wr, int wc, int fr, int fq) const {
        const int row0 = u.pm * 256 + wr * 64 + fr, col0 = u.pn * 256 + wc * 32 + 8 * fq;
#pragma unroll
        for (int ai = 0; ai < 2; ++ai)
#pragma unroll
            for (int m = 0; m < 4; ++m) f(row0 + ai * 128 + m * 16, col0, acc[ai][0][m][0], acc[ai][0][m][1], acc[ai][1][m][0], acc[ai][1][m][1]);
    } };
template <class F> struct EpiP4 { static constexpr bool PERM = false, AFTER_DRAIN = false; F f;
    __device__ __forceinline__ void operator()(const f32x4 (&acc)[2][2][4][2], const pg8::Unit& u, int wr, int wc, int fr, int fq) const {
        const int row0 = u.pm * 256 + wr * 64 + fr, col0 = u.pn * 256 + wc * 32 + 4 * fq;
#pragma unroll
        for (int ai = 0; ai < 2; ++ai)
#pragma unroll
            for (int m = 0; m < 4; ++m)
#pragma unroll
                for (int bj = 0; bj < 2; ++bj)
#pragma unroll
                    for (int n = 0; n < 2; ++n) f(row0 + ai * 128 + m * 16, col0 + bj * 128 + n * 16, acc[ai][bj][m][n]);
    } };
__device__ __forceinline__ u32x4 pack8(f32x4 a, f32x4 b) { u32x4 w; w.x = pg8::cvt_pk_bf16(a.x, a.y); w.y = pg8::cvt_pk_bf16(a.z, a.w); w.z = pg8::cvt_pk_bf16(b.x, b.y); w.w = pg8::cvt_pk_bf16(b.z, b.w); return w; }
__device__ __forceinline__ float fsig(float x) { return __builtin_amdgcn_rcpf(1.0f + __expf(-x)); }
struct F_Proj1 { unsigned char* ws;
    __device__ __forceinline__ void operator()(int row, int col, f32x4 a, f32x4 b) const {
        bf16_t* p;
        if (col < 512) p = (bf16_t*)(ws + WS_QA) + (size_t)row * 512 + col;
        else if (col < 1024) p = (bf16_t*)(ws + WS_KA) + (size_t)row * 512 + (col - 512);
        else if (col < 2560) p = (bf16_t*)(ws + WS_QKVB) + (size_t)row * 1536 + (col - 1024);
        else if (col < 3072) p = (bf16_t*)(ws + WS_GATEB) + (size_t)row * 512 + (col - 2560);
        else p = (bf16_t*)(ws + WS_POOL) + (size_t)row * 512 + (col - 3072);
        *(u32x4*)p = pack8(a, b); } };
struct F_Bf16 { bf16_t* O; int ldc, cmask;
    __device__ __forceinline__ void operator()(int row, int col, f32x4 a, f32x4 b) const { *(u32x4*)(O + (size_t)row * ldc + (col & cmask)) = pack8(a, b); } };
struct F_Gates { bf16_t* O; const float* gb;
    __device__ __forceinline__ void operator()(int row, int col, f32x4 a, f32x4 b) const { const f32x4 b0 = *(const f32x4*)(gb + col), b1 = *(const f32x4*)(gb + col + 4);
        a = a + b0; b = b + b1; a.x = fsig(a.x); a.y = fsig(a.y); a.z = fsig(a.z); a.w = fsig(a.w); b.x = fsig(b.x); b.y = fsig(b.y); b.z = fsig(b.z); b.w = fsig(b.w);
        *(u32x4*)(O + (size_t)row * 3072 + col) = pack8(a, b); } };
template <int WHICH> struct F_Branch { bf16_t* Y; const bf16_t* gates;
    __device__ __forceinline__ void operator()(int row, int col, f32x4 a, f32x4 b) const {
        const u32x4 g = *(const u32x4*)(gates + (size_t)row * 3072 + WHICH * 1024 + col);
        a.x *= bflo(g.x); a.y *= bfhi(g.x); a.z *= bflo(g.y); a.w *= bfhi(g.y); b.x *= bflo(g.z); b.y *= bfhi(g.z); b.z *= bflo(g.w); b.w *= bfhi(g.w);
        bf16_t* yp = Y + (size_t)row * 1024 + col;
        if (WHICH > 0) { const u32x4 o = *(const u32x4*)yp; a.x += bflo(o.x); a.y += bfhi(o.x); a.z += bflo(o.y); a.w += bfhi(o.y); b.x += bflo(o.z); b.y += bfhi(o.z); b.z += bflo(o.w); b.w += bfhi(o.w); }
        *(u32x4*)yp = pack8(a, b); } };
struct F_F32 { float* O; int ldc;
    __device__ __forceinline__ void operator()(int row, int col, f32x4 v) const { *(f32x4*)(O + (size_t)row * ldc + col) = v; } };
struct F_Hdn { bf16_t* H;
    __device__ __forceinline__ void operator()(int row, int col, f32x4 a0, f32x4 a1, f32x4 b0, f32x4 b1) const {
        const int hc = ((col >> 8) & 3) * 128 + (col & 127);
        a0.x = a0.x * fsig(a0.x) * b0.x; a0.y = a0.y * fsig(a0.y) * b0.y; a0.z = a0.z * fsig(a0.z) * b0.z; a0.w = a0.w * fsig(a0.w) * b0.w;
        a1.x = a1.x * fsig(a1.x) * b1.x; a1.y = a1.y * fsig(a1.y) * b1.y; a1.z = a1.z * fsig(a1.z) * b1.z; a1.w = a1.w * fsig(a1.w) * b1.w;
        *(u32x4*)(H + (size_t)row * 512 + hc) = pack8(a0, a1); } };
struct MoeOrder { const LAS int* tab; int nunits, G, c;
    __device__ __forceinline__ bool next(int i, pg8::Unit& u) const { const int L = i * G + c; if (L >= nunits) return false; const int blk = L >> 2; u.pm = blk; u.pn = tab[blk] * 4 + (L & 3); return true; }
    __device__ __forceinline__ void a_ready(const pg8::Unit&) const {}
    __device__ __forceinline__ void done(const pg8::Unit&) const {} };
constexpr int LDS_TAB_OFF = 131072;

__device__ __forceinline__ void phase_g_proj1(const Args& a, LAS unsigned char* lds, int G, int c) {
    const bf16_t* XB = (const bf16_t*)(a.ws + WS_XB);
    { pg8::Gemm g{XB, (const bf16_t*)(a.ws + WS_WIN1), T, N1, 1024}; pg8::StaticOrder S; S.init(T, N1, G, c); EpiP8<F_Proj1> E{F_Proj1{a.ws}};
      pg8::gemm_phase<EpiP8<F_Proj1>, pg8::StaticOrder, true, true>(lds, g, S, E); }
    { pg8::Gemm g{(const bf16_t*)(a.ws + WS_WV), XB, 512, T, 1024}; pg8::StaticOrder S; S.init(512, T, G, c); EpiP8<F_Bf16> E{F_Bf16{(bf16_t*)(a.ws + WS_VT), T, 0x7fffffff}};
      pg8::gemm_phase<EpiP8<F_Bf16>, pg8::StaticOrder, true, true>(lds, g, S, E); }
}
__device__ __forceinline__ void phase_g_gates(const Args& a, LAS unsigned char* lds, int layer, int G, int c) {
    pg8::Gemm g{(const bf16_t*)(a.ws + WS_XB), (const bf16_t*)(a.ws + WS_WG), T, 3072, 1024}; pg8::StaticOrder S; S.init(T, 3072, G, c);
    EpiP8<F_Gates> E{F_Gates{(bf16_t*)(a.ws + WS_GATES), a.in[12] + (size_t)layer * 3072}};
    pg8::gemm_phase<EpiP8<F_Gates>, pg8::StaticOrder, true, true>(lds, g, S, E);
}
__device__ __forceinline__ void phase_g_branch(const Args& a, LAS unsigned char* lds, int G, int c) {
    bf16_t* Y = (bf16_t*)(a.ws + WS_Y); const bf16_t* gates = (const bf16_t*)(a.ws + WS_GATES); const bf16_t* W = (const bf16_t*)(a.ws + WS_WBR);
    pg8::StaticOrder S; S.init(T, 1024, G, c);
    { pg8::Gemm g{(const bf16_t*)(a.ws + WS_OA), W, T, 1024, 512}; EpiP8<F_Branch<0>> E{F_Branch<0>{Y, gates}}; pg8::gemm_phase<EpiP8<F_Branch<0>>, pg8::StaticOrder, true, true>(lds, g, S, E); }
    { pg8::Gemm g{(const bf16_t*)(a.ws + WS_OB), W + (size_t)1024 * 512, T, 1024, 512}; EpiP8<F_Branch<1>> E{F_Branch<1>{Y, gates}}; pg8::gemm_phase<EpiP8<F_Branch<1>>, pg8::StaticOrder, true, true>(lds, g, S, E); }
    { pg8::Gemm g{(const bf16_t*)(a.ws + WS_PLD), W + (size_t)2 * 1024 * 512, T, 1024, 512}; EpiP8<F_Branch<2>> E{F_Branch<2>{Y, gates}}; pg8::gemm_phase<EpiP8<F_Branch<2>>, pg8::StaticOrder, true, true>(lds, g, S, E); }
}
__device__ __forceinline__ void phase_g_out(const Args& a, LAS unsigned char* lds, int G, int c) {
    pg8::Gemm g{(const bf16_t*)(a.ws + WS_Y), (const bf16_t*)(a.ws + WS_WOUT), T, 1024, 1024}; pg8::StaticOrder S; S.init(T, 1024, G, c);
    EpiP4<F_F32> E{F_F32{(float*)(a.ws + WS_MIX), 1024}};
    pg8::gemm_phase<EpiP4<F_F32>, pg8::StaticOrder, true, true>(lds, g, S, E);
}
__device__ __forceinline__ void moe_table(const Args& a, LAS unsigned char* lds, MoeOrder& S, int G, int c, int tid) {
    const int* blk_e = (const int*)(a.ws + WS_BLKE); LAS int* tab = (LAS int*)(lds + LDS_TAB_OFF);
    const int nblk = blk_e[1023];
    for (int i = tid; i < nblk; i += NTHR) tab[i] = blk_e[i];
    __syncthreads();
    S.tab = tab; S.nunits = nblk * 4; S.G = G; S.c = c;
}
__device__ __forceinline__ void phase_moe1(const Args& a, LAS unsigned char* lds, int G, int c, int tid) {
    MoeOrder S; moe_table(a, lds, S, G, c, tid);
    pg8::Gemm g{(const bf16_t*)(a.ws + WS_XG), (const bf16_t*)(a.ws + WS_W13), CAP, NEXP * 1024, 1024};
    EpiPair<F_Hdn> E{F_Hdn{(bf16_t*)(a.ws + WS_HDN)}};
    pg8::gemm_phase<EpiPair<F_Hdn>, MoeOrder, true, true>(lds, g, S, E);
}
__device__ __forceinline__ void phase_moe2(const Args& a, LAS unsigned char* lds, int G, int c, int tid) {
    MoeOrder S; moe_table(a, lds, S, G, c, tid);
    pg8::Gemm g{(const bf16_t*)(a.ws + WS_HDN), (const bf16_t*)(a.ws + WS_W2), CAP, NEXP * 1024, 512};
    EpiP8<F_Bf16> E{F_Bf16{(bf16_t*)(a.ws + WS_YMOE), 1024, 1023}};
    pg8::gemm_phase<EpiP8<F_Bf16>, MoeOrder, true, true>(lds, g, S, E);
}


__device__ __forceinline__ void attn_stage_bias(const Args& a, LAS unsigned char* lds, int layer, int tid) {
    LAS float* rb = (LAS float*)lds;
    const float* relb = a.in[2] + (size_t)layer * A_HEADS * A_NREL;
    for (int i = tid; i < A_HEADS * A_NREL; i += NTHR) rb[i] = relb[i] * 1.4426950408889634f;
    __syncthreads();
}
__device__ __forceinline__ void attn_item(const Args& a, const LAS float* rb, int item, int lane) {
    const bf16_t* qA = (const bf16_t*)(a.ws + WS_QA); const bf16_t* kA = (const bf16_t*)(a.ws + WS_KA); const bf16_t* vT = (const bf16_t*)(a.ws + WS_VT); bf16_t* oA = (bf16_t*)(a.ws + WS_OA);
    const int fr = lane & 15, fq = lane >> 4;
    const int hq = item & 1, ci = (item >> 1) & 31, h = (item >> 6) & 7, b = item >> 9;
    const size_t tokq = (size_t)b * SEQ + ci * 64 + hq * 32;
    bf16x8 Bq[2][2];
#pragma unroll
    for (int qt = 0; qt < 2; ++qt)
#pragma unroll
        for (int ks = 0; ks < 2; ++ks) Bq[qt][ks] = *(const bf16x8*)(qA + (tokq + qt * 16 + fr) * 512 + h * 64 + ks * 32 + 8 * fq);
    f32x4 O[4][2];
#pragma unroll
    for (int dt = 0; dt < 4; ++dt) { O[dt][0] = (f32x4){0.f, 0.f, 0.f, 0.f}; O[dt][1] = (f32x4){0.f, 0.f, 0.f, 0.f}; }
    float mrun[2] = {-1.0e30f, -1.0e30f}, lrun[2] = {0.f, 0.f};
    const LAS float* rbh = rb + h * A_NREL;
    const float SC = 0.125f * 1.4426950408889634f;
    const int kc_lo = ci >= 8 ? ci - 8 : 0;
    for (int kc = kc_lo; kc <= ci; ++kc) {
        const int t = ci - kc;
        const size_t tokk = (size_t)b * SEQ + kc * 64;
        f32x4 S[4][2];
#pragma unroll
        for (int kt = 0; kt < 4; ++kt) {
            const bf16_t* kp = kA + (tokk + kt * 16 + fr) * 512 + h * 64 + 8 * fq;
            const bf16x8 Ak0 = *(const bf16x8*)kp, Ak1 = *(const bf16x8*)(kp + 32);
#pragma unroll
            for (int qt = 0; qt < 2; ++qt) {
                f32x4 z = (f32x4){0.f, 0.f, 0.f, 0.f};
                z = __builtin_amdgcn_mfma_f32_16x16x32_bf16(Ak0, Bq[qt][0], z, 0, 0, 0);
                S[kt][qt] = __builtin_amdgcn_mfma_f32_16x16x32_bf16(Ak1, Bq[qt][1], z, 0, 0, 0);
            }
        }
        if (t >= 5) {
            const float cb = rbh[319];
#pragma unroll
            for (int kt = 0; kt < 4; ++kt)
#pragma unroll
                for (int qt = 0; qt < 2; ++qt) S[kt][qt] = S[kt][qt] * SC + cb;
        } else {
#pragma unroll
            for (int kt = 0; kt < 4; ++kt)
#pragma unroll
                for (int qt = 0; qt < 2; ++qt)
#pragma unroll
                    for (int r = 0; r < 4; ++r) {
                        int dist = (hq * 32 + qt * 16 + fr) - (kt * 16 + 4 * fq + r) + 64 * t; dist = dist > A_CLIP ? A_CLIP : dist;
                        S[kt][qt][r] = S[kt][qt][r] * SC + rbh[dist + 63];
                    }
        }
#pragma unroll
        for (int qt = 0; qt < 2; ++qt) {
            float mx = S[0][qt][0];
#pragma unroll
            for (int kt = 0; kt < 4; ++kt)
#pragma unroll
                for (int r = 0; r < 4; ++r) mx = fmaxf(mx, S[kt][qt][r]);
            mx = fmaxf(mx, __shfl_xor(mx, 16)); mx = fmaxf(mx, __shfl_xor(mx, 32));
            const float mn = fmaxf(mrun[qt], mx), al = __builtin_amdgcn_exp2f(mrun[qt] - mn); mrun[qt] = mn;
            float ps = 0.f;
#pragma unroll
            for (int kt = 0; kt < 4; ++kt)
#pragma unroll
                for (int r = 0; r < 4; ++r) { const float p = __builtin_amdgcn_exp2f(S[kt][qt][r] - mn); S[kt][qt][r] = p; ps += p; }
            lrun[qt] = lrun[qt] * al + ps;
#pragma unroll
            for (int dt = 0; dt < 4; ++dt) O[dt][qt] = O[dt][qt] * al;
        }
        bf16x8 Bp[2][2];
#pragma unroll
        for (int qt = 0; qt < 2; ++qt)
#pragma unroll
            for (int s2 = 0; s2 < 2; ++s2) { const u32x4 w = pack8(S[2 * s2][qt], S[2 * s2 + 1][qt]); Bp[qt][s2] = __builtin_bit_cast(bf16x8, w); }
#pragma unroll
        for (int dt = 0; dt < 4; ++dt)
#pragma unroll
            for (int s2 = 0; s2 < 2; ++s2) {
                const bf16_t* vp = vT + (size_t)(h * 64 + dt * 16 + fr) * T + tokk + 32 * s2 + 4 * fq;
                const u32x2 lo = *(const u32x2*)vp, hi = *(const u32x2*)(vp + 16);
                const u32x4 w = {lo.x, lo.y, hi.x, hi.y}; const bf16x8 Av = __builtin_bit_cast(bf16x8, w);
#pragma unroll
                for (int qt = 0; qt < 2; ++qt) O[dt][qt] = __builtin_amdgcn_mfma_f32_16x16x32_bf16(Av, Bp[qt][s2], O[dt][qt], 0, 0, 0);
            }
    }
#pragma unroll
    for (int qt = 0; qt < 2; ++qt) {
        float l = lrun[qt]; l += __shfl_xor(l, 16); l += __shfl_xor(l, 32);
        const float inv = 1.0f / l;
#pragma unroll
        for (int dt = 0; dt < 4; ++dt) {
            const f32x4 o = O[dt][qt] * inv; u32x2 w; w.x = pg8::cvt_pk_bf16(o.x, o.y); w.y = pg8::cvt_pk_bf16(o.z, o.w);
            *(u32x2*)(oA + (tokq + qt * 16 + fr) * 512 + h * 64 + dt * 16 + 4 * fq) = w;
        }
    }
}
__device__ __forceinline__ void phase_attn(const Args& a, LAS unsigned char* lds, int layer, int wave, int lane, int tid, int G) {
    attn_stage_bias(a, lds, layer, tid);
    const LAS float* rb = (const LAS float*)lds;
    constexpr int NGRP = BATCH * A_HEADS * NCH / 4;
    const int per = (NGRP + G - 1) / G;
    for (int gi = 0; gi < per; ++gi) {
        const int grp = blockIdx.x * per + gi; if (grp >= NGRP) break;
        attn_item(a, rb, grp * 8 + wave, lane);
    }
    __syncthreads();
}


constexpr int PKR = 272, PKT = 144;
constexpr int G1_KR = 0, G1_LB = 4 * 64 * PKR, G1_CW = G1_LB + 65536, G1_GB = G1_CW + 8192, G1_BB = G1_GB + 1024, G1_GC = G1_BB + 1024, G1_END = G1_GC + 1024;
constexpr int G2_KR = 0, G2_QS = 17408, G2_KT = 34816, G2_VT = 53248, G2_VN = 71680, G2_QK = 90112, G2_ST = 99328, G2_CW = 134144, G2_SM = 140288, G2_WN = G2_SM + 2048, G2_END = G2_WN + 17408;
static_assert(G1_END <= LDS_BYTES - 16 && G2_END <= LDS_BYTES - 16, "gdn LDS maps");
#define MFMA16(a_, b_, c_) __builtin_amdgcn_mfma_f32_16x16x32_bf16((a_), (b_), (c_), 0, 0, 0)
#define LDSF(off) (*(const LAS bf16x8*)(lds + (off)))

__device__ __forceinline__ void gdn_pre_stage(const Args& a, LAS unsigned char* lds, int layer, int tid) {
    LAS float* cw = (LAS float*)(lds + G1_CW);
    const float* cwg = a.in[3] + (size_t)layer * 4 * 1536;
    for (int i = tid; i < 4 * 512; i += NTHR) cw[i] = cwg[(i >> 9) * 1536 + 512 + (i & 511)];
    __syncthreads();
}
__device__ __forceinline__ void gdn_pre_item(const Args& a, LAS unsigned char* lds, int layer, int item, int wave, int lane, int tid) {
    const int b = item >> 5, n = item & 31;
    const bf16_t* qkvB = (const bf16_t*)(a.ws + WS_QKVB); const float* bdl = (const float*)(a.ws + WS_BDL); float* gcg = (float*)(a.ws + WS_GC);
    const LAS float* cw = (const LAS float*)(lds + G1_CW); LAS float* gb = (LAS float*)(lds + G1_GB); LAS float* bb = (LAS float*)(lds + G1_BB); LAS float* gcb = (LAS float*)(lds + G1_GC);
    {
        const int tk = tid >> 3, cgp = tid & 7, hh = cgp >> 1, half = cgp & 1;
        const int tl = n * 64 + tk; const size_t r = (size_t)b * SEQ + tl;
        const int cbase = hh * 128 + half * 64;
        float kv[64];
#pragma unroll
        for (int c = 0; c < 64; ++c) kv[c] = 0.f;
#pragma unroll
        for (int i = 0; i < 4; ++i) {
            if (tl - 3 + i >= 0) {
                const u32x4* src = (const u32x4*)(qkvB + (r - 3 + i) * 1536 + 512 + cbase);
#pragma unroll
                for (int q = 0; q < 8; ++q) { const u32x4 w = src[q]; const LAS float* wp = cw + i * 512 + cbase + 8 * q;
                    const f32x4 w0 = *(const LAS f32x4*)wp, w1 = *(const LAS f32x4*)(wp + 4);
                    kv[8 * q + 0] += w0.x * bflo(w.x); kv[8 * q + 1] += w0.y * bfhi(w.x); kv[8 * q + 2] += w0.z * bflo(w.y); kv[8 * q + 3] += w0.w * bfhi(w.y);
                    kv[8 * q + 4] += w1.x * bflo(w.z); kv[8 * q + 5] += w1.y * bfhi(w.z); kv[8 * q + 6] += w1.z * bflo(w.w); kv[8 * q + 7] += w1.w * bfhi(w.w); }
            }
            asm volatile("" ::: "memory");
        }
        float ss = 0.f;
#pragma unroll
        for (int c = 0; c < 64; ++c) { kv[c] = siluf_(kv[c]); ss += kv[c] * kv[c]; }
        ss += __shfl_xor(ss, 1);
        const float rk = rsqrtf(ss + RMS_EPS);
        LAS unsigned char* dst = lds + G1_KR + hh * (64 * PKR) + tk * PKR + half * 128;
#pragma unroll
        for (int q = 0; q < 8; ++q) { f32x4 x0 = {kv[8 * q] * rk, kv[8 * q + 1] * rk, kv[8 * q + 2] * rk, kv[8 * q + 3] * rk}, x1 = {kv[8 * q + 4] * rk, kv[8 * q + 5] * rk, kv[8 * q + 6] * rk, kv[8 * q + 7] * rk};
            *(LAS u32x4*)(dst + 16 * q) = pack8(x0, x1); }
        if (half == 0) {
            const float Aexp = expf(a.in[4][layer * 4 + hh]), dtb = a.in[5][layer * 4 + hh];
            bb[hh * 64 + tk] = sigmoidf_(bdl[r * 8 + hh]);
            gb[hh * 64 + tk] = -Aexp * softplusf_(bdl[r * 8 + 4 + hh] + dtb);
        }
    }
    __syncthreads();
    {
        const int hh = wave >> 1, fr = lane & 15, fq = lane >> 4;
        float g = gb[hh * 64 + lane];
#pragma unroll
        for (int o = 1; o < 64; o <<= 1) { const float t = __shfl_up(g, o); if (lane >= o) g += t; }
        gcb[hh * 64 + lane] = g;
        if ((wave & 1) == 0) gcg[((size_t)b * SEQ + n * 64 + lane) * 4 + hh] = g;
        asm volatile("s_waitcnt lgkmcnt(0)" ::: "memory");
        const int kr = G1_KR + hh * (64 * PKR);
        LAS float* Lb = (LAS float*)(lds + G1_LB) + hh * 4096;
#pragma unroll
        for (int tt = 0; tt < 2; ++tt) {
            const int ti = 2 * (wave & 1) + tt;
            bf16x8 Af[4];
#pragma unroll
            for (int ks = 0; ks < 4; ++ks) Af[ks] = LDSF(kr + (ti * 16 + fr) * PKR + ks * 64 + fq * 16);
#pragma unroll
            for (int tj = 0; tj < 4; ++tj) {
                f32x4 acc = {0.f, 0.f, 0.f, 0.f};
                if (tj <= ti) {
#pragma unroll
                    for (int ks = 0; ks < 4; ++ks) acc = MFMA16(Af[ks], LDSF(kr + (tj * 16 + fr) * PKR + ks * 64 + fq * 16), acc);
                }
                const int j = tj * 16 + fr; const float gcj = gcb[hh * 64 + j];
#pragma unroll
                for (int rg = 0; rg < 4; ++rg) { const int i = ti * 16 + 4 * fq + rg;
                    Lb[i * 64 + j] = (i > j) ? bb[hh * 64 + i] * acc[rg] * __expf(gcb[hh * 64 + i] - gcj) : 0.f; }
            }
        }
    }
    __syncthreads();
    if (wave < 4) {
        const int hh = wave; const LAS float* Lb = (const LAS float*)(lds + G1_LB) + hh * 4096;
        float Tc[64];
        int ln = lane; asm volatile("" : "+v"(ln));
#pragma unroll
        for (int i = 0; i < 64; ++i) {
            float acc = (ln == i) ? 1.f : 0.f;
#pragma unroll
            for (int j4 = 0; j4 < (i + 3) / 4; ++j4) { const f32x4 l4 = *(const LAS f32x4*)(Lb + i * 64 + 4 * j4);
                if (4 * j4 + 0 < i) acc -= l4.x * Tc[4 * j4 + 0];
                if (4 * j4 + 1 < i) acc -= l4.y * Tc[4 * j4 + 1];
                if (4 * j4 + 2 < i) acc -= l4.z * Tc[4 * j4 + 2];
                if (4 * j4 + 3 < i) acc -= l4.w * Tc[4 * j4 + 3]; }
            Tc[i] = acc;
            if ((i & 3) == 3) asm volatile("" ::: "memory");
        }
        const float bc = bb[hh * 64 + lane], ec = bc * __expf(gcb[hh * 64 + lane]);
        bf16_t* tu = (bf16_t*)(a.ws + WS_TMU) + ((size_t)item * 4 + hh) * 4096; bf16_t* tw = (bf16_t*)(a.ws + WS_TMW) + ((size_t)item * 4 + hh) * 4096;
#pragma unroll
        for (int i = 0; i < 64; ++i) { tu[i * 64 + lane] = (bf16_t)f2bf(Tc[i] * bc); tw[i * 64 + lane] = (bf16_t)f2bf(Tc[i] * ec); }
    }
    __syncthreads();
}

__device__ __forceinline__ void st8(LAS unsigned char* p, f32x4 v) { u32x2 w; w.x = pg8::cvt_pk_bf16(v.x, v.y); w.y = pg8::cvt_pk_bf16(v.z, v.w); *(LAS u32x2*)p = w; }

__device__ __forceinline__ void gdn_scan_item(const Args& a, LAS unsigned char* lds, int layer, int item, int wave, int lane, int tid) {
    const int b = item >> 2, h = item & 3, fr = lane & 15, fq = lane >> 4;
    const bf16_t* qkvB = (const bf16_t*)(a.ws + WS_QKVB); const float* bdl = (const float*)(a.ws + WS_BDL); const float* gcg = (const float*)(a.ws + WS_GC);
    const bf16_t* gateB = (const bf16_t*)(a.ws + WS_GATEB);
    bf16_t* oB = (bf16_t*)(a.ws + WS_OB);
    LAS float* cwl = (LAS float*)(lds + G2_CW);
    LAS float* gcs = (LAS float*)(lds + G2_SM); LAS float* egc = gcs + 64; LAS float* ekd = gcs + 128; LAS float* ng = gcs + 192; LAS float* red = gcs + 320;
    {
        const float* cwg = a.in[3] + (size_t)layer * 4 * 1536;
        for (int i = tid; i < 4 * 384; i += NTHR) { const int tap = i / 384, rem = i % 384, seg = rem >> 7, c = rem & 127; cwl[i] = cwg[tap * 1536 + seg * 512 + h * 128 + c]; }
        for (int i = tid; i < 128; i += NTHR) ng[i] = a.in[6][layer * 128 + i];
        for (int i = tid; i < 34816 / 16; i += NTHR) ((LAS u32x4*)(lds + G2_ST))[i] = (u32x4){0u, 0u, 0u, 0u};
    }
    f32x4 Sacc[8];
#pragma unroll
    for (int i = 0; i < 8; ++i) Sacc[i] = (f32x4){0.f, 0.f, 0.f, 0.f};
    __syncthreads();
    for (int n = 0; n < NCH; ++n) {
        const size_t tok0 = (size_t)b * SEQ + n * 64;
        int zv_ = 0; asm volatile("" : "+v"(zv_));
        const float gcl = gcg[(tok0 + 63) * 4 + h + zv_];
        {
            const int tk = tid >> 3, cgp = tid & 7, c0 = cgp * 16;
            const int tl = n * 64 + tk; const size_t r = tok0 + tk;
            float qkv[3][16];
#pragma unroll
            for (int c = 0; c < 16; ++c) { qkv[0][c] = 0.f; qkv[1][c] = 0.f; qkv[2][c] = 0.f; }
#pragma unroll
            for (int i = 0; i < 4; ++i) {
                if (tl - 3 + i >= 0) {
                    const bf16_t* rowp = qkvB + (r - 3 + i) * 1536 + h * 128 + c0;
#pragma unroll
                    for (int seg = 0; seg < 3; ++seg) {
                        const u32x4 x0 = *(const u32x4*)(rowp + seg * 512), x1 = *(const u32x4*)(rowp + seg * 512 + 8);
                        const LAS float* wp = cwl + i * 384 + seg * 128 + c0;
                        const f32x4 w0 = *(const LAS f32x4*)wp, w1 = *(const LAS f32x4*)(wp + 4), w2 = *(const LAS f32x4*)(wp + 8), w3 = *(const LAS f32x4*)(wp + 12);
                        float (&d)[16] = qkv[seg];
                        d[0] += w0.x * bflo(x0.x); d[1] += w0.y * bfhi(x0.x); d[2] += w0.z * bflo(x0.y); d[3] += w0.w * bfhi(x0.y);
                        d[4] += w1.x * bflo(x0.z); d[5] += w1.y * bfhi(x0.z); d[6] += w1.z * bflo(x0.w); d[7] += w1.w * bfhi(x0.w);
                        d[8] += w2.x * bflo(x1.x); d[9] += w2.y * bfhi(x1.x); d[10] += w2.z * bflo(x1.y); d[11] += w2.w * bfhi(x1.y);
                        d[12] += w3.x * bflo(x1.z); d[13] += w3.y * bfhi(x1.z); d[14] += w3.z * bflo(x1.w); d[15] += w3.w * bfhi(x1.w);
                    }
                }
            }
            float (&q)[16] = qkv[0]; float (&k)[16] = qkv[1]; float (&v)[16] = qkv[2];
            float sq = 0.f, sk = 0.f;
#pragma unroll
            for (int c = 0; c < 16; ++c) { q[c] = siluf_(q[c]); k[c] = siluf_(k[c]); v[c] = siluf_(v[c]); sq += q[c] * q[c]; sk += k[c] * k[c]; }
            sq += __shfl_xor(sq, 1); sk += __shfl_xor(sk, 1); sq += __shfl_xor(sq, 2); sk += __shfl_xor(sk, 2); sq += __shfl_xor(sq, 4); sk += __shfl_xor(sk, 4);
            const float rq = rsqrtf(sq + RMS_EPS) * 0.08838834764831845f, rk = rsqrtf(sk + RMS_EPS);
            const float gc = gcg[r * 4 + h];
            unsigned kb[8], vb[8];
#pragma unroll
            for (int c = 0; c < 8; ++c) { kb[c] = pg8::cvt_pk_bf16(k[2 * c] * rk, k[2 * c + 1] * rk); vb[c] = pg8::cvt_pk_bf16(v[2 * c], v[2 * c + 1]); }
            *(LAS u32x4*)(lds + G2_KR + tk * PKR + c0 * 2) = (u32x4){kb[0], kb[1], kb[2], kb[3]}; *(LAS u32x4*)(lds + G2_KR + tk * PKR + c0 * 2 + 16) = (u32x4){kb[4], kb[5], kb[6], kb[7]};
            {
                f32x4 a0 = {q[0] * rq, q[1] * rq, q[2] * rq, q[3] * rq}, a1 = {q[4] * rq, q[5] * rq, q[6] * rq, q[7] * rq}, a2 = {q[8] * rq, q[9] * rq, q[10] * rq, q[11] * rq}, a3 = {q[12] * rq, q[13] * rq, q[14] * rq, q[15] * rq};
                *(LAS u32x4*)(lds + G2_QS + tk * PKR + c0 * 2) = pack8(a0, a1); *(LAS u32x4*)(lds + G2_QS + tk * PKR + c0 * 2 + 16) = pack8(a2, a3);
            }
            {
                const int odd = tk & 1;
#pragma unroll
                for (int c = 0; c < 8; ++c) {
                    const unsigned pk_ = (unsigned)__shfl_xor((int)kb[c], 8), pv_ = (unsigned)__shfl_xor((int)vb[c], 8);
                    const unsigned wk = odd ? ((pk_ >> 16) | (kb[c] & 0xffff0000u)) : ((kb[c] & 0xffffu) | (pk_ << 16));
                    const unsigned wv = odd ? ((pv_ >> 16) | (vb[c] & 0xffff0000u)) : ((vb[c] & 0xffffu) | (pv_ << 16));
                    *(LAS unsigned*)(lds + G2_KT + (c0 + 2 * c + odd) * PKT + (tk & ~1) * 2) = wk;
                    *(LAS unsigned*)(lds + G2_VT + (c0 + 2 * c + odd) * PKT + (tk & ~1) * 2) = wv;
                }
            }
            if (cgp == 0) { gcs[tk] = gc; egc[tk] = __expf(gc); ekd[tk] = __expf(gcl - gc); }
        }
        const float gl = __expf(gcl);
        const bf16_t* tmu = (const bf16_t*)(a.ws + WS_TMU) + (((size_t)(b * 32 + n)) * 4 + h) * 4096; const bf16_t* tmw = (const bf16_t*)(a.ws + WS_TMW) + (((size_t)(b * 32 + n)) * 4 + h) * 4096;
        __syncthreads();
        {
            const int tj = wave & 3;
#pragma unroll
            for (int tt = 0; tt < 2; ++tt) {
                const int ti = 2 * (wave >> 2) + tt;
                f32x4 acc = {0.f, 0.f, 0.f, 0.f};
                if (ti >= tj) {
#pragma unroll
                    for (int ks = 0; ks < 4; ++ks) acc = MFMA16(LDSF(G2_KR + (tj * 16 + fr) * PKR + ks * 64 + fq * 16), LDSF(G2_QS + (ti * 16 + fr) * PKR + ks * 64 + fq * 16), acc);
                }
                const int i = ti * 16 + fr; const float gci = gcs[i];
                f32x4 o;
#pragma unroll
                for (int rg = 0; rg < 4; ++rg) { const int j = tj * 16 + 4 * fq + rg; o[rg] = (i >= j) ? acc[rg] * __expf(gci - gcs[j]) : 0.f; }
                st8(lds + G2_QK + i * PKT + (tj * 16 + 4 * fq) * 2, o);
            }
        }
        {
            const bf16x8 A0 = LDSF(G2_KT + (wave * 16 + fr) * PKT + fq * 16), A1 = LDSF(G2_KT + (wave * 16 + fr) * PKT + 64 + fq * 16);
#pragma unroll
            for (int it = 0; it < 4; ++it) {
                const bf16x8 B0 = *(const bf16x8*)(tmw + (it * 16 + fr) * 64 + 8 * fq), B1 = *(const bf16x8*)(tmw + (it * 16 + fr) * 64 + 32 + 8 * fq);
                f32x4 acc = {0.f, 0.f, 0.f, 0.f};
                acc = MFMA16(A0, B0, acc); acc = MFMA16(A1, B1, acc);
                st8(lds + G2_WN + (it * 16 + fr) * PKR + (wave * 16 + 4 * fq) * 2, -acc);
            }
        }
        __syncthreads();
        f32x4 vn[4];
        {
            bf16x8 Bv[2], Bs[4];
#pragma unroll
            for (int ks = 0; ks < 2; ++ks) Bv[ks] = LDSF(G2_VT + (wave * 16 + fr) * PKT + ks * 64 + fq * 16);
#pragma unroll
            for (int ks = 0; ks < 4; ++ks) Bs[ks] = LDSF(G2_ST + (wave * 16 + fr) * PKR + ks * 64 + fq * 16);
#pragma unroll
            for (int it = 0; it < 4; ++it) {
                f32x4 acc = {0.f, 0.f, 0.f, 0.f};
#pragma unroll
                for (int ks = 0; ks < 2; ++ks) acc = MFMA16(*(const bf16x8*)(tmu + (it * 16 + fr) * 64 + ks * 32 + 8 * fq), Bv[ks], acc);
#pragma unroll
                for (int ks = 0; ks < 4; ++ks) acc = MFMA16(LDSF(G2_WN + (it * 16 + fr) * PKR + ks * 64 + fq * 16), Bs[ks], acc);
                vn[it] = acc;
            }
        }
        __syncthreads();
#pragma unroll
        for (int it = 0; it < 4; ++it) {
            st8(lds + G2_VN + (wave * 16 + fr) * PKT + (it * 16 + 4 * fq) * 2, vn[it]);
            const f32x4 e4 = *(const LAS f32x4*)(ekd + it * 16 + 4 * fq);
            st8(lds + G2_VT + (wave * 16 + fr) * PKT + (it * 16 + 4 * fq) * 2, vn[it] * e4);
        }
        __syncthreads();
        {
            const int it = wave & 3, dq = 4 * (wave >> 2);
            const size_t tok = tok0 + it * 16 + fr;
            u32x2 gt[4];
#pragma unroll
            for (int x = 0; x < 4; ++x) gt[x] = *(const u32x2*)(gateB + tok * 512 + h * 128 + (dq + x) * 16 + 4 * fq);
            bf16x8 Bq[4], Bk[2];
#pragma unroll
            for (int ks = 0; ks < 4; ++ks) Bq[ks] = LDSF(G2_QS + (it * 16 + fr) * PKR + ks * 64 + fq * 16);
#pragma unroll
            for (int ks = 0; ks < 2; ++ks) Bk[ks] = LDSF(G2_QK + (it * 16 + fr) * PKT + ks * 64 + fq * 16);
            const float eg = egc[it * 16 + fr];
            f32x4 O[4]; float ss = 0.f;
#pragma unroll
            for (int x = 0; x < 4; ++x) {
                f32x4 acc = {0.f, 0.f, 0.f, 0.f};
#pragma unroll
                for (int ks = 0; ks < 4; ++ks) acc = MFMA16(LDSF(G2_ST + ((dq + x) * 16 + fr) * PKR + ks * 64 + fq * 16), Bq[ks], acc);
                acc = acc * eg;
#pragma unroll
                for (int ks = 0; ks < 2; ++ks) acc = MFMA16(LDSF(G2_VN + ((dq + x) * 16 + fr) * PKT + ks * 64 + fq * 16), Bk[ks], acc);
                O[x] = acc; ss += (acc.x * acc.x + acc.y * acc.y) + (acc.z * acc.z + acc.w * acc.w);
            }
            ss += __shfl_xor(ss, 16); ss += __shfl_xor(ss, 32);
            if (fq == 0) red[(wave >> 2) * 64 + it * 16 + fr] = ss;
            {
                const bf16x8 A0 = LDSF(G2_KT + (wave * 16 + fr) * PKT + fq * 16), A1 = LDSF(G2_KT + (wave * 16 + fr) * PKT + 64 + fq * 16);
#pragma unroll
                for (int dv = 0; dv < 8; ++dv) {
                    f32x4 acc = Sacc[dv] * gl;
                    acc = MFMA16(A0, LDSF(G2_VT + (dv * 16 + fr) * PKT + fq * 16), acc);
                    acc = MFMA16(A1, LDSF(G2_VT + (dv * 16 + fr) * PKT + 64 + fq * 16), acc);
                    Sacc[dv] = acc;
                }
            }
            __syncthreads();
            const float tot = red[it * 16 + fr] + red[64 + it * 16 + fr];
            const float rstd = rsqrtf(tot * (1.0f / 128.0f) + RMS_EPS);
#pragma unroll
            for (int x = 0; x < 4; ++x) {
                const f32x4 g4 = *(const LAS f32x4*)(ng + (dq + x) * 16 + 4 * fq);
                const float t0 = bflo(gt[x].x), t1 = bfhi(gt[x].x), t2 = bflo(gt[x].y), t3 = bfhi(gt[x].y);
                f32x4 o = O[x] * rstd * g4; o.x *= t0 * fsig(t0); o.y *= t1 * fsig(t1); o.z *= t2 * fsig(t2); o.w *= t3 * fsig(t3);
                u32x2 w; w.x = pg8::cvt_pk_bf16(o.x, o.y); w.y = pg8::cvt_pk_bf16(o.z, o.w);
                *(u32x2*)(oB + tok * 512 + h * 128 + (dq + x) * 16 + 4 * fq) = w;
            }
#pragma unroll
            for (int dv = 0; dv < 8; ++dv) st8(lds + G2_ST + (dv * 16 + fr) * PKR + (wave * 16 + 4 * fq) * 2, Sacc[dv]);
        }
        __syncthreads();
    }
}


constexpr int CW_ATTQ = 65536;
__device__ __forceinline__ void phase_pre(const Args& a, LAS unsigned char* lds, int layer, int gw, int NGW, int wave, int lane, int tid, int G) {
    gdn_pre_stage(a, lds, layer, tid);
    for (int item = blockIdx.x; item < BATCH * NCH; item += G) gdn_pre_item(a, lds, layer, item, wave, lane, tid);
    phase_pool(a, gw, NGW, lane);
}
__device__ __forceinline__ void phase_mix(const Args& a, LAS unsigned char* lds, int layer, int wave, int lane, int tid, int G) {
    for (int item = blockIdx.x; item < BATCH * B_HEADS; item += G) gdn_scan_item(a, lds, layer, item, wave, lane, tid);
    __syncthreads();
    attn_stage_bias(a, lds, layer, tid);
    const LAS float* rb = (const LAS float*)lds;
    LAS int* qslot = (LAS int*)(lds + 16384);
    unsigned* qctr = (unsigned*)(a.ws + WS_CTL) + CW_ATTQ + layer * 64;
    constexpr int NGRP = BATCH * A_HEADS * NCH / 4;
    for (;;) {
        if (tid == 0) *qslot = (int)__hip_atomic_fetch_add(qctr, 1u, __ATOMIC_RELAXED, __HIP_MEMORY_SCOPE_AGENT);
        __syncthreads();
        const int grp = *qslot;
        __syncthreads();
        if (grp >= NGRP) break;
        attn_item(a, rb, grp * 8 + wave, lane);
    }
}

#define XB_TMO      128
#define XB_XCNT(j)  (256  + 64 * (j))
#define XB_XSUB(j)  (1280 + 64 * (j))
#define XB_XGEN(j)  (2304 + 64 * (j))
#define XB_TOP      3328
#define XB_TOPGEN   3392
#define XCD_BAR_WORDS 3456
#define XB_SPIN_CAP (1u << 18)

__device__ __forceinline__ unsigned xb_ld(unsigned* p)              { return __hip_atomic_load(p, __ATOMIC_RELAXED, __HIP_MEMORY_SCOPE_AGENT); }
__device__ __forceinline__ unsigned xb_add(unsigned* p, unsigned v) { return __hip_atomic_fetch_add(p, v, __ATOMIC_RELAXED, __HIP_MEMORY_SCOPE_AGENT); }
__device__ __forceinline__ unsigned xb_xcc_id() { return (unsigned)__builtin_amdgcn_s_getreg((3 << 11) | 20) & 0xFu; }
#define XB_SPIN(cond, bar) do { unsigned _sp = 0; while (cond) { __builtin_amdgcn_s_sleep(1); \
    if ((++_sp & 255u) == 0u) { if (xb_ld(&(bar)[XB_TMO])) break; if (_sp > XB_SPIN_CAP) { atomicAdd(&(bar)[XB_TMO], 1u); break; } } } } while (0)

struct XcdBarrier {
    unsigned* bar; unsigned x;
    volatile LAS unsigned* st;
};

__device__ __forceinline__ XcdBarrier xcd_barrier_post(unsigned* bar, volatile LAS unsigned* st) {
    XcdBarrier b; b.bar = bar; b.x = xb_xcc_id(); b.st = st;
    if (threadIdx.x == 0) (void)xb_add(&bar[XB_XCNT(b.x)], 1u);
    return b;
}
__device__ __forceinline__ void xcd_barrier_complete(unsigned* bar, unsigned x, unsigned& nloc, unsigned& nx) {
    const unsigned G = gridDim.x * gridDim.y * gridDim.z;
    unsigned sum, cnt, mine, sp = 0u;
    for (;;) {
        sum = 0u; cnt = 0u; mine = 0u;
#pragma unroll
        for (unsigned j = 0; j < 16; ++j) { const unsigned c = xb_ld(&bar[XB_XCNT(j)]); sum += c; cnt += (c > 0u) ? 1u : 0u; mine = (j == x) ? c : mine; }
        if (sum == G) break;
        __builtin_amdgcn_s_sleep(1);
        if ((++sp & 255u) == 0u) { if (xb_ld(&bar[XB_TMO])) break; if (sp > XB_SPIN_CAP) { atomicAdd(&bar[XB_TMO], 1u); break; } }
    }
    nloc = mine > 0u ? mine : 1u; nx = cnt > 0u ? cnt : 1u;
}

__device__ __forceinline__ void xcd_barrier(const XcdBarrier& b) {
    asm volatile("s_waitcnt vmcnt(0)" ::: "memory");
    __syncthreads();
    if (threadIdx.x == 0) {
        unsigned* bar = b.bar;
        __builtin_amdgcn_s_waitcnt(0);
        unsigned nloc = b.st[0], nx = b.st[1];
        if (nloc == 0u) { xcd_barrier_complete(bar, b.x, nloc, nx); b.st[0] = nloc; b.st[1] = nx; }
        const unsigned old = xb_add(&bar[XB_XSUB(b.x)], 1u);
        const unsigned gen = old / nloc;
        if (old + 1u == (gen + 1u) * nloc) {
            __builtin_amdgcn_fence(__ATOMIC_RELEASE, "agent");
            asm volatile("s_waitcnt vmcnt(0)" ::: "memory");
            const unsigned og = xb_add(&bar[XB_TOP], 1u);
            const unsigned tg = og / nx;
            if (og + 1u == (tg + 1u) * nx) xb_add(&bar[XB_TOPGEN], 1u);
            else XB_SPIN(xb_ld(&bar[XB_TOPGEN]) == tg, bar);
            __builtin_amdgcn_fence(__ATOMIC_ACQUIRE, "agent");
            xb_add(&bar[XB_XGEN(b.x)], 1u);
            asm volatile("s_waitcnt vmcnt(0)" ::: "memory");
        } else {
            XB_SPIN(xb_ld(&bar[XB_XGEN(b.x)]) == gen, bar);
            __builtin_amdgcn_fence(__ATOMIC_ACQUIRE, "agent");
            asm volatile("s_waitcnt vmcnt(0)" ::: "memory");
        }
    }
    __syncthreads();
}


constexpr int CW_BAR = 4096;
constexpr int LDS_BARW = LDS_BYTES - 16;
#define IN(k) (a.ph_lo <= (k) && (k) < a.ph_hi)
#define SEAM(k) do { if (fused && !((k) == PH_COUNT - 1 && layer == a.lay_hi - 1) && !((k) == a.ph_hi - 1 && a.ph_hi < PH_COUNT)) xcd_barrier(bar); } while (0)
template <int layer> __device__ __forceinline__ void layer_prog(const Args& a, LAS unsigned char* lds, const XcdBarrier& bar, bool fused, int gw, int NGW, int wave, int lane, int tid, int gtid, int GT, int G) {
        if (IN(PH_CONVERT)) { phase_convert(a, lds, layer, gw, NGW, wave, lane, tid, gtid, GT); if (layer == 0) { __syncthreads(); phase_xconv(a, lds, gw, NGW, lane, tid); } SEAM(PH_CONVERT); }
        if (IN(PH_PROJ1)) { phase_g_proj1(a, lds, G, (int)blockIdx.x); SEAM(PH_PROJ1); }
        if (IN(PH_PRE)) { phase_pre(a, lds, layer, gw, NGW, wave, lane, tid, G); SEAM(PH_PRE); }
        if (IN(PH_MIX)) { phase_mix(a, lds, layer, wave, lane, tid, G); SEAM(PH_MIX); }
        if (IN(PH_GATES)) { phase_g_gates(a, lds, layer, G, (int)blockIdx.x); SEAM(PH_GATES); }
        if (IN(PH_BRANCH)) { phase_g_branch(a, lds, G, (int)blockIdx.x); SEAM(PH_BRANCH); }
        if (IN(PH_OUT)) { phase_g_out(a, lds, G, (int)blockIdx.x); SEAM(PH_OUT); }
        if (IN(PH_LN1)) { phase_ln1(a, layer, gw, NGW, lane); SEAM(PH_LN1); }
        if (IN(PH_SLOTS)) { phase_slots(a, lds, gw, NGW, wave, lane, tid); SEAM(PH_SLOTS); }
        if (IN(PH_MOE1)) { phase_moe1(a, lds, G, (int)blockIdx.x, tid); SEAM(PH_MOE1); }
        if (IN(PH_MOE2)) { phase_moe2(a, lds, G, (int)blockIdx.x, tid); SEAM(PH_MOE2); }
        if (IN(PH_LN2)) { phase_ln2(a, lds, layer, gw, NGW, lane, tid); SEAM(PH_LN2); }
}
#undef IN
#undef SEAM
__global__ void __launch_bounds__(NTHR, 2) mk(Args a) {
    extern __shared__ __attribute__((aligned(16))) unsigned char lds_raw[];
    LAS unsigned char* lds = (LAS unsigned char*)lds_raw;
    const int tid = threadIdx.x, lane = tid & 63, wave = __builtin_amdgcn_readfirstlane(tid >> 6);
    const int G = gridDim.x, gw = blockIdx.x * NWAVES + wave, NGW = G * NWAVES, gtid = blockIdx.x * NTHR + tid, GT = G * NTHR;
    const bool fused = (a.ph_hi - a.ph_lo > 1) || (a.lay_hi - a.lay_lo > 1);
    if (tid == 0) *(LAS u32x4*)(lds + LDS_BARW) = (u32x4){0u, 0u, 0u, 0u};
    __syncthreads();
    XcdBarrier bar; bar.bar = (unsigned*)(a.ws + WS_CTL) + CW_BAR; bar.x = 0; bar.st = (volatile LAS unsigned*)(lds + LDS_BARW);
    if (fused) bar = xcd_barrier_post((unsigned*)(a.ws + WS_CTL) + CW_BAR, (volatile LAS unsigned*)(lds + LDS_BARW));
    if (a.lay_lo <= 0 && 0 < a.lay_hi) layer_prog<0>(a, lds, bar, fused, gw, NGW, wave, lane, tid, gtid, GT, G);
    if (a.lay_lo <= 1 && 1 < a.lay_hi) layer_prog<1>(a, lds, bar, fused, gw, NGW, wave, lane, tid, gtid, GT, G);
}

extern "C" void kernel_launch(void* const* d_in, const int* in_sizes, int n_in, void* d_out, int out_size, void* d_ws, size_t ws_size, hipStream_t stream) {
    static int grid = 0;
    if (grid == 0) {
        if (n_in != 25 || in_sizes[0] != T * D || out_size != T * D || ws_size < WS_END) { fprintf(stderr, "kernel_launch: unexpected shapes (n_in %d, in0 %d, out %d, ws %zu < %zu)\n", n_in, n_in > 0 ? in_sizes[0] : -1, out_size, ws_size, (size_t)WS_END); grid = -1; return; }
        int dev = 0, cus = 0;
        if (hipGetDevice(&dev) != hipSuccess || hipDeviceGetAttribute(&cus, hipDeviceAttributeMultiprocessorCount, dev) != hipSuccess) { grid = -1; return; }
        if (hipFuncSetAttribute((const void*)mk, hipFuncAttributeMaxDynamicSharedMemorySize, LDS_BYTES) != hipSuccess) { fprintf(stderr, "kernel_launch: hipFuncSetAttribute failed\n"); grid = -1; return; }
        grid = cus;
    }
    if (grid < 0) return;
    unsigned char* ws = (unsigned char*)d_ws;
    (void)hipMemsetAsync(ws + WS_CTL, 0, 1 * MiB, stream);
    Args a{};
    for (int i = 0; i < 25; ++i) a.in[i] = (const float*)d_in[i];
    a.out = (float*)d_out; a.ws = ws;
#if MK_N_LAUNCHES == 1
    a.lay_lo = 0; a.lay_hi = DEPTH; a.ph_lo = 0; a.ph_hi = PH_COUNT;
    hipLaunchKernelGGL(mk, dim3(grid), dim3(NTHR), LDS_BYTES, stream, a);
#else
    for (int layer = 0; layer < DEPTH; ++layer) for (int ph = 0; ph < PH_COUNT; ++ph) { a.lay_lo = layer; a.lay_hi = layer + 1; a.ph_lo = ph; a.ph_hi = ph + 1; hipLaunchKernelGGL(mk, dim3(grid), dim3(NTHR), LDS_BYTES, stream, a); }
#endif
}
```

```cpp
#include <hip/hip_runtime.h>
#include <cstdio>
#include <cstdint>
#ifndef PROBE_PH
#define PROBE_PH (-1)
#endif
#ifndef PROBE_MIX
#define PROBE_MIX 0
#endif
#ifndef PROBE_REP
#define PROBE_REP 2
#endif
#ifndef MK_N_LAUNCHES
#define MK_N_LAUNCHES 1
#endif

#define GAS __attribute__((address_space(1)))
#define LAS __attribute__((address_space(3)))
typedef unsigned short bf16_t;
typedef short bf16x8 __attribute__((ext_vector_type(8)));
typedef float f32x4 __attribute__((ext_vector_type(4)));
typedef float f32x2 __attribute__((ext_vector_type(2)));
typedef unsigned u32x4 __attribute__((ext_vector_type(4)));
typedef unsigned u32x2 __attribute__((ext_vector_type(2)));

namespace pg8 {
#define PG8_LAS __attribute__((address_space(3)))
typedef unsigned short bf16_t;
typedef short bf16x8 __attribute__((ext_vector_type(8)));
typedef float f32x4 __attribute__((ext_vector_type(4)));
typedef unsigned u32x4 __attribute__((ext_vector_type(4)));
constexpr int BM = 256, BK = 64, HALF = 128, HTB = HALF * BK * 2  , STAGE_BYTES = 8 * HTB, NXCD = 8, WGM = 8;

__host__ __device__ __forceinline__ int lds_byte(int r, int c) { const int st = (r >> 4) * 2 + (c >> 5), rr = r & 15, cc = c & 31, ob = rr * 64 + cc * 2; return st * 1024 + (ob ^ (((ob >> 9) & 1) << 5)); }
__host__ __device__ __forceinline__ void stage_rc(int b, int& R, int& C) { const int st = b / 1024, sb = b % 1024, swz = sb ^ (((sb >> 9) & 1) << 5); R = (st >> 1) * 16 + swz / 64; C = (st & 1) * 32 + (swz % 64) / 2; }
__host__ __device__ __forceinline__ int perm32(int rho) { const int n = rho >> 4, i = rho & 15; return 8 * (i >> 2) + 4 * n + (i & 3); }

struct Unit { int pm, pn; };
struct Gemm { const bf16_t* A; const bf16_t* Bt; int M, N, K; };

struct StaticOrder {
    int nM, nN, nwg, G, c;
    __host__ __device__ void init(int M, int N, int G_, int c_) { nM = M / BM; nN = N / BM; nwg = nM * nN; G = G_; c = c_; }
    __host__ __device__ bool next(int i, Unit& u) const {
        const long L = (long)i * G + c; if (L >= nwg) return false;
        int wgid = (int)L; { const int q = nwg / NXCD, r = nwg % NXCD, xcd = wgid % NXCD, off = wgid / NXCD; wgid = (xcd < r ? xcd * (q + 1) : r * (q + 1) + (xcd - r) * q) + off; }
        const int nig = WGM * nN, gid = wgid / nig, fm = gid * WGM, gsz = (nM - fm) < WGM ? (nM - fm) : WGM;
        u.pm = fm + ((wgid % nig) % gsz); u.pn = (wgid % nig) / gsz; return true;
    }
    __device__ __forceinline__ void a_ready(const Unit&) const {}
    __device__ __forceinline__ void done(const Unit&) const {}
};
typedef float f32x2_ __attribute__((ext_vector_type(2)));
typedef __bf16 bf16x2_ __attribute__((ext_vector_type(2)));
__device__ __forceinline__ unsigned cvt_pk_bf16(float lo, float hi) { const f32x2_ v = {lo, hi}; return __builtin_bit_cast(unsigned, __builtin_convertvector(v, bf16x2_)); }
template <class Epi, class Sched, bool ALIGN_EPI = false, bool SP2 = false>
__device__ __forceinline__ void gemm_phase(PG8_LAS unsigned char* lds, const Gemm g, const Sched& S, const Epi& E, const int wid, const int lane) {
    const int tid = wid * 64 + lane, wr = wid >> 2, wc = wid & 3, fr = lane & 15, fq = lane >> 4;
    const int K = g.K, nt = K / BK;
    unsigned voffA[2], voffB[2];
#pragma unroll
    for (int i = 0; i < 2; ++i) { int R, C; stage_rc(tid * 16 + i * 8192, R, C); const int Rb = Epi::PERM ? ((R & ~31) + perm32(R & 31)) : R;
        voffA[i] = (unsigned)(R * K + C) * 2u; voffB[i] = (unsigned)(Rb * K + C) * 2u; }
    const size_t kstep = (size_t)(BK * 2);
    const size_t hstep = (size_t)HALF * K * 2;
    const size_t tstep = 2 * hstep;
    const unsigned ldsw = (unsigned)wid * 1024u;
    const int aoff = lds_byte(wr * 64 + fr, fq * 8), boff = lds_byte(wc * 32 + fr, fq * 8);
#define PG8_SA(b, h) (((b) * 2 + (h)) * HTB)
#define PG8_SB(b, h) ((4 + (b) * 2 + (h)) * HTB)
#define PG8_STAGE(bufoff, gbase, voff) do { _Pragma("unroll") for (int _i = 0; _i < 2; ++_i) \
        __builtin_amdgcn_global_load_lds((const unsigned*)((const char*)(gbase) + (voff)[_i]), (PG8_LAS unsigned*)(lds + (bufoff) + ldsw + _i * 8192), 16, 0, 0); } while (0)
#define PG8_LDA(dst, b, h) do { _Pragma("unroll") for (int m = 0; m < 4; ++m) _Pragma("unroll") for (int k = 0; k < 2; ++k) dst[m][k] = *(const PG8_LAS bf16x8*)(lds + PG8_SA(b, h) + aoff + m * 2048 + k * 1024); } while (0)
#define PG8_LDB(dst, b, h) do { _Pragma("unroll") for (int n = 0; n < 2; ++n) _Pragma("unroll") for (int k = 0; k < 2; ++k) dst[n][k] = *(const PG8_LAS bf16x8*)(lds + PG8_SB(b, h) + boff + n * 2048 + k * 1024); } while (0)
#define PG8_MMA(ai, bj, At, Bt) do { __builtin_amdgcn_s_setprio(1); _Pragma("unroll") for (int m = 0; m < 4; ++m) _Pragma("unroll") for (int n = 0; n < 2; ++n) _Pragma("unroll") for (int k = 0; k < 2; ++k) \
        acc[ai][bj][m][n] = __builtin_amdgcn_mfma_f32_16x16x32_bf16(Bt[n][k], At[m][k], acc[ai][bj][m][n], 0, 0, 0); __builtin_amdgcn_s_setprio(0); } while (0)
#define PG8_WAIT_V(n) asm volatile("s_waitcnt vmcnt(" #n ")" ::: "memory")
#define PG8_WAIT_L(n) asm volatile("s_waitcnt lgkmcnt(" #n ")" ::: "memory")
#define PG8_BAR __builtin_amdgcn_s_barrier()
#define PG8_SCHED __builtin_amdgcn_sched_barrier(0)
    Unit cur, nxt; int ui = 0;
    if (!S.next(0, cur)) return;
    f32x4 acc[2][2][4][2];
#pragma unroll
    for (int a = 0; a < 2; ++a)
#pragma unroll
        for (int b = 0; b < 2; ++b)
#pragma unroll
            for (int m = 0; m < 4; ++m)
#pragma unroll
                for (int n = 0; n < 2; ++n) acc[a][b][m][n] = (f32x4){0.f, 0.f, 0.f, 0.f};
    bf16x8 At[4][2], B0[2][2], B1[2][2];
    const char* cA = (const char*)g.A + (size_t)cur.pm * tstep; const char* cB = (const char*)g.Bt + (size_t)cur.pn * tstep;
    S.a_ready(cur);
    if constexpr (SP2) {
        PG8_STAGE(PG8_SB(0, 0), cB, voffB); PG8_STAGE(PG8_SB(0, 1), cB + hstep, voffB); PG8_STAGE(PG8_SA(0, 0), cA, voffA); PG8_STAGE(PG8_SA(0, 1), cA + hstep, voffA);
        if (wr == 1) PG8_BAR;
        PG8_WAIT_V(2); PG8_BAR;
        PG8_STAGE(PG8_SB(1, 0), cB + kstep, voffB); PG8_STAGE(PG8_SA(1, 0), cA + kstep, voffA); PG8_STAGE(PG8_SB(1, 1), cB + hstep + kstep, voffB);
        PG8_WAIT_V(6); PG8_BAR;
    } else {
        PG8_STAGE(PG8_SB(0, 0), cB, voffB); PG8_STAGE(PG8_SA(0, 0), cA, voffA); PG8_STAGE(PG8_SB(0, 1), cB + hstep, voffB); PG8_STAGE(PG8_SA(0, 1), cA + hstep, voffA);
        if (wr == 1) PG8_BAR;
        PG8_WAIT_V(4); PG8_BAR;
        PG8_STAGE(PG8_SB(1, 0), cB + kstep, voffB); PG8_STAGE(PG8_SA(1, 0), cA + kstep, voffA); PG8_STAGE(PG8_SB(1, 1), cB + hstep + kstep, voffB);
        PG8_WAIT_V(6); PG8_BAR;
    }
    for (;;) {
        const bool has_next = S.next(ui + 1, nxt);
        const char* nA = has_next ? (const char*)g.A + (size_t)nxt.pm * tstep : cA; const char* nB = has_next ? (const char*)g.Bt + (size_t)nxt.pn * tstep : cB;
        for (int t = 0; t < nt; t += 2) {
            const bool last = (t == nt - 2);
            const char* a1 = cA + (size_t)(t + 1) * kstep;
            const char* a2 = last ? nA : cA + (size_t)(t + 2) * kstep; const char* b2 = last ? nB : cB + (size_t)(t + 2) * kstep;
            const char* a3 = a2 + kstep; const char* b3 = b2 + kstep;
            if (last && has_next) S.a_ready(nxt);
            if constexpr (SP2) {
            PG8_LDB(B0, 0, 0); PG8_LDB(B1, 0, 1); PG8_SCHED; PG8_LDA(At, 0, 0); PG8_STAGE(PG8_SA(1, 1), a1 + hstep, voffA);
            PG8_WAIT_V(8); PG8_WAIT_L(0); PG8_BAR; PG8_MMA(0, 0, At, B0); PG8_MMA(0, 1, At, B1); PG8_BAR; PG8_SCHED;
            PG8_LDA(At, 0, 1); PG8_STAGE(PG8_SB(0, 0), b2, voffB); PG8_STAGE(PG8_SB(0, 1), b2 + hstep, voffB); PG8_STAGE(PG8_SA(0, 0), a2, voffA);
            PG8_WAIT_V(8); PG8_WAIT_L(0); PG8_BAR; PG8_MMA(1, 0, At, B0); PG8_MMA(1, 1, At, B1); PG8_BAR; PG8_SCHED;
            PG8_LDB(B0, 1, 0); PG8_LDB(B1, 1, 1); PG8_SCHED; PG8_LDA(At, 1, 0); PG8_STAGE(PG8_SA(0, 1), a2 + hstep, voffA);
            PG8_WAIT_V(8); PG8_WAIT_L(0); PG8_BAR; PG8_MMA(0, 0, At, B0); PG8_MMA(0, 1, At, B1); PG8_BAR; PG8_SCHED;
            PG8_LDA(At, 1, 1); PG8_STAGE(PG8_SB(1, 0), b3, voffB); PG8_STAGE(PG8_SB(1, 1), b3 + hstep, voffB); PG8_STAGE(PG8_SA(1, 0), a3, voffA);
            PG8_WAIT_V(8); PG8_WAIT_L(0); PG8_BAR; PG8_MMA(1, 0, At, B0); PG8_MMA(1, 1, At, B1); PG8_BAR; PG8_SCHED;
            } else {
            PG8_LDB(B0, 0, 0); PG8_SCHED; PG8_LDA(At, 0, 0); PG8_STAGE(PG8_SA(1, 1), a1 + hstep, voffA);
            PG8_WAIT_L(8); PG8_BAR; PG8_WAIT_L(0); PG8_MMA(0, 0, At, B0); PG8_BAR; PG8_SCHED;
            PG8_LDB(B1, 0, 1); PG8_STAGE(PG8_SB(0, 0), b2, voffB);
            PG8_BAR; PG8_WAIT_L(0); PG8_MMA(0, 1, At, B1); PG8_BAR;
            PG8_LDA(At, 0, 1); PG8_STAGE(PG8_SA(0, 0), a2, voffA);
            PG8_BAR; PG8_WAIT_L(0); PG8_MMA(1, 0, At, B0); PG8_BAR; PG8_SCHED;
            PG8_STAGE(PG8_SB(0, 1), b2 + hstep, voffB);
            PG8_WAIT_V(6); PG8_BAR; PG8_MMA(1, 1, At, B1); PG8_BAR;
            PG8_LDB(B0, 1, 0); PG8_SCHED; PG8_LDA(At, 1, 0); PG8_STAGE(PG8_SA(0, 1), a2 + hstep, voffA);
            PG8_WAIT_L(8); PG8_BAR; PG8_WAIT_L(0); PG8_MMA(0, 0, At, B0); PG8_BAR; PG8_SCHED;
            PG8_LDB(B1, 1, 1); PG8_STAGE(PG8_SB(1, 0), b3, voffB);
            PG8_BAR; PG8_WAIT_L(0); PG8_MMA(0, 1, At, B1); PG8_BAR;
            PG8_LDA(At, 1, 1); PG8_STAGE(PG8_SA(1, 0), a3, voffA);
            PG8_BAR; PG8_WAIT_L(0); PG8_MMA(1, 0, At, B0); PG8_BAR; PG8_SCHED;
            PG8_STAGE(PG8_SB(1, 1), b3 + hstep, voffB);
            PG8_WAIT_V(6); PG8_BAR; PG8_MMA(1, 1, At, B1); PG8_BAR;
            }
        }
        if constexpr (ALIGN_EPI) { if (wr == 0) PG8_BAR; }
        if constexpr (!Epi::AFTER_DRAIN) { E(acc, cur, wr, wc, fr, fq); S.done(cur); }
        if (!has_next) break;
#pragma unroll
        for (int a = 0; a < 2; ++a)
#pragma unroll
            for (int b = 0; b < 2; ++b)
#pragma unroll
                for (int m = 0; m < 4; ++m)
#pragma unroll
                    for (int n = 0; n < 2; ++n) acc[a][b][m][n] = (f32x4){0.f, 0.f, 0.f, 0.f};
        cur = nxt; cA = nA; cB = nB; ++ui;
        if constexpr (ALIGN_EPI) { if (wr == 1) PG8_BAR; }
    }
    PG8_WAIT_V(0);
    if constexpr (!ALIGN_EPI) { if (wr == 0) PG8_BAR; }
    PG8_BAR;
    if constexpr (Epi::AFTER_DRAIN) { E.fused(acc, cur, wr, wc, fr, fq, lds, wid, lane); S.done(cur); }
#undef PG8_SA
#undef PG8_SB
#undef PG8_STAGE
#undef PG8_LDA
#undef PG8_LDB
#undef PG8_MMA
#undef PG8_WAIT_V
#undef PG8_WAIT_L
#undef PG8_BAR
#undef PG8_SCHED
}
}

constexpr int BATCH = 32, SEQ = 2048, D = 1024, T = BATCH * SEQ, DEPTH = 2, CHUNK = 64, NCH = SEQ / CHUNK;
constexpr int A_HEADS = 8, A_HD = 64, A_W = 512, A_LEFT = 8, A_BAND = 576, A_CLIP = 256, A_NREL = 320;
constexpr int B_HEADS = 4, B_HD = 128, B_W = 512;
constexpr int C_W = 512;
constexpr int D_IN = 7176;
constexpr int OFF_QA = 0, OFF_KA = 512, OFF_VA = 1024, OFF_QKVB = 1536, OFF_BETA = 3072, OFF_DEC = 3076, OFF_GATEB = 3080, OFF_POOL = 3592, OFF_GATES = 4104;
constexpr int NEXP = 32, MOE_FF = 512, MOE_BLOCK = 256;
constexpr int NPAIR = 2 * T, NBLK_MAX = NPAIR / MOE_BLOCK + NEXP, CAP = NBLK_MAX * MOE_BLOCK;
constexpr float DN_ALPHA = 1.4142135623730951f;
constexpr float LN_EPS = 1e-5f, RMS_EPS = 1e-6f;
constexpr int N1 = 3584;

constexpr size_t MiB = 1ull << 20, U = 128 * MiB;
constexpr size_t WS_CTL = 0;
constexpr size_t WS_WIN1 = 1 * MiB, WS_WV = 8 * MiB, WS_WG = 9 * MiB, WS_WBR = 15 * MiB, WS_WOUT = 18 * MiB, WS_W13 = 20 * MiB, WS_W2 = 84 * MiB;
constexpr size_t WS_XB = U;
constexpr size_t WS_P = 2 * U;
constexpr size_t WS_QA = WS_P, WS_KA = WS_P + U / 2, WS_VT = WS_P + U, WS_QKVB = WS_P + 3 * U / 2, WS_GATEB = WS_P + 3 * U, WS_POOL = WS_P + 7 * U / 2;
constexpr size_t WS_OA = WS_P + 4 * U, WS_OB = WS_P + 9 * U / 2, WS_PLD = WS_P + 5 * U;
constexpr size_t WS_SM = 116 * MiB;
constexpr size_t WS_BDL = WS_SM, WS_EID = WS_SM + 2 * MiB, WS_WTS = WS_SM + 5 * MiB / 2, WS_SLOT = WS_SM + 3 * MiB, WS_HIST = WS_SM + 7 * MiB / 2, WS_BLKE = WS_SM + 15 * MiB / 4, WS_GC = WS_SM + 4 * MiB;
constexpr size_t WS_TMU = WS_P + 11 * U / 2, WS_TMW = WS_TMU + 32 * MiB;
constexpr size_t WS_GATES = WS_P, WS_Y = WS_P + 3 * U, WS_MIX = WS_P;
constexpr size_t WS_XG = WS_P, WS_HDN = WS_P + (size_t)CAP * 2048, WS_YMOE = WS_HDN + (size_t)CAP * 1024;
constexpr size_t WS_END = 8 * U;
static_assert(WS_YMOE + (size_t)CAP * 2048 <= WS_TMU, "moe buffers");
static_assert(WS_GC + 1 * MiB <= U, "small tables");
constexpr size_t WS_WRT = WS_SM + 5 * MiB;
static_assert(WS_WRT + 2 * 48 * 1024 * 2 <= U, "router weights");
static_assert(WS_W2 + 32 * MiB <= U, "weights");

__device__ __forceinline__ unsigned f2bf(float f) { unsigned u = __builtin_bit_cast(unsigned, f); return (u + 0x7fffu + ((u >> 16) & 1u)) >> 16; }
__device__ __forceinline__ unsigned pk2(float lo, float hi) { return f2bf(lo) | (f2bf(hi) << 16); }
__device__ __forceinline__ float bf2f(unsigned short b) { return __builtin_bit_cast(float, ((unsigned)b) << 16); }
__device__ __forceinline__ float bflo(unsigned w) { return __builtin_bit_cast(float, w << 16); }
__device__ __forceinline__ float bfhi(unsigned w) { return __builtin_bit_cast(float, w & 0xffff0000u); }
__device__ __forceinline__ float wave_sum(float v) {
#pragma unroll
    for (int o = 1; o < 64; o <<= 1) v += __shfl_xor(v, o);
    return v;
}
__device__ __forceinline__ float sigmoidf_(float x) { return 1.0f / (1.0f + __expf(-x)); }
__device__ __forceinline__ float siluf_(float x) { return x / (1.0f + __expf(-x)); }
__device__ __forceinline__ float softplusf_(float x) { return x > 20.f ? x : log1pf(expf(x)); }

__device__ __forceinline__ int fresh_lane() { int l; asm volatile("v_mbcnt_lo_u32_b32 %0, -1, 0\n\tv_mbcnt_hi_u32_b32 %0, -1, %0" : "=v"(l)); return l; }
struct Args { const float* in[25]; float* out; unsigned char* ws; int lay_lo, lay_hi, ph_lo, ph_hi; };

enum Phase { PH_CONVERT = 0, PH_PROJ1 = 1, PH_PRE = 2, PH_MIX = 3, PH_GATES = 4, PH_BRANCH = 5, PH_OUT = 6, PH_LN1 = 7, PH_SLOTS = 8, PH_MOE1 = 9, PH_MOE2 = 10, PH_LN2 = 11, PH_COUNT = 12 };

constexpr int NWAVES = 8, NTHR = 512;
constexpr int LDS_BYTES = 163840;

__device__ __forceinline__ void convert_item(const float* W, int ldw, int col0, int k0, bf16_t* WT, int Kd, int rowbase, int ilv_half, LAS unsigned char* lds, int tid) {
    LAS float* scr = (LAS float*)lds;
#pragma unroll
    for (int i = 0; i < 16; ++i) { const int k = 4 * i + (tid >> 7), c4 = (tid & 127) * 4;
        *(LAS f32x4*)(scr + k * 516 + c4) = *(const f32x4*)(W + (size_t)(k0 + k) * ldw + col0 + c4); }
    __syncthreads();
    const int nlo = tid & 31, cch = (tid >> 5) & 7, nhi = tid >> 8;
#pragma unroll
    for (int j = 0; j < 8; ++j) {
        const int n = nlo + 32 * (nhi + 2 * j); const LAS float* sp = scr + (8 * cch) * 516 + n;
        u32x4 o; o.x = pg8::cvt_pk_bf16(sp[0], sp[516]); o.y = pg8::cvt_pk_bf16(sp[2 * 516], sp[3 * 516]); o.z = pg8::cvt_pk_bf16(sp[4 * 516], sp[5 * 516]); o.w = pg8::cvt_pk_bf16(sp[6 * 516], sp[7 * 516]);
        const int fr_ = (ilv_half < 0) ? n : ((n >> 7) * 256 + ilv_half * 128 + (n & 127));
        *(u32x4*)(WT + (size_t)(rowbase + fr_) * Kd + k0 + 8 * cch) = o;
    }
    __syncthreads();
}
__device__ __forceinline__ void phase_convert(const Args& a, LAS unsigned char* lds, int layer, int gw, int NGW, int wave, int lane, int tid, int gtid, int GT) {
    unsigned char* ws = a.ws;
    const float* w_in = a.in[1] + (size_t)layer * D * D_IN;
    constexpr int I_IN = 14 * 16, I_BR = 2 * 2 * 8, I_OUT = 2 * 16, I_W13 = NEXP * 2 * 16, I_W2 = NEXP * 2 * 8, I_FOLD = 32, NITEMS = I_IN + I_BR + I_OUT + I_W13 + I_W2 + I_FOLD;
    const int G_ = NGW / NWAVES;
    for (int it = blockIdx.x; it < NITEMS; it += G_) {
        int r = it;
        if (r < I_IN) {
            const int kb = r & 15, cb = r >> 4;
            int c0, r0; size_t dd;
            if (cb == 0) { c0 = OFF_QA; r0 = 0; dd = WS_WIN1; } else if (cb == 1) { c0 = OFF_KA; r0 = 512; dd = WS_WIN1; }
            else if (cb < 5) { c0 = OFF_QKVB + 512 * (cb - 2); r0 = 1024 + 512 * (cb - 2); dd = WS_WIN1; }
            else if (cb == 5) { c0 = OFF_GATEB; r0 = 2560; dd = WS_WIN1; } else if (cb == 6) { c0 = OFF_POOL; r0 = 3072; dd = WS_WIN1; }
            else if (cb == 7) { c0 = OFF_VA; r0 = 0; dd = WS_WV; } else { c0 = OFF_GATES + 512 * (cb - 8); r0 = 512 * (cb - 8); dd = WS_WG; }
            convert_item(w_in, D_IN, c0, 64 * kb, (bf16_t*)(ws + dd), 1024, r0, -1, lds, tid);
            continue;
        }
        r -= I_IN;
        if (r < I_BR) {
            const int which = r >> 4, cb = (r >> 3) & 1, kb = r & 7;
            const float* W = (which == 0 ? a.in[9] : a.in[10]) + (size_t)layer * 512 * 1024;
            convert_item(W, 1024, 512 * cb, 64 * kb, (bf16_t*)(ws + WS_WBR) + (size_t)which * 1024 * 512, 512, 512 * cb, -1, lds, tid);
            continue;
        }
        r -= I_BR;
        if (r < I_OUT) {
            const int cb = r >> 4, kb = r & 15;
            convert_item(a.in[13] + (size_t)layer * 1024 * 1024, 1024, 512 * cb, 64 * kb, (bf16_t*)(ws + WS_WOUT), 1024, 512 * cb, -1, lds, tid);
            continue;
        }
        r -= I_OUT;
        if (r < I_W13) {
            const int e = r >> 5, half = (r >> 4) & 1, kb = r & 15;
            const float* W = (half == 0 ? a.in[20] : a.in[21]) + ((size_t)layer * NEXP + e) * 1024 * 512;
            convert_item(W, 512, 0, 64 * kb, (bf16_t*)(ws + WS_W13), 1024, e * 1024, half, lds, tid);
            continue;
        }
        r -= I_W13;
        if (r < I_W2) {
            const int e = r >> 4, cb = (r >> 3) & 1, kb = r & 7;
            const float* W = a.in[22] + ((size_t)layer * NEXP + e) * 512 * 1024;
            convert_item(W, 1024, 512 * cb, 64 * kb, (bf16_t*)(ws + WS_W2), 512, e * 1024 + 512 * cb, -1, lds, tid);
            continue;
        }
        r -= I_W2;
        {
            const int g = r >> 3, d0 = (r & 7) * 128;
            const float* pw = a.in[7] + ((size_t)layer * 4 + g) * 128 * 128; const float* ps = a.in[8] + (size_t)layer * 512 + g * 128;
            const float* wc = a.in[11] + ((size_t)layer * 512 + g * 128) * 1024 + d0;
            LAS float* pws = (LAS float*)lds; LAS float* wcs = pws + 128 * 128;
            for (int i = tid; i < 128 * 128; i += NTHR) { pws[i] = pw[i] * ps[i & 127]; wcs[i] = wc[(size_t)(i >> 7) * 1024 + (i & 127)]; }
            __syncthreads();
            const int d = tid & 127, cg = __builtin_amdgcn_readfirstlane(tid >> 7);
            float acc[32];
#pragma unroll
            for (int j = 0; j < 32; ++j) acc[j] = 0.f;
            for (int c2 = 0; c2 < 128; ++c2) { const float wv = wcs[c2 * 128 + d];
#pragma unroll
                for (int j = 0; j < 32; ++j) acc[j] += pws[(cg * 32 + j) * 128 + c2] * wv; }
            bf16_t* dst = (bf16_t*)(ws + WS_WBR) + (size_t)2 * 1024 * 512 + (size_t)(d0 + d) * 512 + g * 128 + cg * 32;
#pragma unroll
            for (int j = 0; j < 4; ++j) { u32x4 o; o.x = pg8::cvt_pk_bf16(acc[8 * j], acc[8 * j + 1]); o.y = pg8::cvt_pk_bf16(acc[8 * j + 2], acc[8 * j + 3]); o.z = pg8::cvt_pk_bf16(acc[8 * j + 4], acc[8 * j + 5]); o.w = pg8::cvt_pk_bf16(acc[8 * j + 6], acc[8 * j + 7]);
                *(u32x4*)(dst + 8 * j) = o; }
            __syncthreads();
        }
    }
    {
        const float* we = a.in[18] + (size_t)layer * D * 32; const float* wgp = a.in[16] + (size_t)layer * D * 4;
        bf16_t* dst = (bf16_t*)(ws + WS_WRT);
        for (int i = gtid; i < 48 * 1024; i += GT) {
            const int n = i >> 10, k = i & 1023;
            const float w = (n < 32) ? we[(size_t)k * 32 + n] : (n < 36 ? wgp[(size_t)k * 4 + (n - 32)] : 0.f);
            const unsigned h = f2bf(w); const float lo = w - bf2f((unsigned short)h);
            dst[i] = (bf16_t)h; dst[48 * 1024 + i] = (bf16_t)f2bf(lo);
        }
    }
}

__device__ __forceinline__ void row_store_bf16(bf16_t* dst_row, const f32x4 (&v)[4], int lane) {
    unsigned long long* o8 = (unsigned long long*)dst_row + lane;
#pragma unroll
    for (int j = 0; j < 4; ++j) o8[64 * j] = (unsigned long long)pk2(v[j].x, v[j].y) | ((unsigned long long)pk2(v[j].z, v[j].w) << 32);
}
__device__ __forceinline__ void row_bd_logits(const f32x4 (&v)[4], const LAS float* wbd, float* bdl_row, int lane) {
    float acc[8];
#pragma unroll
    for (int i = 0; i < 8; ++i) acc[i] = 0.f;
#pragma unroll
    for (int j = 0; j < 4; ++j)
#pragma unroll
        for (int c = 0; c < 4; ++c) {
            const int k = 256 * j + 4 * lane + c; const float xv = v[j][c];
            const f32x4 w0 = *(const LAS f32x4*)(wbd + k * 8), w1 = *(const LAS f32x4*)(wbd + k * 8 + 4);
            acc[0] += xv * w0.x; acc[1] += xv * w0.y; acc[2] += xv * w0.z; acc[3] += xv * w0.w;
            acc[4] += xv * w1.x; acc[5] += xv * w1.y; acc[6] += xv * w1.z; acc[7] += xv * w1.w;
            if (c == 3) asm volatile("" ::: "memory");
        }
    float r = 0.f;
#pragma unroll
    for (int i = 0; i < 8; ++i) { const float s = wave_sum(acc[i]); r = (lane == i) ? s : r; }
    if (lane < 8) bdl_row[lane] = r;
}
__device__ __forceinline__ void stage_wbd(const float* w_in_layer, LAS float* wbd, int tid) {
    for (int k = tid; k < 1024; k += NTHR) {
        const f32x4 a0 = *(const f32x4*)(w_in_layer + (size_t)k * D_IN + OFF_BETA), a1 = *(const f32x4*)(w_in_layer + (size_t)k * D_IN + OFF_BETA + 4);
        *(LAS f32x4*)(wbd + k * 8) = a0; *(LAS f32x4*)(wbd + k * 8 + 4) = a1;
    }
    __syncthreads();
}

__device__ __forceinline__ void phase_xconv(const Args& a, LAS unsigned char* lds, int gw, int NGW, int lane, int tid) {
    LAS float* wbd = (LAS float*)(lds);
    stage_wbd(a.in[1], wbd, tid);
    const float* x = a.in[0]; bf16_t* XB = (bf16_t*)(a.ws + WS_XB); float* bdl = (float*)(a.ws + WS_BDL);
    for (int m = gw; m < T; m += NGW) {
        const f32x4* xr = (const f32x4*)(x + (size_t)m * D) + lane;
        f32x4 v[4];
#pragma unroll
        for (int j = 0; j < 4; ++j) v[j] = xr[64 * j];
        row_store_bf16(XB + (size_t)m * D, v, lane);
        row_bd_logits(v, wbd, bdl + (size_t)m * 8, lane);
    }
    __syncthreads();
}

__device__ __forceinline__ void phase_pool(const Args& a, int gw, int NGW, int lane) {
    const bf16_t* pool = (const bf16_t*)(a.ws + WS_POOL); bf16_t* pld = (bf16_t*)(a.ws + WS_PLD);
    const int g = lane >> 4, win = 2 << g;
    for (int blk = gw; blk < T / 32; blk += NGW) {
        const int m0 = blk * 32, tl0 = m0 & (SEQ - 1);
        float s[8];
#pragma unroll
        for (int i = 0; i < 8; ++i) s[i] = 0.f;
        for (int q = 1; q < 16; ++q) {
            if (q < win && tl0 - q >= 0) { const u32x4 w = *(const u32x4*)(pool + (size_t)(m0 - q) * 512 + 8 * lane);
                s[0] += bflo(w.x); s[1] += bfhi(w.x); s[2] += bflo(w.y); s[3] += bfhi(w.y); s[4] += bflo(w.z); s[5] += bfhi(w.z); s[6] += bflo(w.w); s[7] += bfhi(w.w); }
        }
        for (int r = 0; r < 32; ++r) {
            const int m = m0 + r, tl = tl0 + r;
            const u32x4 cur = *(const u32x4*)(pool + (size_t)m * 512 + 8 * lane);
            const int old = tl - win + 1;
            u32x4 w = {0u, 0u, 0u, 0u};
            if (old >= 0) w = *(const u32x4*)(pool + (size_t)(m - win + 1) * 512 + 8 * lane);
            s[0] += bflo(cur.x); s[1] += bfhi(cur.x); s[2] += bflo(cur.y); s[3] += bfhi(cur.y); s[4] += bflo(cur.z); s[5] += bfhi(cur.z); s[6] += bflo(cur.w); s[7] += bfhi(cur.w);
            const int n = (tl + 1 < win) ? tl + 1 : win;
            const float inv = 1.0f / (float)n;
            u32x4 o;
            o.x = pg8::cvt_pk_bf16(s[0] * inv - bflo(cur.x), s[1] * inv - bfhi(cur.x)); o.y = pg8::cvt_pk_bf16(s[2] * inv - bflo(cur.y), s[3] * inv - bfhi(cur.y));
            o.z = pg8::cvt_pk_bf16(s[4] * inv - bflo(cur.z), s[5] * inv - bfhi(cur.z)); o.w = pg8::cvt_pk_bf16(s[6] * inv - bflo(cur.w), s[7] * inv - bfhi(cur.w));
            *(u32x4*)(pld + (size_t)m * 512 + 8 * lane) = o;
            s[0] -= bflo(w.x); s[1] -= bfhi(w.x); s[2] -= bflo(w.y); s[3] -= bfhi(w.y); s[4] -= bflo(w.z); s[5] -= bfhi(w.z); s[6] -= bflo(w.w); s[7] -= bfhi(w.w);
        }
    }
}

__device__ __forceinline__ void phase_ln1(const Args& a, LAS unsigned char* lds, int layer, int gw, int NGW, int wave, int lane) {
    const float* xin = (layer == 0) ? a.in[0] : a.out;
    const bf16_t* mix = (const bf16_t*)(a.ws + WS_MIX);
    float* xo = a.out; bf16_t* XB = (bf16_t*)(a.ws + WS_XB);
    const float* lg_ = a.in[14] + (size_t)layer * D; const float* lb_ = a.in[15] + (size_t)layer * D;
    const float* bg = a.in[17] + (size_t)layer * 4; const float* be = a.in[19] + (size_t)layer * 32;
    const bf16_t* wrt = (const bf16_t*)(a.ws + WS_WRT);
    int* eid = (int*)(a.ws + WS_EID); float* wts = (float*)(a.ws + WS_WTS); int* hist = (int*)(a.ws + WS_HIST);
    LAS float* lgt = (LAS float*)(lds + wave * 4096);
    LAS int* hst = (LAS int*)(lds + wave * 4096 + 3072);
    if (lane < 32) hst[lane] = 0;
    f32x4 gv[4], bv[4];
#pragma unroll
    for (int j = 0; j < 4; ++j) { gv[j] = ((const f32x4*)lg_)[64 * j + lane]; bv[j] = ((const f32x4*)lb_)[64 * j + lane]; }
    const int fr = lane & 15, fq = lane >> 4;
    for (int grp = gw; grp < T / 16; grp += NGW) {
        f32x4 xa[4]; u32x2 ma[4];
        {
            const f32x4* xr = (const f32x4*)(xin + (size_t)(grp * 16) * D) + lane; const u32x2* mr = (const u32x2*)(mix + (size_t)(grp * 16) * D) + lane;
#pragma unroll
            for (int j = 0; j < 4; ++j) { xa[j] = xr[64 * j]; ma[j] = mr[64 * j]; }
        }
        for (int rr = 0; rr < 16; ++rr) {
            const int m = grp * 16 + rr;
            f32x4 v[4]; float s = 0.f;
#pragma unroll
            for (int j = 0; j < 4; ++j) { const f32x4 mf = {bflo(ma[j].x), bfhi(ma[j].x), bflo(ma[j].y), bfhi(ma[j].y)}; v[j] = xa[j] * DN_ALPHA + mf; s += (v[j].x + v[j].y) + (v[j].z + v[j].w); }
            if (rr + 1 < 16) {
                const f32x4* xr = (const f32x4*)(xin + (size_t)(m + 1) * D) + lane; const u32x2* mr = (const u32x2*)(mix + (size_t)(m + 1) * D) + lane;
#pragma unroll
                for (int j = 0; j < 4; ++j) { xa[j] = xr[64 * j]; ma[j] = mr[64 * j]; }
            }
            const float mean = wave_sum(s) * (1.f / D); float s2 = 0.f;
#pragma unroll
            for (int j = 0; j < 4; ++j) { v[j] = v[j] - mean; s2 += (v[j].x * v[j].x + v[j].y * v[j].y) + (v[j].z * v[j].z + v[j].w * v[j].w); }
            const float rstd = 1.f / sqrtf(wave_sum(s2) * (1.f / D) + LN_EPS);
#pragma unroll
            for (int j = 0; j < 4; ++j) v[j] = v[j] * rstd * gv[j] + bv[j];
            f32x4* orow = (f32x4*)(xo + (size_t)m * D) + lane;
#pragma unroll
            for (int j = 0; j < 4; ++j) orow[64 * j] = v[j];
            row_store_bf16(XB + (size_t)m * D, v, lane);
        }
        asm volatile("s_waitcnt vmcnt(0)" ::: "memory");
        f32x4 acc[3];
#pragma unroll
        for (int t = 0; t < 3; ++t) acc[t] = (f32x4){0.f, 0.f, 0.f, 0.f};
        const float* xrow = xo + (size_t)(grp * 16 + fr) * D + 8 * fq;
#pragma unroll 4
        for (int ks = 0; ks < 32; ++ks) {
            const f32x4 x0 = *(const f32x4*)(xrow + ks * 32), x1 = *(const f32x4*)(xrow + ks * 32 + 4);
            u32x4 hi; hi.x = pg8::cvt_pk_bf16(x0.x, x0.y); hi.y = pg8::cvt_pk_bf16(x0.z, x0.w); hi.z = pg8::cvt_pk_bf16(x1.x, x1.y); hi.w = pg8::cvt_pk_bf16(x1.z, x1.w);
            u32x4 lo; lo.x = pg8::cvt_pk_bf16(x0.x - bflo(hi.x), x0.y - bfhi(hi.x)); lo.y = pg8::cvt_pk_bf16(x0.z - bflo(hi.y), x0.w - bfhi(hi.y));
            lo.z = pg8::cvt_pk_bf16(x1.x - bflo(hi.z), x1.y - bfhi(hi.z)); lo.w = pg8::cvt_pk_bf16(x1.z - bflo(hi.w), x1.w - bfhi(hi.w));
            const bf16x8 Bh = __builtin_bit_cast(bf16x8, hi), Bl = __builtin_bit_cast(bf16x8, lo);
#pragma unroll
            for (int t = 0; t < 3; ++t) {
                const bf16x8 Ah = *(const bf16x8*)(wrt + (size_t)(t * 16 + fr) * 1024 + ks * 32 + 8 * fq), Al = *(const bf16x8*)(wrt + (size_t)(48 + t * 16 + fr) * 1024 + ks * 32 + 8 * fq);
                acc[t] = __builtin_amdgcn_mfma_f32_16x16x32_bf16(Ah, Bh, acc[t], 0, 0, 0);
                acc[t] = __builtin_amdgcn_mfma_f32_16x16x32_bf16(Ah, Bl, acc[t], 0, 0, 0);
                acc[t] = __builtin_amdgcn_mfma_f32_16x16x32_bf16(Al, Bh, acc[t], 0, 0, 0);
            }
        }
#pragma unroll
        for (int t = 0; t < 3; ++t) *(LAS f32x4*)(lgt + fr * 48 + t * 16 + 4 * fq) = acc[t];
        asm volatile("s_waitcnt lgkmcnt(0)" ::: "memory");
        if (lane < 16) {
            const int m = grp * 16 + lane; const LAS float* lr = lgt + lane * 48;
            float ag[4];
#pragma unroll
            for (int i = 0; i < 4; ++i) ag[i] = lr[32 + i] + bg[i];
            int gsel = 0; float gm = ag[0];
#pragma unroll
            for (int i = 1; i < 4; ++i) if (ag[i] > gm) { gm = ag[i]; gsel = i; }
            float gs = 0.f;
#pragma unroll
            for (int i = 0; i < 4; ++i) gs += expf(ag[i] - gm);
            const float p_top = 1.0f / gs;
            float le[8];
#pragma unroll
            for (int i = 0; i < 8; ++i) le[i] = lr[gsel * 8 + i] + be[gsel * 8 + i];
            int i0 = 0; float l0 = le[0];
#pragma unroll
            for (int i = 1; i < 8; ++i) if (le[i] > l0) { l0 = le[i]; i0 = i; }
            int i1 = -1; float l1 = -3.0e38f;
#pragma unroll
            for (int i = 0; i < 8; ++i) if (i != i0 && le[i] > l1) { l1 = le[i]; i1 = i; }
            const float ex = expf(l1 - l0); const float w0 = p_top / (1.0f + ex), w1 = p_top * ex / (1.0f + ex);
            const int e0 = gsel * 8 + i0, e1 = gsel * 8 + i1;
            eid[2 * m] = e0; eid[2 * m + 1] = e1; wts[2 * m] = w0; wts[2 * m + 1] = w1;
            __hip_atomic_fetch_add(hst + e0, 1, __ATOMIC_RELAXED, __HIP_MEMORY_SCOPE_WORKGROUP); __hip_atomic_fetch_add(hst + e1, 1, __ATOMIC_RELAXED, __HIP_MEMORY_SCOPE_WORKGROUP);
        }
        asm volatile("s_waitcnt lgkmcnt(0)" ::: "memory");
    }
    if (lane < 32) hist[gw * 32 + lane] = hst[lane];
}

__device__ __forceinline__ void phase_slots(const Args& a, LAS unsigned char* lds, int gw, int NGW, int wave, int lane, int tid) {
    LAS int* red = (LAS int*)lds;
    LAS int* tot = red + 1024;
    LAS int* bef = tot + 32;
    LAS int* pst = bef + 32;
    LAS int* base = pst + 64;
    const int* hist = (const int*)(a.ws + WS_HIST);
    const int nwv = NGW;
    const int wg0 = gw - wave;
    {
        const int e = tid & 31, part = tid >> 5;
        const int per = (nwv + 15) / 16; const int lo = part * per, hi = (lo + per < nwv) ? lo + per : nwv;
        int st = 0, sb = 0;
        for (int g = lo; g < hi; ++g) { const int v = hist[g * 32 + e]; st += v; sb += (g < wg0) ? v : 0; }
        red[part * 32 + e] = st; red[512 + part * 32 + e] = sb;
    }
    __syncthreads();
    if (tid < 32) { int st = 0, sb = 0; for (int p = 0; p < 16; ++p) { st += red[p * 32 + tid]; sb += red[512 + p * 32 + tid]; } tot[tid] = st; bef[tid] = sb; }
    __syncthreads();
    if (tid == 0) { int acc = 0; for (int e = 0; e < 32; ++e) { pst[e] = acc; acc += (tot[e] + MOE_BLOCK - 1) / MOE_BLOCK * MOE_BLOCK; } pst[32] = acc; }
    __syncthreads();
    if (tid < 32) { int acc = pst[tid] + bef[tid]; for (int w = 0; w < NWAVES; ++w) { base[w * 32 + tid] = acc; acc += hist[(wg0 + w) * 32 + tid]; } }
    __syncthreads();
    if (blockIdx.x == 0) {
        int* blk_e = (int*)(a.ws + WS_BLKE);
        const int nblk = pst[32] / MOE_BLOCK;
        if (tid == 0) blk_e[1023] = nblk;
        for (int b = tid; b < nblk; b += NTHR) { int e = 0; for (int q = 0; q < 32; ++q) if (pst[q] <= b * MOE_BLOCK) e = q; blk_e[b] = e; }
    }
    const int* eid = (const int*)(a.ws + WS_EID); int* slot = (int*)(a.ws + WS_SLOT);
    const bf16_t* XB = (const bf16_t*)(a.ws + WS_XB); bf16_t* xg = (bf16_t*)(a.ws + WS_XG);
    int cnt = (lane < 32) ? base[wave * 32 + lane] : 0;
    for (int grp = gw; grp < T / 16; grp += NGW)
    for (int rr = 0; rr < 16; ++rr) {
        const int m = grp * 16 + rr;
        const int e0 = eid[2 * m], e1 = eid[2 * m + 1];
        const int s0 = __shfl(cnt, e0); cnt += (lane == e0) ? 1 : 0;
        const int s1 = __shfl(cnt, e1); cnt += (lane == e1) ? 1 : 0;
        if (lane == 0) { slot[2 * m] = s0; slot[2 * m + 1] = s1; }
        const u32x4* src = (const u32x4*)(XB + (size_t)m * D) + lane;
        const u32x4 p0 = src[0], p1 = src[64];
        u32x4* d0 = (u32x4*)(xg + (size_t)s0 * D) + lane; u32x4* d1 = (u32x4*)(xg + (size_t)s1 * D) + lane;
        d0[0] = p0; d0[64] = p1; d1[0] = p0; d1[64] = p1;
    }
    __syncthreads();
}

__device__ __forceinline__ void phase_ln2(const Args& a, LAS unsigned char* lds, int layer, int gw, int NGW, int lane, int tid) {
    LAS float* wbd = (LAS float*)(lds);
    const bool has_next = (layer + 1 < DEPTH);
    if (has_next) stage_wbd(a.in[1] + (size_t)(layer + 1) * D * D_IN, wbd, tid);
    float* xo = a.out; bf16_t* XB = (bf16_t*)(a.ws + WS_XB); float* bdl = (float*)(a.ws + WS_BDL);
    const bf16_t* ymoe = (const bf16_t*)(a.ws + WS_YMOE);
    const int* slot = (const int*)(a.ws + WS_SLOT); const float* wts = (const float*)(a.ws + WS_WTS);
    const float* lg_ = a.in[23] + (size_t)layer * D; const float* lb_ = a.in[24] + (size_t)layer * D;
    LAS f32x4* gbl = (LAS f32x4*)(lds + 32768);
    for (int i = tid; i < 256; i += NTHR) { gbl[i] = ((const f32x4*)lg_)[i]; gbl[256 + i] = ((const f32x4*)lb_)[i]; }
    __syncthreads();
    const int nrows = (T - gw + NGW - 1) / NGW;
    for (int i0 = 0; i0 < nrows; i0 += 64) {
        const int nb = (nrows - i0 < 64) ? nrows - i0 : 64;
        int sl0 = 0, sl1 = 0; float ww0 = 0.f, ww1 = 0.f;
        if (lane < nb) { const int mm = gw + (i0 + lane) * NGW; sl0 = slot[2 * mm]; sl1 = slot[2 * mm + 1]; ww0 = wts[2 * mm]; ww1 = wts[2 * mm + 1]; }
        f32x4 xa[4]; unsigned long long ya0[4], ya1[4];
        {
            const int m = gw + i0 * NGW; const int s0 = __builtin_amdgcn_readlane(sl0, 0), s1 = __builtin_amdgcn_readlane(sl1, 0);
            const f32x4* xr = (const f32x4*)(xo + (size_t)m * D) + lane;
            const unsigned long long* y0 = (const unsigned long long*)(ymoe + (size_t)s0 * D) + lane; const unsigned long long* y1 = (const unsigned long long*)(ymoe + (size_t)s1 * D) + lane;
#pragma unroll
            for (int j = 0; j < 4; ++j) { xa[j] = xr[64 * j]; ya0[j] = y0[64 * j]; ya1[j] = y1[64 * j]; }
        }
        for (int i = 0; i < nb; ++i) {
            const int m = gw + (i0 + i) * NGW;
            const float w0 = __builtin_bit_cast(float, __builtin_amdgcn_readlane(__builtin_bit_cast(int, ww0), i)), w1 = __builtin_bit_cast(float, __builtin_amdgcn_readlane(__builtin_bit_cast(int, ww1), i));
            f32x4 xc[4]; unsigned long long yc0[4], yc1[4];
#pragma unroll
            for (int j = 0; j < 4; ++j) { xc[j] = xa[j]; yc0[j] = ya0[j]; yc1[j] = ya1[j]; }
            if (i + 1 < nb) {
                const int mn = m + NGW; const int s0 = __builtin_amdgcn_readlane(sl0, i + 1), s1 = __builtin_amdgcn_readlane(sl1, i + 1);
                const f32x4* xr = (const f32x4*)(xo + (size_t)mn * D) + lane;
                const unsigned long long* y0 = (const unsigned long long*)(ymoe + (size_t)s0 * D) + lane; const unsigned long long* y1 = (const unsigned long long*)(ymoe + (size_t)s1 * D) + lane;
#pragma unroll
                for (int j = 0; j < 4; ++j) { xa[j] = xr[64 * j]; ya0[j] = y0[64 * j]; ya1[j] = y1[64 * j]; }
            }
            f32x4 v[4]; float s = 0.f;
#pragma unroll
            for (int j = 0; j < 4; ++j) {
                const unsigned long long p = yc0[j], q = yc1[j];
                f32x4 f; f.x = w0 * bflo((unsigned)p) + w1 * bflo((unsigned)q); f.y = w0 * bfhi((unsigned)p) + w1 * bfhi((unsigned)q);
                f.z = w0 * bflo((unsigned)(p >> 32)) + w1 * bflo((unsigned)(q >> 32)); f.w = w0 * bfhi((unsigned)(p >> 32)) + w1 * bfhi((unsigned)(q >> 32));
                v[j] = xc[j] * DN_ALPHA + f; s += (v[j].x + v[j].y) + (v[j].z + v[j].w);
            }
            const float mean = wave_sum(s) * (1.f / D); float s2 = 0.f;
#pragma unroll
            for (int j = 0; j < 4; ++j) { v[j] = v[j] - mean; s2 += (v[j].x * v[j].x + v[j].y * v[j].y) + (v[j].z * v[j].z + v[j].w * v[j].w); }
            const float rstd = 1.f / sqrtf(wave_sum(s2) * (1.f / D) + LN_EPS);
#pragma unroll
            for (int j = 0; j < 4; ++j) v[j] = v[j] * rstd * gbl[64 * j + lane] + gbl[256 + 64 * j + lane];
            f32x4* orow = (f32x4*)(xo + (size_t)m * D) + lane;
#pragma unroll
            for (int j = 0; j < 4; ++j) orow[64 * j] = v[j];
            if (has_next) { row_store_bf16(XB + (size_t)m * D, v, lane); row_bd_logits(v, wbd, bdl + (size_t)m * 8, lane); }
        }
    }
    __syncthreads();
}


template <class F> struct EpiP8 { static constexpr bool PERM = true, AFTER_DRAIN = false; F f;
    __device__ __forceinline__ void operator()(const f32x4 (&acc)[2][2][4][2], const pg8::Unit& u, int wr, int wc, int fr, int fq) const {
        const int row0 = u.pm * 256 + wr * 64 + fr, col0 = u.pn * 256 + wc * 32 + 8 * fq;
#pragma unroll
        for (int ai = 0; ai < 2; ++ai)
#pragma unroll
            for (int m = 0; m < 4; ++m)
#pragma unroll
                for (int bj = 0; bj < 2; ++bj) f(row0 + ai * 128 + m * 16, col0 + bj * 128, u.pn, acc[ai][bj][m][0], acc[ai][bj][m][1]);
    } };
template <class F> struct EpiPair { static constexpr bool PERM = true, AFTER_DRAIN = false; F f;
    __device__ __forceinline__ void operator()(const f32x4 (&acc)[2][2][4][2], const pg8::Unit& u, int wr, int wc, int fr, int fq) const {
        const int row0 = u.pm * 256 + wr * 64 + fr, col0 = u.pn * 256 + wc * 32 + 8 * fq;
#pragma unroll
        for (int ai = 0; ai < 2; ++ai)
#pragma unroll
            for (int m = 0; m < 4; ++m) f(row0 + ai * 128 + m * 16, col0, acc[ai][0][m][0], acc[ai][0][m][1], acc[ai][1][m][0], acc[ai][1][m][1]);
    } };
template <class F> struct EpiP4 { static constexpr bool PERM = false, AFTER_DRAIN = false; F f;
    __device__ __forceinline__ void operator()(const f32x4 (&acc)[2][2][4][2], const pg8::Unit& u, int wr, int wc, int fr, int fq) const {
        const int row0 = u.pm * 256 + wr * 64 + fr, col0 = u.pn * 256 + wc * 32 + 4 * fq;
#pragma unroll
        for (int ai = 0; ai < 2; ++ai)
#pragma unroll
            for (int m = 0; m < 4; ++m)
#pragma unroll
                for (int bj = 0; bj < 2; ++bj)
#pragma unroll
                    for (int n = 0; n < 2; ++n) f(row0 + ai * 128 + m * 16, col0 + bj * 128 + n * 16, acc[ai][bj][m][n]);
    } };
__device__ __forceinline__ u32x4 pack8(f32x4 a, f32x4 b) { u32x4 w; w.x = pg8::cvt_pk_bf16(a.x, a.y); w.y = pg8::cvt_pk_bf16(a.z, a.w); w.z = pg8::cvt_pk_bf16(b.x, b.y); w.w = pg8::cvt_pk_bf16(b.z, b.w); return w; }
__device__ __forceinline__ float fsig(float x) { return __builtin_amdgcn_rcpf(1.0f + __expf(-x)); }
struct F_Proj1 { unsigned char* ws;
    __device__ __forceinline__ void operator()(int row, int col, int pn, f32x4 a, f32x4 b) const {
        bf16_t* p;
        if (pn < 2) p = (bf16_t*)(ws + WS_QA) + (size_t)row * 512 + col;
        else if (pn < 4) p = (bf16_t*)(ws + WS_KA) + (size_t)row * 512 + (col - 512);
        else if (pn < 10) p = (bf16_t*)(ws + WS_QKVB) + (size_t)row * 1536 + (col - 1024);
        else if (pn < 12) p = (bf16_t*)(ws + WS_GATEB) + (size_t)row * 512 + (col - 2560);
        else p = (bf16_t*)(ws + WS_POOL) + (size_t)row * 512 + (col - 3072);
        *(u32x4*)p = pack8(a, b); } };
struct F_Bf16 { bf16_t* O; int ldc, cmask;
    __device__ __forceinline__ void operator()(int row, int col, int, f32x4 a, f32x4 b) const { *(u32x4*)(O + (size_t)row * ldc + (col & cmask)) = pack8(a, b); } };
struct F_Gates { bf16_t* O; const float* gb;
    __device__ __forceinline__ void operator()(int row, int col, int, f32x4 a, f32x4 b) const { const f32x4 b0 = *(const f32x4*)(gb + col), b1 = *(const f32x4*)(gb + col + 4);
        a = a + b0; b = b + b1; a.x = fsig(a.x); a.y = fsig(a.y); a.z = fsig(a.z); a.w = fsig(a.w); b.x = fsig(b.x); b.y = fsig(b.y); b.z = fsig(b.z); b.w = fsig(b.w);
        *(u32x4*)(O + (size_t)row * 3072 + col) = pack8(a, b); } };
template <int WHICH> struct F_Branch { bf16_t* Y; const bf16_t* gates;
    __device__ __forceinline__ void operator()(int row, int col, int, f32x4 a, f32x4 b) const {
        const u32x4 g = *(const u32x4*)(gates + (size_t)row * 3072 + WHICH * 1024 + col);
        a.x *= bflo(g.x); a.y *= bfhi(g.x); a.z *= bflo(g.y); a.w *= bfhi(g.y); b.x *= bflo(g.z); b.y *= bfhi(g.z); b.z *= bflo(g.w); b.w *= bfhi(g.w);
        bf16_t* yp = Y + (size_t)row * 1024 + col;
        if (WHICH > 0) { const u32x4 o = *(const u32x4*)yp; a.x += bflo(o.x); a.y += bfhi(o.x); a.z += bflo(o.y); a.w += bfhi(o.y); b.x += bflo(o.z); b.y += bfhi(o.z); b.z += bflo(o.w); b.w += bfhi(o.w); }
        *(u32x4*)yp = pack8(a, b); } };
struct F_F32 { float* O; int ldc;
    __device__ __forceinline__ void operator()(int row, int col, f32x4 v) const { *(f32x4*)(O + (size_t)row * ldc + col) = v; } };
struct F_Hdn { bf16_t* H;
    __device__ __forceinline__ void operator()(int row, int col, f32x4 a0, f32x4 a1, f32x4 b0, f32x4 b1) const {
        const int hc = ((col >> 8) & 3) * 128 + (col & 127);
        a0.x = a0.x * fsig(a0.x) * b0.x; a0.y = a0.y * fsig(a0.y) * b0.y; a0.z = a0.z * fsig(a0.z) * b0.z; a0.w = a0.w * fsig(a0.w) * b0.w;
        a1.x = a1.x * fsig(a1.x) * b1.x; a1.y = a1.y * fsig(a1.y) * b1.y; a1.z = a1.z * fsig(a1.z) * b1.z; a1.w = a1.w * fsig(a1.w) * b1.w;
        *(u32x4*)(H + (size_t)row * 512 + hc) = pack8(a0, a1); } };
struct MoeOrder { const LAS int* tab; int nunits, G, c;
    __device__ __forceinline__ bool next(int i, pg8::Unit& u) const { const int L = i * G + c; if (L >= nunits) return false; const int blk = L >> 2; u.pm = blk; u.pn = tab[blk] * 4 + (L & 3); return true; }
    __device__ __forceinline__ void a_ready(const pg8::Unit&) const {}
    __device__ __forceinline__ void done(const pg8::Unit&) const {} };
constexpr int LDS_TAB_OFF = 131072;

__device__ __forceinline__ void phase_g_proj1(const Args& a, LAS unsigned char* lds, int G, int c, int wave, int lane) {
    const bf16_t* XB = (const bf16_t*)(a.ws + WS_XB);
    { pg8::Gemm g{XB, (const bf16_t*)(a.ws + WS_WIN1), T, N1, 1024}; pg8::StaticOrder S; S.init(T, N1, G, c); EpiP8<F_Proj1> E{F_Proj1{a.ws}};
      pg8::gemm_phase<EpiP8<F_Proj1>, pg8::StaticOrder, true, true>(lds, g, S, E, wave, lane); }
    { pg8::Gemm g{(const bf16_t*)(a.ws + WS_WV), XB, 512, T, 1024}; pg8::StaticOrder S; S.init(512, T, G, c); EpiP8<F_Bf16> E{F_Bf16{(bf16_t*)(a.ws + WS_VT), T, 0x7fffffff}};
      pg8::gemm_phase<EpiP8<F_Bf16>, pg8::StaticOrder, true, true>(lds, g, S, E, wave, lane); }
}
__device__ __forceinline__ void phase_g_gates(const Args& a, LAS unsigned char* lds, int layer, int G, int c, int wave, int lane) {
    pg8::Gemm g{(const bf16_t*)(a.ws + WS_XB), (const bf16_t*)(a.ws + WS_WG), T, 3072, 1024}; pg8::StaticOrder S; S.init(T, 3072, G, c);
    EpiP8<F_Gates> E{F_Gates{(bf16_t*)(a.ws + WS_GATES), a.in[12] + (size_t)layer * 3072}};
    pg8::gemm_phase<EpiP8<F_Gates>, pg8::StaticOrder, true, true>(lds, g, S, E, wave, lane);
}
__device__ __forceinline__ void phase_g_branch(const Args& a, LAS unsigned char* lds, int G, int c, int wave, int lane) {
    bf16_t* Y = (bf16_t*)(a.ws + WS_Y); const bf16_t* gates = (const bf16_t*)(a.ws + WS_GATES); const bf16_t* W = (const bf16_t*)(a.ws + WS_WBR);
    pg8::StaticOrder S; S.init(T, 1024, G, c);
    { pg8::Gemm g{(const bf16_t*)(a.ws + WS_OA), W, T, 1024, 512}; EpiP8<F_Branch<0>> E{F_Branch<0>{Y, gates}}; pg8::gemm_phase<EpiP8<F_Branch<0>>, pg8::StaticOrder, true, true>(lds, g, S, E, wave, lane); }
    { pg8::Gemm g{(const bf16_t*)(a.ws + WS_OB), W + (size_t)1024 * 512, T, 1024, 512}; EpiP8<F_Branch<1>> E{F_Branch<1>{Y, gates}}; pg8::gemm_phase<EpiP8<F_Branch<1>>, pg8::StaticOrder, true, true>(lds, g, S, E, wave, lane); }
    { pg8::Gemm g{(const bf16_t*)(a.ws + WS_PLD), W + (size_t)2 * 1024 * 512, T, 1024, 512}; EpiP8<F_Branch<2>> E{F_Branch<2>{Y, gates}}; pg8::gemm_phase<EpiP8<F_Branch<2>>, pg8::StaticOrder, true, true>(lds, g, S, E, wave, lane); }
}
__device__ __forceinline__ void phase_g_out(const Args& a, LAS unsigned char* lds, int G, int c, int wave, int lane) {
    pg8::Gemm g{(const bf16_t*)(a.ws + WS_Y), (const bf16_t*)(a.ws + WS_WOUT), T, 1024, 1024}; pg8::StaticOrder S; S.init(T, 1024, G, c);
    EpiP8<F_Bf16> E{F_Bf16{(bf16_t*)(a.ws + WS_MIX), 1024, 0x7fffffff}};
    pg8::gemm_phase<EpiP8<F_Bf16>, pg8::StaticOrder, true, true>(lds, g, S, E, wave, lane);
}
__device__ __forceinline__ void moe_table(const Args& a, LAS unsigned char* lds, MoeOrder& S, int G, int c, int tid) {
    const int* blk_e = (const int*)(a.ws + WS_BLKE); LAS int* tab = (LAS int*)(lds + LDS_TAB_OFF);
    const int nblk = blk_e[1023];
    for (int i = tid; i < nblk; i += NTHR) tab[i] = blk_e[i];
    __syncthreads();
    S.tab = tab; S.nunits = nblk * 4; S.G = G; S.c = c;
}
__device__ __forceinline__ void phase_moe1(const Args& a, LAS unsigned char* lds, int G, int c, int tid, int wave, int lane) {
    MoeOrder S; moe_table(a, lds, S, G, c, tid);
    pg8::Gemm g{(const bf16_t*)(a.ws + WS_XG), (const bf16_t*)(a.ws + WS_W13), CAP, NEXP * 1024, 1024};
    EpiPair<F_Hdn> E{F_Hdn{(bf16_t*)(a.ws + WS_HDN)}};
    pg8::gemm_phase<EpiPair<F_Hdn>, MoeOrder, true, true>(lds, g, S, E, wave, lane);
}
__device__ __forceinline__ void phase_moe2(const Args& a, LAS unsigned char* lds, int G, int c, int tid, int wave, int lane) {
    MoeOrder S; moe_table(a, lds, S, G, c, tid);
    pg8::Gemm g{(const bf16_t*)(a.ws + WS_HDN), (const bf16_t*)(a.ws + WS_W2), CAP, NEXP * 1024, 512};
    EpiP8<F_Bf16> E{F_Bf16{(bf16_t*)(a.ws + WS_YMOE), 1024, 1023}};
    pg8::gemm_phase<EpiP8<F_Bf16>, MoeOrder, true, true>(lds, g, S, E, wave, lane);
}


__device__ __forceinline__ void attn_stage_bias(const Args& a, LAS unsigned char* lds, int layer, int tid) {
    LAS float* rb = (LAS float*)lds;
    const float* relb = a.in[2] + (size_t)layer * A_HEADS * A_NREL;
    for (int i = tid; i < A_HEADS * A_NREL; i += NTHR) rb[i] = relb[i] * 1.4426950408889634f;
    __syncthreads();
}
__device__ __forceinline__ void attn_item(const Args& a, const LAS float* rb, int item, int lane) {
    const bf16_t* qA = (const bf16_t*)(a.ws + WS_QA); const bf16_t* kA = (const bf16_t*)(a.ws + WS_KA); const bf16_t* vT = (const bf16_t*)(a.ws + WS_VT); bf16_t* oA = (bf16_t*)(a.ws + WS_OA);
    const int fr = lane & 15, fq = lane >> 4;
    const int hq = item & 1, ci = (item >> 1) & 31, h = (item >> 6) & 7, b = item >> 9;
    const size_t tokq = (size_t)b * SEQ + ci * 64 + hq * 32;
    bf16x8 Bq[2][2];
#pragma unroll
    for (int qt = 0; qt < 2; ++qt)
#pragma unroll
        for (int ks = 0; ks < 2; ++ks) Bq[qt][ks] = *(const bf16x8*)(qA + (tokq + qt * 16 + fr) * 512 + h * 64 + ks * 32 + 8 * fq);
    f32x4 O[4][2];
#pragma unroll
    for (int dt = 0; dt < 4; ++dt) { O[dt][0] = (f32x4){0.f, 0.f, 0.f, 0.f}; O[dt][1] = (f32x4){0.f, 0.f, 0.f, 0.f}; }
    float mrun[2] = {-1.0e30f, -1.0e30f}, lrun[2] = {0.f, 0.f};
    const LAS float* rbh = rb + h * A_NREL;
    const float SC = 0.125f * 1.4426950408889634f;
    const int kc_lo = ci >= 8 ? ci - 8 : 0;
    for (int kc = kc_lo; kc <= ci; ++kc) {
        const int t = ci - kc;
        const size_t tokk = (size_t)b * SEQ + kc * 64;
        f32x4 S[4][2];
#pragma unroll
        for (int kt = 0; kt < 4; ++kt) {
            const bf16_t* kp = kA + (tokk + kt * 16 + fr) * 512 + h * 64 + 8 * fq;
            const bf16x8 Ak0 = *(const bf16x8*)kp, Ak1 = *(const bf16x8*)(kp + 32);
#pragma unroll
            for (int qt = 0; qt < 2; ++qt) {
                f32x4 z = (f32x4){0.f, 0.f, 0.f, 0.f};
                z = __builtin_amdgcn_mfma_f32_16x16x32_bf16(Ak0, Bq[qt][0], z, 0, 0, 0);
                S[kt][qt] = __builtin_amdgcn_mfma_f32_16x16x32_bf16(Ak1, Bq[qt][1], z, 0, 0, 0);
            }
        }
        if (t >= 5) {
            const float cb = rbh[319];
#pragma unroll
            for (int kt = 0; kt < 4; ++kt)
#pragma unroll
                for (int qt = 0; qt < 2; ++qt) S[kt][qt] = S[kt][qt] * SC + cb;
        } else {
#pragma unroll
            for (int kt = 0; kt < 4; ++kt)
#pragma unroll
                for (int qt = 0; qt < 2; ++qt)
#pragma unroll
                    for (int r = 0; r < 4; ++r) {
                        int dist = (hq * 32 + qt * 16 + fr) - (kt * 16 + 4 * fq + r) + 64 * t; dist = dist > A_CLIP ? A_CLIP : dist;
                        S[kt][qt][r] = S[kt][qt][r] * SC + rbh[dist + 63];
                    }
        }
#pragma unroll
        for (int qt = 0; qt < 2; ++qt) {
            float mx = S[0][qt][0];
#pragma unroll
            for (int kt = 0; kt < 4; ++kt)
#pragma unroll
                for (int r = 0; r < 4; ++r) mx = fmaxf(mx, S[kt][qt][r]);
            mx = fmaxf(mx, __shfl_xor(mx, 16)); mx = fmaxf(mx, __shfl_xor(mx, 32));
            const float mn = fmaxf(mrun[qt], mx), al = __builtin_amdgcn_exp2f(mrun[qt] - mn); mrun[qt] = mn;
            float ps = 0.f;
#pragma unroll
            for (int kt = 0; kt < 4; ++kt)
#pragma unroll
                for (int r = 0; r < 4; ++r) { const float p = __builtin_amdgcn_exp2f(S[kt][qt][r] - mn); S[kt][qt][r] = p; ps += p; }
            lrun[qt] = lrun[qt] * al + ps;
#pragma unroll
            for (int dt = 0; dt < 4; ++dt) O[dt][qt] = O[dt][qt] * al;
        }
        bf16x8 Bp[2][2];
#pragma unroll
        for (int qt = 0; qt < 2; ++qt)
#pragma unroll
            for (int s2 = 0; s2 < 2; ++s2) { const u32x4 w = pack8(S[2 * s2][qt], S[2 * s2 + 1][qt]); Bp[qt][s2] = __builtin_bit_cast(bf16x8, w); }
#pragma unroll
        for (int dt = 0; dt < 4; ++dt)
#pragma unroll
            for (int s2 = 0; s2 < 2; ++s2) {
                const bf16_t* vp = vT + (size_t)(h * 64 + dt * 16 + fr) * T + tokk + 32 * s2 + 4 * fq;
                const u32x2 lo = *(const u32x2*)vp, hi = *(const u32x2*)(vp + 16);
                const u32x4 w = {lo.x, lo.y, hi.x, hi.y}; const bf16x8 Av = __builtin_bit_cast(bf16x8, w);
#pragma unroll
                for (int qt = 0; qt < 2; ++qt) O[dt][qt] = __builtin_amdgcn_mfma_f32_16x16x32_bf16(Av, Bp[qt][s2], O[dt][qt], 0, 0, 0);
            }
    }
#pragma unroll
    for (int qt = 0; qt < 2; ++qt) {
        float l = lrun[qt]; l += __shfl_xor(l, 16); l += __shfl_xor(l, 32);
        const float inv = 1.0f / l;
#pragma unroll
        for (int dt = 0; dt < 4; ++dt) {
            const f32x4 o = O[dt][qt] * inv; u32x2 w; w.x = pg8::cvt_pk_bf16(o.x, o.y); w.y = pg8::cvt_pk_bf16(o.z, o.w);
            *(u32x2*)(oA + (tokq + qt * 16 + fr) * 512 + h * 64 + dt * 16 + 4 * fq) = w;
        }
    }
}
__device__ __forceinline__ void phase_attn(const Args& a, LAS unsigned char* lds, int layer, int wave, int lane, int tid, int G) {
    attn_stage_bias(a, lds, layer, tid);
    const LAS float* rb = (const LAS float*)lds;
    constexpr int NGRP = BATCH * A_HEADS * NCH / 4;
    const int per = (NGRP + G - 1) / G;
    for (int gi = 0; gi < per; ++gi) {
        const int grp = blockIdx.x * per + gi; if (grp >= NGRP) break;
        attn_item(a, rb, grp * 8 + wave, lane);
    }
    __syncthreads();
}


constexpr int PKR = 272, PKT = 144;
constexpr int G1_KR = 0, G1_LB = 4 * 64 * PKR, G1_CW = G1_LB + 65536, G1_GB = G1_CW + 8192, G1_BB = G1_GB + 1024, G1_GC = G1_BB + 1024, G1_END = G1_GC + 1024;
constexpr int G2_KR = 0, G2_QS = 17408, G2_KT = 34816, G2_VT = 53248, G2_VN = 71680, G2_QK = 90112, G2_ST = 99328, G2_CW = 134144, G2_SM = 140288, G2_WN = G2_SM + 2048, G2_END = G2_WN + 17408;
static_assert(G1_END <= LDS_BYTES - 16 && G2_END <= LDS_BYTES - 16, "gdn LDS maps");
#define MFMA16(a_, b_, c_) __builtin_amdgcn_mfma_f32_16x16x32_bf16((a_), (b_), (c_), 0, 0, 0)
#define LDSF(off) (*(const LAS bf16x8*)(lds + (off)))

__device__ __forceinline__ void gdn_pre_stage(const Args& a, LAS unsigned char* lds, int layer, int tid) {
    LAS float* cw = (LAS float*)(lds + G1_CW);
    const float* cwg = a.in[3] + (size_t)layer * 4 * 1536;
    for (int i = tid; i < 4 * 512; i += NTHR) cw[i] = cwg[(i >> 9) * 1536 + 512 + (i & 511)];
    __syncthreads();
}
__device__ __forceinline__ void gdn_pre_item(const Args& a, LAS unsigned char* lds, int layer, int item, int wave, int lane, int tid) {
    const int b = item >> 5, n = item & 31;
    const bf16_t* qkvB = (const bf16_t*)(a.ws + WS_QKVB); const float* bdl = (const float*)(a.ws + WS_BDL); float* gcg = (float*)(a.ws + WS_GC);
    const LAS float* cw = (const LAS float*)(lds + G1_CW); LAS float* gb = (LAS float*)(lds + G1_GB); LAS float* bb = (LAS float*)(lds + G1_BB); LAS float* gcb = (LAS float*)(lds + G1_GC);
    {
        const int tk = tid >> 3, cgp = tid & 7, hh = cgp >> 1, half = cgp & 1;
        const int tl = n * 64 + tk; const size_t r = (size_t)b * SEQ + tl;
        const int cbase = hh * 128 + half * 64;
        float kv[64];
#pragma unroll
        for (int c = 0; c < 64; ++c) kv[c] = 0.f;
#pragma unroll
        for (int i = 0; i < 4; ++i) {
            if (tl - 3 + i >= 0) {
                const u32x4* src = (const u32x4*)(qkvB + (r - 3 + i) * 1536 + 512 + cbase);
#pragma unroll
                for (int q = 0; q < 8; ++q) { const u32x4 w = src[q]; const LAS float* wp = cw + i * 512 + cbase + 8 * q;
                    const f32x4 w0 = *(const LAS f32x4*)wp, w1 = *(const LAS f32x4*)(wp + 4);
                    kv[8 * q + 0] += w0.x * bflo(w.x); kv[8 * q + 1] += w0.y * bfhi(w.x); kv[8 * q + 2] += w0.z * bflo(w.y); kv[8 * q + 3] += w0.w * bfhi(w.y);
                    kv[8 * q + 4] += w1.x * bflo(w.z); kv[8 * q + 5] += w1.y * bfhi(w.z); kv[8 * q + 6] += w1.z * bflo(w.w); kv[8 * q + 7] += w1.w * bfhi(w.w); }
            }
            asm volatile("" ::: "memory");
        }
        float ss = 0.f;
#pragma unroll
        for (int c = 0; c < 64; ++c) { kv[c] = siluf_(kv[c]); ss += kv[c] * kv[c]; }
        ss += __shfl_xor(ss, 1);
        const float rk = rsqrtf(ss + RMS_EPS);
        LAS unsigned char* dst = lds + G1_KR + hh * (64 * PKR) + tk * PKR + half * 128;
#pragma unroll
        for (int q = 0; q < 8; ++q) { f32x4 x0 = {kv[8 * q] * rk, kv[8 * q + 1] * rk, kv[8 * q + 2] * rk, kv[8 * q + 3] * rk}, x1 = {kv[8 * q + 4] * rk, kv[8 * q + 5] * rk, kv[8 * q + 6] * rk, kv[8 * q + 7] * rk};
            *(LAS u32x4*)(dst + 16 * q) = pack8(x0, x1); }
        if (half == 0) {
            const float Aexp = expf(a.in[4][layer * 4 + hh]), dtb = a.in[5][layer * 4 + hh];
            bb[hh * 64 + tk] = sigmoidf_(bdl[r * 8 + hh]);
            gb[hh * 64 + tk] = -Aexp * softplusf_(bdl[r * 8 + 4 + hh] + dtb);
        }
    }
    __syncthreads();
    {
        const int hh = wave >> 1, fr = lane & 15, fq = lane >> 4;
        float g = gb[hh * 64 + lane];
#pragma unroll
        for (int o = 1; o < 64; o <<= 1) { const float t = __shfl_up(g, o); if (lane >= o) g += t; }
        gcb[hh * 64 + lane] = g;
        if ((wave & 1) == 0) gcg[((size_t)b * SEQ + n * 64 + lane) * 4 + hh] = g;
        asm volatile("s_waitcnt lgkmcnt(0)" ::: "memory");
        const int kr = G1_KR + hh * (64 * PKR);
        LAS float* Lb = (LAS float*)(lds + G1_LB) + hh * 4096;
#pragma unroll
        for (int tt = 0; tt < 2; ++tt) {
            const int ti = 2 * (wave & 1) + tt;
            bf16x8 Af[4];
#pragma unroll
            for (int ks = 0; ks < 4; ++ks) Af[ks] = LDSF(kr + (ti * 16 + fr) * PKR + ks * 64 + fq * 16);
#pragma unroll
            for (int tj = 0; tj < 4; ++tj) {
                f32x4 acc = {0.f, 0.f, 0.f, 0.f};
                if (tj <= ti) {
#pragma unroll
                    for (int ks = 0; ks < 4; ++ks) acc = MFMA16(Af[ks], LDSF(kr + (tj * 16 + fr) * PKR + ks * 64 + fq * 16), acc);
                }
                const int j = tj * 16 + fr; const float gcj = gcb[hh * 64 + j];
#pragma unroll
                for (int rg = 0; rg < 4; ++rg) { const int i = ti * 16 + 4 * fq + rg;
                    Lb[i * 64 + j] = (i > j) ? bb[hh * 64 + i] * acc[rg] * __expf(gcb[hh * 64 + i] - gcj) : 0.f; }
            }
        }
    }
    __syncthreads();
    if (wave < 4) {
        const int hh = wave; const LAS float* Lb = (const LAS float*)(lds + G1_LB) + hh * 4096;
        float Tc[64];
        int ln = lane; asm volatile("" : "+v"(ln));
#pragma unroll
        for (int i = 0; i < 64; ++i) {
            float acc = (ln == i) ? 1.f : 0.f;
#pragma unroll
            for (int j4 = 0; j4 < (i + 3) / 4; ++j4) { const f32x4 l4 = *(const LAS f32x4*)(Lb + i * 64 + 4 * j4);
                if (4 * j4 + 0 < i) acc -= l4.x * Tc[4 * j4 + 0];
                if (4 * j4 + 1 < i) acc -= l4.y * Tc[4 * j4 + 1];
                if (4 * j4 + 2 < i) acc -= l4.z * Tc[4 * j4 + 2];
                if (4 * j4 + 3 < i) acc -= l4.w * Tc[4 * j4 + 3]; }
            Tc[i] = acc;
            if ((i & 3) == 3) asm volatile("" ::: "memory");
        }
        const float bc = bb[hh * 64 + lane], ec = bc * __expf(gcb[hh * 64 + lane]);
        bf16_t* tu = (bf16_t*)(a.ws + WS_TMU) + ((size_t)item * 4 + hh) * 4096; bf16_t* tw = (bf16_t*)(a.ws + WS_TMW) + ((size_t)item * 4 + hh) * 4096;
#pragma unroll
        for (int i = 0; i < 64; ++i) { tu[i * 64 + lane] = (bf16_t)f2bf(Tc[i] * bc); tw[i * 64 + lane] = (bf16_t)f2bf(Tc[i] * ec); }
    }
    __syncthreads();
}

__device__ __forceinline__ void st8(LAS unsigned char* p, f32x4 v) { u32x2 w; w.x = pg8::cvt_pk_bf16(v.x, v.y); w.y = pg8::cvt_pk_bf16(v.z, v.w); *(LAS u32x2*)p = w; }

__device__ __forceinline__ void gdn_scan_item(const Args& a, LAS unsigned char* lds, int layer, int item, int wave, int lane, int tid) {
    asm volatile("" : "+v"(tid), "+v"(lane));
    const int b = item >> 2, h = item & 3; int fr = lane & 15, fq = lane >> 4;
#define RELANE() asm volatile("" : "+v"(fr), "+v"(fq))
    const bf16_t* qkvB = (const bf16_t*)(a.ws + WS_QKVB); const float* bdl = (const float*)(a.ws + WS_BDL); const float* gcg = (const float*)(a.ws + WS_GC);
    const bf16_t* gateB = (const bf16_t*)(a.ws + WS_GATEB);
    bf16_t* oB = (bf16_t*)(a.ws + WS_OB);
    LAS float* cwl = (LAS float*)(lds + G2_CW);
    LAS float* gcs = (LAS float*)(lds + G2_SM); LAS float* egc = gcs + 64; LAS float* ekd = gcs + 128; LAS float* ng = gcs + 192; LAS float* red = gcs + 320;
    {
        const float* cwg = a.in[3] + (size_t)layer * 4 * 1536;
        for (int i = tid; i < 4 * 384; i += NTHR) { const int tap = i / 384, rem = i % 384, seg = rem >> 7, c = rem & 127; cwl[i] = cwg[tap * 1536 + seg * 512 + h * 128 + c]; }
        for (int i = tid; i < 128; i += NTHR) ng[i] = a.in[6][layer * 128 + i];
        for (int i = tid; i < 34816 / 16; i += NTHR) ((LAS u32x4*)(lds + G2_ST))[i] = (u32x4){0u, 0u, 0u, 0u};
    }
    f32x4 Sacc[8];
#pragma unroll
    for (int i = 0; i < 8; ++i) Sacc[i] = (f32x4){0.f, 0.f, 0.f, 0.f};
    __syncthreads();
#define G2_LBAR() asm volatile("s_waitcnt lgkmcnt(0)\n\ts_barrier" ::: "memory")
    for (int n = 0; n < NCH; ++n) {
        const size_t tok0 = (size_t)b * SEQ + n * 64;
        int zv_ = 0; asm volatile("" : "+v"(zv_));
        const float gcl = gcg[(tok0 + 63) * 4 + h + zv_];
        {
            asm volatile("" : "+v"(tid));
            const int tk = tid >> 3, cgp = tid & 7, c0 = cgp * 16;
            const int tl = n * 64 + tk; const size_t r = tok0 + tk;
            const LAS float* cwv = cwl; asm volatile("" : "+v"(cwv));
            const bf16_t* qkvb_it = qkvB + (size_t)tok0 * 1536 + h * 128;
            int rowo[4]; float vm[4];
#pragma unroll
            for (int i = 0; i < 4; ++i) { const bool ok = (tl - 3 + i >= 0); rowo[i] = (ok ? (tk - 3 + i) : tk) * 1536 + c0; vm[i] = ok ? 1.f : 0.f; }
#define rowp_(i) (qkvb_it + rowo[i])
#define G2_ACC16(d, x0, x1, wp, vm_) do { const f32x4 w0 = *(const LAS f32x4*)(wp) * (vm_), w1 = *(const LAS f32x4*)((wp) + 4) * (vm_), w2 = *(const LAS f32x4*)((wp) + 8) * (vm_), w3 = *(const LAS f32x4*)((wp) + 12) * (vm_); \
                d[0] += w0.x * bflo(x0.x); d[1] += w0.y * bfhi(x0.x); d[2] += w0.z * bflo(x0.y); d[3] += w0.w * bfhi(x0.y); d[4] += w1.x * bflo(x0.z); d[5] += w1.y * bfhi(x0.z); d[6] += w1.z * bflo(x0.w); d[7] += w1.w * bfhi(x0.w); \
                d[8] += w2.x * bflo(x1.x); d[9] += w2.y * bfhi(x1.x); d[10] += w2.z * bflo(x1.y); d[11] += w2.w * bfhi(x1.y); d[12] += w3.x * bflo(x1.z); d[13] += w3.y * bfhi(x1.z); d[14] += w3.z * bflo(x1.w); d[15] += w3.w * bfhi(x1.w); } while (0)
            u32x4 rw[4][2];
#define G2_LOAD8(segoff) do { _Pragma("unroll") for (int i = 0; i < 4; ++i) { rw[i][0] = *(const u32x4*)(rowp_(i) + (segoff)); rw[i][1] = *(const u32x4*)(rowp_(i) + (segoff) + 8); } } while (0)
            const int odd = tk & 1;
            const float gc = gcg[r * 4 + h];
            G2_LOAD8(0);
            {
                float q[16];
#pragma unroll
                for (int c = 0; c < 16; ++c) q[c] = 0.f;
#pragma unroll
                for (int i = 0; i < 4; ++i) G2_ACC16(q, rw[i][0], rw[i][1], cwv + i * 384 + c0, vm[i]);
                G2_LOAD8(512);
                float sq = 0.f;
#pragma unroll
                for (int c = 0; c < 16; ++c) { q[c] = siluf_(q[c]); sq += q[c] * q[c]; }
                sq += __shfl_xor(sq, 1); sq += __shfl_xor(sq, 2); sq += __shfl_xor(sq, 4);
                const float rq_ = rsqrtf(sq + RMS_EPS) * 0.08838834764831845f;
                f32x4 a0 = {q[0] * rq_, q[1] * rq_, q[2] * rq_, q[3] * rq_}, a1 = {q[4] * rq_, q[5] * rq_, q[6] * rq_, q[7] * rq_}, a2 = {q[8] * rq_, q[9] * rq_, q[10] * rq_, q[11] * rq_}, a3 = {q[12] * rq_, q[13] * rq_, q[14] * rq_, q[15] * rq_};
                *(LAS u32x4*)(lds + G2_QS + tk * PKR + c0 * 2) = pack8(a0, a1); *(LAS u32x4*)(lds + G2_QS + tk * PKR + c0 * 2 + 16) = pack8(a2, a3);
            }
            {
                float k[16];
#pragma unroll
                for (int c = 0; c < 16; ++c) k[c] = 0.f;
#pragma unroll
                for (int i = 0; i < 4; ++i) G2_ACC16(k, rw[i][0], rw[i][1], cwv + i * 384 + 128 + c0, vm[i]);
                G2_LOAD8(1024);
                float sk = 0.f;
#pragma unroll
                for (int c = 0; c < 16; ++c) { k[c] = siluf_(k[c]); sk += k[c] * k[c]; }
                sk += __shfl_xor(sk, 1); sk += __shfl_xor(sk, 2); sk += __shfl_xor(sk, 4);
                const float rk_ = rsqrtf(sk + RMS_EPS);
                unsigned kb[8];
#pragma unroll
                for (int c = 0; c < 8; ++c) kb[c] = pg8::cvt_pk_bf16(k[2 * c] * rk_, k[2 * c + 1] * rk_);
                *(LAS u32x4*)(lds + G2_KR + tk * PKR + c0 * 2) = (u32x4){kb[0], kb[1], kb[2], kb[3]}; *(LAS u32x4*)(lds + G2_KR + tk * PKR + c0 * 2 + 16) = (u32x4){kb[4], kb[5], kb[6], kb[7]};
#pragma unroll
                for (int c = 0; c < 8; ++c) {
                    const unsigned pk_ = (unsigned)__shfl_xor((int)kb[c], 8);
                    const unsigned wk = odd ? ((pk_ >> 16) | (kb[c] & 0xffff0000u)) : ((kb[c] & 0xffffu) | (pk_ << 16));
                    *(LAS unsigned*)(lds + G2_KT + (c0 + 2 * c + odd) * PKT + (tk & ~1) * 2) = wk;
                }
            }
            {
                float v[16];
#pragma unroll
                for (int c = 0; c < 16; ++c) v[c] = 0.f;
#pragma unroll
                for (int i = 0; i < 4; ++i) G2_ACC16(v, rw[i][0], rw[i][1], cwv + i * 384 + 256 + c0, vm[i]);
#pragma unroll
                for (int c = 0; c < 8; ++c) {
                    const unsigned vb = pg8::cvt_pk_bf16(siluf_(v[2 * c]), siluf_(v[2 * c + 1]));
                    const unsigned pv_ = (unsigned)__shfl_xor((int)vb, 8);
                    const unsigned wv = odd ? ((pv_ >> 16) | (vb & 0xffff0000u)) : ((vb & 0xffffu) | (pv_ << 16));
                    *(LAS unsigned*)(lds + G2_VT + (c0 + 2 * c + odd) * PKT + (tk & ~1) * 2) = wv;
                }
            }
#undef G2_LOAD8
#undef G2_ACC16
#undef rowp_
            if (cgp == 0) { gcs[tk] = gc; egc[tk] = __expf(gc); ekd[tk] = __expf(gcl - gc); }
        }
        const float gl = __expf(gcl);
        const bf16_t* tmu = (const bf16_t*)(a.ws + WS_TMU) + (((size_t)(b * 32 + n)) * 4 + h) * 4096; const bf16_t* tmw = (const bf16_t*)(a.ws + WS_TMW) + (((size_t)(b * 32 + n)) * 4 + h) * 4096;
        RELANE();
        bf16x8 TW[4][2];
#pragma unroll
        for (int it = 0; it < 4; ++it) { TW[it][0] = *(const bf16x8*)(tmw + (it * 16 + fr) * 64 + 8 * fq); TW[it][1] = *(const bf16x8*)(tmw + (it * 16 + fr) * 64 + 32 + 8 * fq); }
        G2_LBAR();
        RELANE();
        {
            const int tj = wave & 3;
#pragma unroll
            for (int tt = 0; tt < 2; ++tt) {
                const int ti = 2 * (wave >> 2) + tt;
                f32x4 acc = {0.f, 0.f, 0.f, 0.f};
                if (ti >= tj) {
#pragma unroll
                    for (int ks = 0; ks < 4; ++ks) acc = MFMA16(LDSF(G2_KR + (tj * 16 + fr) * PKR + ks * 64 + fq * 16), LDSF(G2_QS + (ti * 16 + fr) * PKR + ks * 64 + fq * 16), acc);
                }
                const int i = ti * 16 + fr; const float gci = gcs[i];
                f32x4 o;
#pragma unroll
                for (int rg = 0; rg < 4; ++rg) { const int j = tj * 16 + 4 * fq + rg; o[rg] = (i >= j) ? acc[rg] * __expf(gci - gcs[j]) : 0.f; }
                st8(lds + G2_QK + i * PKT + (tj * 16 + 4 * fq) * 2, o);
            }
        }
        RELANE();
        {
            const bf16x8 A0 = LDSF(G2_KT + (wave * 16 + fr) * PKT + fq * 16), A1 = LDSF(G2_KT + (wave * 16 + fr) * PKT + 64 + fq * 16);
#pragma unroll
            for (int it = 0; it < 4; ++it) {
                f32x4 acc = {0.f, 0.f, 0.f, 0.f};
                acc = MFMA16(A0, TW[it][0], acc); acc = MFMA16(A1, TW[it][1], acc);
                st8(lds + G2_WN + (it * 16 + fr) * PKR + (wave * 16 + 4 * fq) * 2, -acc);
            }
        }
        bf16x8 TU[4][2];
#pragma unroll
        for (int it = 0; it < 4; ++it) { TU[it][0] = *(const bf16x8*)(tmu + (it * 16 + fr) * 64 + 8 * fq); TU[it][1] = *(const bf16x8*)(tmu + (it * 16 + fr) * 64 + 32 + 8 * fq); }
        G2_LBAR();
        RELANE();
        f32x4 vn[4];
        {
            bf16x8 Bv[2], Bs[4];
#pragma unroll
            for (int ks = 0; ks < 2; ++ks) Bv[ks] = LDSF(G2_VT + (wave * 16 + fr) * PKT + ks * 64 + fq * 16);
#pragma unroll
            for (int ks = 0; ks < 4; ++ks) Bs[ks] = LDSF(G2_ST + (wave * 16 + fr) * PKR + ks * 64 + fq * 16);
#pragma unroll
            for (int it = 0; it < 4; ++it) {
                f32x4 acc = {0.f, 0.f, 0.f, 0.f};
#pragma unroll
                for (int ks = 0; ks < 2; ++ks) acc = MFMA16(TU[it][ks], Bv[ks], acc);
#pragma unroll
                for (int ks = 0; ks < 4; ++ks) acc = MFMA16(LDSF(G2_WN + (it * 16 + fr) * PKR + ks * 64 + fq * 16), Bs[ks], acc);
                vn[it] = acc;
            }
        }
        G2_LBAR();
        RELANE();
#pragma unroll
        for (int it = 0; it < 4; ++it) {
            st8(lds + G2_VN + (wave * 16 + fr) * PKT + (it * 16 + 4 * fq) * 2, vn[it]);
            const f32x4 e4 = *(const LAS f32x4*)(ekd + it * 16 + 4 * fq);
            st8(lds + G2_VT + (wave * 16 + fr) * PKT + (it * 16 + 4 * fq) * 2, vn[it] * e4);
        }
        G2_LBAR();
        RELANE();
        {
            const int it = wave & 3, dq = 4 * (wave >> 2);
            const size_t tok = tok0 + it * 16 + fr;
            u32x2 gt[4];
#pragma unroll
            for (int x = 0; x < 4; ++x) gt[x] = *(const u32x2*)(gateB + tok * 512 + h * 128 + (dq + x) * 16 + 4 * fq);
            bf16x8 Bq[4], Bk[2];
#pragma unroll
            for (int ks = 0; ks < 4; ++ks) Bq[ks] = LDSF(G2_QS + (it * 16 + fr) * PKR + ks * 64 + fq * 16);
#pragma unroll
            for (int ks = 0; ks < 2; ++ks) Bk[ks] = LDSF(G2_QK + (it * 16 + fr) * PKT + ks * 64 + fq * 16);
            const float eg = egc[it * 16 + fr];
            f32x4 O[4]; float ss = 0.f;
#pragma unroll
            for (int x = 0; x < 4; ++x) {
                f32x4 acc = {0.f, 0.f, 0.f, 0.f};
#pragma unroll
                for (int ks = 0; ks < 4; ++ks) acc = MFMA16(LDSF(G2_ST + ((dq + x) * 16 + fr) * PKR + ks * 64 + fq * 16), Bq[ks], acc);
                acc = acc * eg;
#pragma unroll
                for (int ks = 0; ks < 2; ++ks) acc = MFMA16(LDSF(G2_VN + ((dq + x) * 16 + fr) * PKT + ks * 64 + fq * 16), Bk[ks], acc);
                O[x] = acc; ss += (acc.x * acc.x + acc.y * acc.y) + (acc.z * acc.z + acc.w * acc.w);
            }
            ss += __shfl_xor(ss, 16); ss += __shfl_xor(ss, 32);
            if (fq == 0) red[(wave >> 2) * 64 + it * 16 + fr] = ss;
            RELANE();
            {
                const bf16x8 A0 = LDSF(G2_KT + (wave * 16 + fr) * PKT + fq * 16), A1 = LDSF(G2_KT + (wave * 16 + fr) * PKT + 64 + fq * 16);
#pragma unroll
                for (int dv = 0; dv < 8; ++dv) {
                    f32x4 acc = Sacc[dv] * gl;
                    acc = MFMA16(A0, LDSF(G2_VT + (dv * 16 + fr) * PKT + fq * 16), acc);
                    acc = MFMA16(A1, LDSF(G2_VT + (dv * 16 + fr) * PKT + 64 + fq * 16), acc);
                    Sacc[dv] = acc;
                }
            }
            G2_LBAR();
            RELANE();
            const float tot = red[it * 16 + fr] + red[64 + it * 16 + fr];
            const float rstd = rsqrtf(tot * (1.0f / 128.0f) + RMS_EPS);
#pragma unroll
            for (int x = 0; x < 4; ++x) {
                const f32x4 g4 = *(const LAS f32x4*)(ng + (dq + x) * 16 + 4 * fq);
                const float t0 = bflo(gt[x].x), t1 = bfhi(gt[x].x), t2 = bflo(gt[x].y), t3 = bfhi(gt[x].y);
                f32x4 o = O[x] * rstd * g4; o.x *= t0 * fsig(t0); o.y *= t1 * fsig(t1); o.z *= t2 * fsig(t2); o.w *= t3 * fsig(t3);
                u32x2 w; w.x = pg8::cvt_pk_bf16(o.x, o.y); w.y = pg8::cvt_pk_bf16(o.z, o.w);
                *(u32x2*)(oB + tok * 512 + h * 128 + (dq + x) * 16 + 4 * fq) = w;
            }
#pragma unroll
            for (int dv = 0; dv < 8; ++dv) st8(lds + G2_ST + (dv * 16 + fr) * PKR + (wave * 16 + 4 * fq) * 2, Sacc[dv]);
        }
        G2_LBAR();
    }
}
#undef G2_LBAR
#undef RELANE

constexpr int CW_ATTQ = 65536;
__device__ __forceinline__ void phase_pre(const Args& a, LAS unsigned char* lds, int layer, int gw, int NGW, int wave, int lane, int tid, int G) {
    gdn_pre_stage(a, lds, layer, tid);
    for (int item = blockIdx.x; item < BATCH * NCH; item += G) gdn_pre_item(a, lds, layer, item, wave, lane, tid);
    phase_pool(a, gw, NGW, lane);
}
__device__ __forceinline__ void phase_mix(const Args& a, LAS unsigned char* lds, int layer, int qsel, int wave, int lane, int tid, int G) {
    for (int rep_ = 0; rep_ < ((PROBE_MIX == 1 && layer == 0) ? 1 + PROBE_REP : 1); ++rep_)
    for (int item = blockIdx.x; item < BATCH * B_HEADS; item += G) gdn_scan_item(a, lds, layer, item, wave, lane, tid);
    __syncthreads();
    lane = fresh_lane(); tid = wave * 64 + lane;
    attn_stage_bias(a, lds, layer, tid);
    const LAS float* rb = (const LAS float*)lds;
    LAS int* qslot = (LAS int*)(lds + 16384);
    unsigned* qctr = (unsigned*)(a.ws + WS_CTL) + CW_ATTQ + qsel * 64;
    constexpr int NGRP = BATCH * A_HEADS * NCH / 4;
    for (int rep_ = 0; rep_ < ((PROBE_MIX == 2 && layer == 0) ? 1 + PROBE_REP : 1); ++rep_, qctr += 64)
    for (;;) {
        if (tid == 0) *qslot = (int)__hip_atomic_fetch_add(qctr, 1u, __ATOMIC_RELAXED, __HIP_MEMORY_SCOPE_AGENT);
        __syncthreads();
        const int grp = *qslot;
        __syncthreads();
        if (grp >= NGRP) break;
        attn_item(a, rb, grp * 8 + wave, lane);
    }
}

#define XB_TMO      128
#define XB_XCNT(j)  (256  + 64 * (j))
#define XB_XSUB(j)  (1280 + 64 * (j))
#define XB_XGEN(j)  (2304 + 64 * (j))
#define XB_TOP      3328
#define XB_TOPGEN   3392
#define XCD_BAR_WORDS 3456
#define XB_SPIN_CAP (1u << 18)

__device__ __forceinline__ unsigned xb_ld(unsigned* p)              { return __hip_atomic_load(p, __ATOMIC_RELAXED, __HIP_MEMORY_SCOPE_AGENT); }
__device__ __forceinline__ unsigned xb_add(unsigned* p, unsigned v) { return __hip_atomic_fetch_add(p, v, __ATOMIC_RELAXED, __HIP_MEMORY_SCOPE_AGENT); }
__device__ __forceinline__ unsigned xb_xcc_id() { return (unsigned)__builtin_amdgcn_s_getreg((3 << 11) | 20) & 0xFu; }
#define XB_SPIN(cond, bar) do { unsigned _sp = 0; while (cond) { __builtin_amdgcn_s_sleep(1); \
    if ((++_sp & 255u) == 0u) { if (xb_ld(&(bar)[XB_TMO])) break; if (_sp > XB_SPIN_CAP) { atomicAdd(&(bar)[XB_TMO], 1u); break; } } } } while (0)

struct XcdBarrier {
    unsigned* bar; unsigned x;
    volatile LAS unsigned* st;
};

__device__ __forceinline__ XcdBarrier xcd_barrier_post(unsigned* bar, volatile LAS unsigned* st) {
    XcdBarrier b; b.bar = bar; b.x = xb_xcc_id(); b.st = st;
    if (threadIdx.x == 0) (void)xb_add(&bar[XB_XCNT(b.x)], 1u);
    return b;
}
__device__ __forceinline__ void xcd_barrier_complete(unsigned* bar, unsigned x, unsigned& nloc, unsigned& nx) {
    const unsigned G = gridDim.x * gridDim.y * gridDim.z;
    unsigned sum, cnt, mine, sp = 0u;
    for (;;) {
        sum = 0u; cnt = 0u; mine = 0u;
#pragma unroll
        for (unsigned j = 0; j < 16; ++j) { const unsigned c = xb_ld(&bar[XB_XCNT(j)]); sum += c; cnt += (c > 0u) ? 1u : 0u; mine = (j == x) ? c : mine; }
        if (sum == G) break;
        __builtin_amdgcn_s_sleep(1);
        if ((++sp & 255u) == 0u) { if (xb_ld(&bar[XB_TMO])) break; if (sp > XB_SPIN_CAP) { atomicAdd(&bar[XB_TMO], 1u); break; } }
    }
    nloc = mine > 0u ? mine : 1u; nx = cnt > 0u ? cnt : 1u;
}

__device__ __forceinline__ void xcd_barrier(const XcdBarrier& b) {
    asm volatile("s_waitcnt vmcnt(0)" ::: "memory");
    __syncthreads();
    if (threadIdx.x == 0) {
        unsigned* bar = b.bar;
        __builtin_amdgcn_s_waitcnt(0);
        unsigned nloc = b.st[0], nx = b.st[1];
        if (nloc == 0u) { xcd_barrier_complete(bar, b.x, nloc, nx); b.st[0] = nloc; b.st[1] = nx; }
        const unsigned old = xb_add(&bar[XB_XSUB(b.x)], 1u);
        const unsigned gen = old / nloc;
        if (old + 1u == (gen + 1u) * nloc) {
            __builtin_amdgcn_fence(__ATOMIC_RELEASE, "agent");
            asm volatile("s_waitcnt vmcnt(0)" ::: "memory");
            const unsigned og = xb_add(&bar[XB_TOP], 1u);
            const unsigned tg = og / nx;
            if (og + 1u == (tg + 1u) * nx) xb_add(&bar[XB_TOPGEN], 1u);
            else XB_SPIN(xb_ld(&bar[XB_TOPGEN]) == tg, bar);
            __builtin_amdgcn_fence(__ATOMIC_ACQUIRE, "agent");
            xb_add(&bar[XB_XGEN(b.x)], 1u);
            asm volatile("s_waitcnt vmcnt(0)" ::: "memory");
        } else {
            XB_SPIN(xb_ld(&bar[XB_XGEN(b.x)]) == gen, bar);
            __builtin_amdgcn_fence(__ATOMIC_ACQUIRE, "agent");
            asm volatile("s_waitcnt vmcnt(0)" ::: "memory");
        }
    }
    __syncthreads();
}


constexpr int CW_BAR = 4096;
constexpr int LDS_BARW = LDS_BYTES - 16;
#define IN(k) (a.ph_lo <= (k) && (k) < a.ph_hi)
#define SEAM(k) do { if (fused && !((k) == PH_COUNT - 1 && layer == a.lay_hi - 1) && !((k) == a.ph_hi - 1 && a.ph_hi < PH_COUNT)) xcd_barrier(bar); } while (0)
template <int layer> __device__ __forceinline__ void layer_prog(const Args& a, LAS unsigned char* lds, const XcdBarrier& bar, bool fused, int gw, int NGW, int wave, int GT, int G) {
#define RUN(k, ...) if (IN(k)) { constexpr int nrep_ = (layer == 0 && (k) == PROBE_PH) ? 1 + PROBE_REP : 1; _Pragma("unroll") for (int rep = 0; rep < nrep_; ++rep) { \
        const int lane = fresh_lane(), tid = wave * 64 + lane, gtid = (int)blockIdx.x * NTHR + tid; (void)gtid; __VA_ARGS__; if (rep + 1 < nrep_) xcd_barrier(bar); } SEAM(k); }
    RUN(PH_CONVERT, phase_convert(a, lds, layer, gw, NGW, wave, lane, tid, gtid, GT); if (layer == 0) { __syncthreads(); phase_xconv(a, lds, gw, NGW, lane, tid); })
    RUN(PH_PROJ1, phase_g_proj1(a, lds, G, (int)blockIdx.x, wave, lane))
    RUN(PH_PRE, phase_pre(a, lds, layer, gw, NGW, wave, lane, tid, G))
    RUN(PH_MIX, phase_mix(a, lds, layer, layer * 4 + rep, wave, lane, tid, G))
    RUN(PH_GATES, phase_g_gates(a, lds, layer, G, (int)blockIdx.x, wave, lane))
    RUN(PH_BRANCH, phase_g_branch(a, lds, G, (int)blockIdx.x, wave, lane))
    RUN(PH_OUT, phase_g_out(a, lds, G, (int)blockIdx.x, wave, lane))
    RUN(PH_LN1, phase_ln1(a, lds, layer, gw, NGW, wave, lane))
    RUN(PH_SLOTS, phase_slots(a, lds, gw, NGW, wave, lane, tid))
    RUN(PH_MOE1, phase_moe1(a, lds, G, (int)blockIdx.x, tid, wave, lane))
    RUN(PH_MOE2, phase_moe2(a, lds, G, (int)blockIdx.x, tid, wave, lane))
    RUN(PH_LN2, phase_ln2(a, lds, layer, gw, NGW, lane, tid))
#undef RUN
}
#undef IN
#undef SEAM
__global__ void __launch_bounds__(NTHR, 2) mk(Args a) {
    extern __shared__ __attribute__((aligned(16))) unsigned char lds_raw[];
    LAS unsigned char* lds = (LAS unsigned char*)lds_raw;
    const int tid = threadIdx.x, lane = tid & 63, wave = __builtin_amdgcn_readfirstlane(tid >> 6);
    const int G = gridDim.x, gw = blockIdx.x * NWAVES + wave, NGW = G * NWAVES, gtid = blockIdx.x * NTHR + tid, GT = G * NTHR;
    const bool fused = (a.ph_hi - a.ph_lo > 1) || (a.lay_hi - a.lay_lo > 1);
    if (tid == 0) *(LAS u32x4*)(lds + LDS_BARW) = (u32x4){0u, 0u, 0u, 0u};
    __syncthreads();
    XcdBarrier bar; bar.bar = (unsigned*)(a.ws + WS_CTL) + CW_BAR; bar.x = 0; bar.st = (volatile LAS unsigned*)(lds + LDS_BARW);
    if (fused) bar = xcd_barrier_post((unsigned*)(a.ws + WS_CTL) + CW_BAR, (volatile LAS unsigned*)(lds + LDS_BARW));
    if (a.lay_lo <= 0 && 0 < a.lay_hi) layer_prog<0>(a, lds, bar, fused, gw, NGW, wave, GT, G);
    if (a.lay_lo <= 1 && 1 < a.lay_hi) layer_prog<1>(a, lds, bar, fused, gw, NGW, wave, GT, G);
}

extern "C" void kernel_launch(void* const* d_in, const int* in_sizes, int n_in, void* d_out, int out_size, void* d_ws, size_t ws_size, hipStream_t stream) {
    static int grid = 0;
    if (grid == 0) {
        if (n_in != 25 || in_sizes[0] != T * D || out_size != T * D || ws_size < WS_END) { fprintf(stderr, "kernel_launch: unexpected shapes (n_in %d, in0 %d, out %d, ws %zu < %zu)\n", n_in, n_in > 0 ? in_sizes[0] : -1, out_size, ws_size, (size_t)WS_END); grid = -1; return; }
        int dev = 0, cus = 0;
        if (hipGetDevice(&dev) != hipSuccess || hipDeviceGetAttribute(&cus, hipDeviceAttributeMultiprocessorCount, dev) != hipSuccess) { grid = -1; return; }
        if (hipFuncSetAttribute((const void*)mk, hipFuncAttributeMaxDynamicSharedMemorySize, LDS_BYTES) != hipSuccess) { fprintf(stderr, "kernel_launch: hipFuncSetAttribute failed\n"); grid = -1; return; }
        grid = cus;
    }
    if (grid < 0) return;
    unsigned char* ws = (unsigned char*)d_ws;
    (void)hipMemsetAsync(ws + WS_CTL, 0, 1 * MiB, stream);
    Args a{};
    for (int i = 0; i < 25; ++i) a.in[i] = (const float*)d_in[i];
    a.out = (float*)d_out; a.ws = ws;
#if MK_N_LAUNCHES == 1
    a.lay_lo = 0; a.lay_hi = DEPTH; a.ph_lo = 0; a.ph_hi = PH_COUNT;
    hipLaunchKernelGGL(mk, dim3(grid), dim3(NTHR), LDS_BYTES, stream, a);
#else
    for (int layer = 0; layer < DEPTH; ++layer) for (int ph = 0; ph < PH_COUNT; ++ph) { a.lay_lo = layer; a.lay_hi = layer + 1; a.ph_lo = ph; a.ph_hi = ph + 1; hipLaunchKernelGGL(mk, dim3(grid), dim3(NTHR), LDS_BYTES, stream, a); }
#endif
}
```

```cpp
#include <hip/hip_runtime.h>
#include <cstdio>
#include <cstdint>
#ifndef PROBE_PH
#define PROBE_PH (-1)
#endif
#ifndef PROBE_MIX
#define PROBE_MIX 0
#endif
#ifndef PROBE_REP
#define PROBE_REP 2
#endif
#ifndef MK_N_LAUNCHES
#define MK_N_LAUNCHES 1
#endif

#define GAS __attribute__((address_space(1)))
#define LAS __attribute__((address_space(3)))
typedef unsigned short bf16_t;
typedef short bf16x8 __attribute__((ext_vector_type(8)));
typedef float f32x4 __attribute__((ext_vector_type(4)));
typedef float f32x2 __attribute__((ext_vector_type(2)));
typedef unsigned u32x4 __attribute__((ext_vector_type(4)));
typedef unsigned u32x2 __attribute__((ext_vector_type(2)));

namespace pg8 {
#define PG8_LAS __attribute__((address_space(3)))
typedef unsigned short bf16_t;
typedef short bf16x8 __attribute__((ext_vector_type(8)));
typedef float f32x4 __attribute__((ext_vector_type(4)));
typedef unsigned u32x4 __attribute__((ext_vector_type(4)));
constexpr int BM = 256, BK = 64, HALF = 128, HTB = HALF * BK * 2  , STAGE_BYTES = 8 * HTB, NXCD = 8, WGM = 8;

__host__ __device__ __forceinline__ int lds_byte(int r, int c) { const int st = (r >> 4) * 2 + (c >> 5), rr = r & 15, cc = c & 31, ob = rr * 64 + cc * 2; return st * 1024 + (ob ^ (((ob >> 9) & 1) << 5)); }
__host__ __device__ __forceinline__ void stage_rc(int b, int& R, int& C) { const int st = b / 1024, sb = b % 1024, swz = sb ^ (((sb >> 9) & 1) << 5); R = (st >> 1) * 16 + swz / 64; C = (st & 1) * 32 + (swz % 64) / 2; }
__host__ __device__ __forceinline__ int perm32(int rho) { const int n = rho >> 4, i = rho & 15; return 8 * (i >> 2) + 4 * n + (i & 3); }

struct Unit { int pm, pn; };
struct Gemm { const bf16_t* A; const bf16_t* Bt; int M, N, K; };

struct StaticOrder {
    int nM, nN, nwg, G, c;
    __host__ __device__ void init(int M, int N, int G_, int c_) { nM = M / BM; nN = N / BM; nwg = nM * nN; G = G_; c = c_; }
    __host__ __device__ bool next(int i, Unit& u) const {
        const long L = (long)i * G + c; if (L >= nwg) return false;
        int wgid = (int)L; { const int q = nwg / NXCD, r = nwg % NXCD, xcd = wgid % NXCD, off = wgid / NXCD; wgid = (xcd < r ? xcd * (q + 1) : r * (q + 1) + (xcd - r) * q) + off; }
        const int nig = WGM * nN, gid = wgid / nig, fm = gid * WGM, gsz = (nM - fm) < WGM ? (nM - fm) : WGM;
        u.pm = fm + ((wgid % nig) % gsz); u.pn = (wgid % nig) / gsz; return true;
    }
    __device__ __forceinline__ void a_ready(const Unit&) const {}
    __device__ __forceinline__ void done(const Unit&) const {}
};
typedef float f32x2_ __attribute__((ext_vector_type(2)));
typedef __bf16 bf16x2_ __attribute__((ext_vector_type(2)));
__device__ __forceinline__ unsigned cvt_pk_bf16(float lo, float hi) { const f32x2_ v = {lo, hi}; return __builtin_bit_cast(unsigned, __builtin_convertvector(v, bf16x2_)); }
template <class Epi, class Sched, bool ALIGN_EPI = false, bool SP2 = false>
__device__ __forceinline__ void gemm_phase(PG8_LAS unsigned char* lds, const Gemm g, const Sched& S, const Epi& E, const int wid, const int lane) {
    const int tid = wid * 64 + lane, wr = wid >> 2, wc = wid & 3, fr = lane & 15, fq = lane >> 4;
    const int K = g.K, nt = K / BK;
    unsigned voffA[2], voffB[2];
#pragma unroll
    for (int i = 0; i < 2; ++i) { int R, C; stage_rc(tid * 16 + i * 8192, R, C); const int Rb = Epi::PERM ? ((R & ~31) + perm32(R & 31)) : R;
        voffA[i] = (unsigned)(R * K + C) * 2u; voffB[i] = (unsigned)(Rb * K + C) * 2u; }
    const size_t kstep = (size_t)(BK * 2);
    const size_t hstep = (size_t)HALF * K * 2;
    const size_t tstep = 2 * hstep;
    const unsigned ldsw = (unsigned)wid * 1024u;
    const int aoff = lds_byte(wr * 64 + fr, fq * 8), boff = lds_byte(wc * 32 + fr, fq * 8);
#define PG8_SA(b, h) (((b) * 2 + (h)) * HTB)
#define PG8_SB(b, h) ((4 + (b) * 2 + (h)) * HTB)
#define PG8_STAGE(bufoff, gbase, voff) do { _Pragma("unroll") for (int _i = 0; _i < 2; ++_i) \
        __builtin_amdgcn_global_load_lds((const unsigned*)((const char*)(gbase) + (voff)[_i]), (PG8_LAS unsigned*)(lds + (bufoff) + ldsw + _i * 8192), 16, 0, 0); } while (0)
#define PG8_LDA(dst, b, h) do { _Pragma("unroll") for (int m = 0; m < 4; ++m) _Pragma("unroll") for (int k = 0; k < 2; ++k) dst[m][k] = *(const PG8_LAS bf16x8*)(lds + PG8_SA(b, h) + aoff + m * 2048 + k * 1024); } while (0)
#define PG8_LDB(dst, b, h) do { _Pragma("unroll") for (int n = 0; n < 2; ++n) _Pragma("unroll") for (int k = 0; k < 2; ++k) dst[n][k] = *(const PG8_LAS bf16x8*)(lds + PG8_SB(b, h) + boff + n * 2048 + k * 1024); } while (0)
#define PG8_MMA(ai, bj, At, Bt) do { __builtin_amdgcn_s_setprio(1); _Pragma("unroll") for (int m = 0; m < 4; ++m) _Pragma("unroll") for (int n = 0; n < 2; ++n) _Pragma("unroll") for (int k = 0; k < 2; ++k) \
        acc[ai][bj][m][n] = __builtin_amdgcn_mfma_f32_16x16x32_bf16(Bt[n][k], At[m][k], acc[ai][bj][m][n], 0, 0, 0); __builtin_amdgcn_s_setprio(0); } while (0)
#define PG8_WAIT_V(n) asm volatile("s_waitcnt vmcnt(" #n ")" ::: "memory")
#define PG8_WAIT_L(n) asm volatile("s_waitcnt lgkmcnt(" #n ")" ::: "memory")
#define PG8_BAR __builtin_amdgcn_s_barrier()
#define PG8_SCHED __builtin_amdgcn_sched_barrier(0)
    Unit cur, nxt; int ui = 0;
    if (!S.next(0, cur)) return;
    f32x4 acc[2][2][4][2];
#pragma unroll
    for (int a = 0; a < 2; ++a)
#pragma unroll
        for (int b = 0; b < 2; ++b)
#pragma unroll
            for (int m = 0; m < 4; ++m)
#pragma unroll
                for (int n = 0; n < 2; ++n) acc[a][b][m][n] = (f32x4){0.f, 0.f, 0.f, 0.f};
    bf16x8 At[4][2], B0[2][2], B1[2][2];
    const char* cA = (const char*)g.A + (size_t)cur.pm * tstep; const char* cB = (const char*)g.Bt + (size_t)cur.pn * tstep;
    S.a_ready(cur);
    if constexpr (SP2) {
        PG8_STAGE(PG8_SB(0, 0), cB, voffB); PG8_STAGE(PG8_SB(0, 1), cB + hstep, voffB); PG8_STAGE(PG8_SA(0, 0), cA, voffA); PG8_STAGE(PG8_SA(0, 1), cA + hstep, voffA);
        if (wr == 1) PG8_BAR;
        PG8_WAIT_V(2); PG8_BAR;
        PG8_STAGE(PG8_SB(1, 0), cB + kstep, voffB); PG8_STAGE(PG8_SA(1, 0), cA + kstep, voffA); PG8_STAGE(PG8_SB(1, 1), cB + hstep + kstep, voffB);
        PG8_WAIT_V(6); PG8_BAR;
    } else {
        PG8_STAGE(PG8_SB(0, 0), cB, voffB); PG8_STAGE(PG8_SA(0, 0), cA, voffA); PG8_STAGE(PG8_SB(0, 1), cB + hstep, voffB); PG8_STAGE(PG8_SA(0, 1), cA + hstep, voffA);
        if (wr == 1) PG8_BAR;
        PG8_WAIT_V(4); PG8_BAR;
        PG8_STAGE(PG8_SB(1, 0), cB + kstep, voffB); PG8_STAGE(PG8_SA(1, 0), cA + kstep, voffA); PG8_STAGE(PG8_SB(1, 1), cB + hstep + kstep, voffB);
        PG8_WAIT_V(6); PG8_BAR;
    }
    for (;;) {
        const bool has_next = S.next(ui + 1, nxt);
        const char* nA = has_next ? (const char*)g.A + (size_t)nxt.pm * tstep : cA; const char* nB = has_next ? (const char*)g.Bt + (size_t)nxt.pn * tstep : cB;
        for (int t = 0; t < nt; t += 2) {
            const bool last = (t == nt - 2);
            const char* a1 = cA + (size_t)(t + 1) * kstep;
            const char* a2 = last ? nA : cA + (size_t)(t + 2) * kstep; const char* b2 = last ? nB : cB + (size_t)(t + 2) * kstep;
            const char* a3 = a2 + kstep; const char* b3 = b2 + kstep;
            if (last && has_next) S.a_ready(nxt);
            if constexpr (SP2) {
            PG8_LDB(B0, 0, 0); PG8_LDB(B1, 0, 1); PG8_SCHED; PG8_LDA(At, 0, 0); PG8_STAGE(PG8_SA(1, 1), a1 + hstep, voffA);
            PG8_WAIT_V(8); PG8_WAIT_L(0); PG8_BAR; PG8_MMA(0, 0, At, B0); PG8_MMA(0, 1, At, B1); PG8_BAR; PG8_SCHED;
            PG8_LDA(At, 0, 1); PG8_STAGE(PG8_SB(0, 0), b2, voffB); PG8_STAGE(PG8_SB(0, 1), b2 + hstep, voffB); PG8_STAGE(PG8_SA(0, 0), a2, voffA);
            PG8_WAIT_V(8); PG8_WAIT_L(0); PG8_BAR; PG8_MMA(1, 0, At, B0); PG8_MMA(1, 1, At, B1); PG8_BAR; PG8_SCHED;
            PG8_LDB(B0, 1, 0); PG8_LDB(B1, 1, 1); PG8_SCHED; PG8_LDA(At, 1, 0); PG8_STAGE(PG8_SA(0, 1), a2 + hstep, voffA);
            PG8_WAIT_V(8); PG8_WAIT_L(0); PG8_BAR; PG8_MMA(0, 0, At, B0); PG8_MMA(0, 1, At, B1); PG8_BAR; PG8_SCHED;
            PG8_LDA(At, 1, 1); PG8_STAGE(PG8_SB(1, 0), b3, voffB); PG8_STAGE(PG8_SB(1, 1), b3 + hstep, voffB); PG8_STAGE(PG8_SA(1, 0), a3, voffA);
            PG8_WAIT_V(8); PG8_WAIT_L(0); PG8_BAR; PG8_MMA(1, 0, At, B0); PG8_MMA(1, 1, At, B1); PG8_BAR; PG8_SCHED;
            } else {
            PG8_LDB(B0, 0, 0); PG8_SCHED; PG8_LDA(At, 0, 0); PG8_STAGE(PG8_SA(1, 1), a1 + hstep, voffA);
            PG8_WAIT_L(8); PG8_BAR; PG8_WAIT_L(0); PG8_MMA(0, 0, At, B0); PG8_BAR; PG8_SCHED;
            PG8_LDB(B1, 0, 1); PG8_STAGE(PG8_SB(0, 0), b2, voffB);
            PG8_BAR; PG8_WAIT_L(0); PG8_MMA(0, 1, At, B1); PG8_BAR;
            PG8_LDA(At, 0, 1); PG8_STAGE(PG8_SA(0, 0), a2, voffA);
            PG8_BAR; PG8_WAIT_L(0); PG8_MMA(1, 0, At, B0); PG8_BAR; PG8_SCHED;
            PG8_STAGE(PG8_SB(0, 1), b2 + hstep, voffB);
            PG8_WAIT_V(6); PG8_BAR; PG8_MMA(1, 1, At, B1); PG8_BAR;
            PG8_LDB(B0, 1, 0); PG8_SCHED; PG8_LDA(At, 1, 0); PG8_STAGE(PG8_SA(0, 1), a2 + hstep, voffA);
            PG8_WAIT_L(8); PG8_BAR; PG8_WAIT_L(0); PG8_MMA(0, 0, At, B0); PG8_BAR; PG8_SCHED;
            PG8_LDB(B1, 1, 1); PG8_STAGE(PG8_SB(1, 0), b3, voffB);
            PG8_BAR; PG8_WAIT_L(0); PG8_MMA(0, 1, At, B1); PG8_BAR;
            PG8_LDA(At, 1, 1); PG8_STAGE(PG8_SA(1, 0), a3, voffA);
            PG8_BAR; PG8_WAIT_L(0); PG8_MMA(1, 0, At, B0); PG8_BAR; PG8_SCHED;
            PG8_STAGE(PG8_SB(1, 1), b3 + hstep, voffB);
            PG8_WAIT_V(6); PG8_BAR; PG8_MMA(1, 1, At, B1); PG8_BAR;
            }
        }
        if constexpr (ALIGN_EPI) { if (wr == 0) PG8_BAR; }
        if constexpr (!Epi::AFTER_DRAIN) { E(acc, cur, wr, wc, fr, fq); S.done(cur); }
        if (!has_next) break;
#pragma unroll
        for (int a = 0; a < 2; ++a)
#pragma unroll
            for (int b = 0; b < 2; ++b)
#pragma unroll
                for (int m = 0; m < 4; ++m)
#pragma unroll
                    for (int n = 0; n < 2; ++n) acc[a][b][m][n] = (f32x4){0.f, 0.f, 0.f, 0.f};
        cur = nxt; cA = nA; cB = nB; ++ui;
        if constexpr (ALIGN_EPI) { if (wr == 1) PG8_BAR; }
    }
    PG8_WAIT_V(0);
    if constexpr (!ALIGN_EPI) { if (wr == 0) PG8_BAR; }
    PG8_BAR;
    if constexpr (Epi::AFTER_DRAIN) { E.fused(acc, cur, wr, wc, fr, fq, lds, wid, lane); S.done(cur); }
#undef PG8_SA
#undef PG8_SB
#undef PG8_STAGE
#undef PG8_LDA
#undef PG8_LDB
#undef PG8_MMA
#undef PG8_WAIT_V
#undef PG8_WAIT_L
#undef PG8_BAR
#undef PG8_SCHED
}
}

constexpr int BATCH = 32, SEQ = 2048, D = 1024, T = BATCH * SEQ, DEPTH = 2, CHUNK = 64, NCH = SEQ / CHUNK;
constexpr int A_HEADS = 8, A_HD = 64, A_W = 512, A_LEFT = 8, A_BAND = 576, A_CLIP = 256, A_NREL = 320;
constexpr int B_HEADS = 4, B_HD = 128, B_W = 512;
constexpr int C_W = 512;
constexpr int D_IN = 7176;
constexpr int OFF_QA = 0, OFF_KA = 512, OFF_VA = 1024, OFF_QKVB = 1536, OFF_BETA = 3072, OFF_DEC = 3076, OFF_GATEB = 3080, OFF_POOL = 3592, OFF_GATES = 4104;
constexpr int NEXP = 32, MOE_FF = 512, MOE_BLOCK = 256;
constexpr int NPAIR = 2 * T, NBLK_MAX = NPAIR / MOE_BLOCK + NEXP, CAP = NBLK_MAX * MOE_BLOCK;
constexpr float DN_ALPHA = 1.4142135623730951f;
constexpr float LN_EPS = 1e-5f, RMS_EPS = 1e-6f;
constexpr int N1 = 3584;

constexpr size_t MiB = 1ull << 20, U = 128 * MiB;
constexpr size_t WS_CTL = 0;
constexpr size_t WS_WIN1 = 1 * MiB, WS_WV = 8 * MiB, WS_WG = 9 * MiB, WS_WBR = 15 * MiB, WS_WOUT = 18 * MiB, WS_W13 = 20 * MiB, WS_W2 = 84 * MiB;
constexpr size_t WS_XB = U;
constexpr size_t WS_P = 2 * U;
constexpr size_t WS_QA = WS_P, WS_KA = WS_P + U / 2, WS_VT = WS_P + U, WS_QKVB = WS_P + 3 * U / 2, WS_GATEB = WS_P + 3 * U, WS_POOL = WS_P + 7 * U / 2;
constexpr size_t WS_OA = WS_P + 4 * U, WS_OB = WS_P + 9 * U / 2, WS_PLD = WS_P + 5 * U;
constexpr size_t WS_SM = 116 * MiB;
constexpr size_t WS_BDL = WS_SM, WS_EID = WS_SM + 2 * MiB, WS_WTS = WS_SM + 5 * MiB / 2, WS_SLOT = WS_SM + 3 * MiB, WS_HIST = WS_SM + 7 * MiB / 2, WS_BLKE = WS_SM + 15 * MiB / 4, WS_GC = WS_SM + 4 * MiB;
constexpr size_t WS_TMU = WS_P + 11 * U / 2, WS_TMW = WS_TMU + 32 * MiB;
constexpr size_t WS_GATES = WS_P, WS_Y = WS_P + 3 * U, WS_MIX = WS_P;
constexpr size_t WS_XG = WS_P, WS_HDN = WS_P + (size_t)CAP * 2048, WS_YMOE = WS_HDN + (size_t)CAP * 1024;
constexpr size_t WS_END = 8 * U;
static_assert(WS_YMOE + (size_t)CAP * 2048 <= WS_TMU, "moe buffers");
static_assert(WS_GC + 1 * MiB <= U, "small tables");
constexpr size_t WS_WRT = WS_SM + 5 * MiB;
static_assert(WS_WRT + 2 * 48 * 1024 * 2 <= U, "router weights");
static_assert(WS_W2 + 32 * MiB <= U, "weights");

__device__ __forceinline__ unsigned f2bf(float f) { unsigned u = __builtin_bit_cast(unsigned, f); return (u + 0x7fffu + ((u >> 16) & 1u)) >> 16; }
__device__ __forceinline__ unsigned pk2(float lo, float hi) { return f2bf(lo) | (f2bf(hi) << 16); }
__device__ __forceinline__ float bf2f(unsigned short b) { return __builtin_bit_cast(float, ((unsigned)b) << 16); }
__device__ __forceinline__ float bflo(unsigned w) { return __builtin_bit_cast(float, w << 16); }
__device__ __forceinline__ float bfhi(unsigned w) { return __builtin_bit_cast(float, w & 0xffff0000u); }
__device__ __forceinline__ float wave_sum(float v) {
#pragma unroll
    for (int o = 1; o < 64; o <<= 1) v += __shfl_xor(v, o);
    return v;
}
__device__ __forceinline__ float sigmoidf_(float x) { return 1.0f / (1.0f + __expf(-x)); }
__device__ __forceinline__ float siluf_(float x) { return x / (1.0f + __expf(-x)); }
__device__ __forceinline__ float softplusf_(float x) { return x > 20.f ? x : log1pf(expf(x)); }

__device__ __forceinline__ int fresh_lane() { int l; asm volatile("v_mbcnt_lo_u32_b32 %0, -1, 0\n\tv_mbcnt_hi_u32_b32 %0, -1, %0" : "=v"(l)); return l; }
struct Args { const float* in[25]; float* out; unsigned char* ws; int lay_lo, lay_hi, ph_lo, ph_hi; };

enum Phase { PH_CONVERT = 0, PH_PROJ1 = 1, PH_PRE = 2, PH_MIX = 3, PH_GATES = 4, PH_BRANCH = 5, PH_OUT = 6, PH_LN1 = 7, PH_SLOTS = 8, PH_MOE1 = 9, PH_MOE2 = 10, PH_LN2 = 11, PH_COUNT = 12 };

constexpr int NWAVES = 8, NTHR = 512;
constexpr int LDS_BYTES = 163840;

__device__ __forceinline__ void convert_item(const float* W, int ldw, int col0, int k0, bf16_t* WT, int Kd, int rowbase, int ilv_half, LAS unsigned char* lds, int tid) {
    LAS float* scr = (LAS float*)lds;
#pragma unroll
    for (int i = 0; i < 16; ++i) { const int k = 4 * i + (tid >> 7), c4 = (tid & 127) * 4;
        *(LAS f32x4*)(scr + k * 516 + c4) = *(const f32x4*)(W + (size_t)(k0 + k) * ldw + col0 + c4); }
    __syncthreads();
    const int nlo = tid & 31, cch = (tid >> 5) & 7, nhi = tid >> 8;
#pragma unroll
    for (int j = 0; j < 8; ++j) {
        const int n = nlo + 32 * (nhi + 2 * j); const LAS float* sp = scr + (8 * cch) * 516 + n;
        u32x4 o; o.x = pg8::cvt_pk_bf16(sp[0], sp[516]); o.y = pg8::cvt_pk_bf16(sp[2 * 516], sp[3 * 516]); o.z = pg8::cvt_pk_bf16(sp[4 * 516], sp[5 * 516]); o.w = pg8::cvt_pk_bf16(sp[6 * 516], sp[7 * 516]);
        const int fr_ = (ilv_half < 0) ? n : ((n >> 7) * 256 + ilv_half * 128 + (n & 127));
        *(u32x4*)(WT + (size_t)(rowbase + fr_) * Kd + k0 + 8 * cch) = o;
    }
    __syncthreads();
}
__device__ __forceinline__ void phase_convert(const Args& a, LAS unsigned char* lds, int layer, int gw, int NGW, int wave, int lane, int tid, int gtid, int GT) {
    unsigned char* ws = a.ws;
    const float* w_in = a.in[1] + (size_t)layer * D * D_IN;
    constexpr int I_IN = 14 * 16, I_BR = 2 * 2 * 8, I_OUT = 2 * 16, I_W13 = NEXP * 2 * 16, I_W2 = NEXP * 2 * 8, I_FOLD = 32, NITEMS = I_IN + I_BR + I_OUT + I_W13 + I_W2 + I_FOLD;
    const int G_ = NGW / NWAVES;
    for (int it = blockIdx.x; it < NITEMS; it += G_) {
        int r = it;
        if (r < I_IN) {
            const int kb = r & 15, cb = r >> 4;
            int c0, r0; size_t dd;
            if (cb == 0) { c0 = OFF_QA; r0 = 0; dd = WS_WIN1; } else if (cb == 1) { c0 = OFF_KA; r0 = 512; dd = WS_WIN1; }
            else if (cb < 5) { c0 = OFF_QKVB + 512 * (cb - 2); r0 = 1024 + 512 * (cb - 2); dd = WS_WIN1; }
            else if (cb == 5) { c0 = OFF_GATEB; r0 = 2560; dd = WS_WIN1; } else if (cb == 6) { c0 = OFF_POOL; r0 = 3072; dd = WS_WIN1; }
            else if (cb == 7) { c0 = OFF_VA; r0 = 0; dd = WS_WV; } else { c0 = OFF_GATES + 512 * (cb - 8); r0 = 512 * (cb - 8); dd = WS_WG; }
            convert_item(w_in, D_IN, c0, 64 * kb, (bf16_t*)(ws + dd), 1024, r0, -1, lds, tid);
            continue;
        }
        r -= I_IN;
        if (r < I_BR) {
            const int which = r >> 4, cb = (r >> 3) & 1, kb = r & 7;
            const float* W = (which == 0 ? a.in[9] : a.in[10]) + (size_t)layer * 512 * 1024;
            convert_item(W, 1024, 512 * cb, 64 * kb, (bf16_t*)(ws + WS_WBR) + (size_t)which * 1024 * 512, 512, 512 * cb, -1, lds, tid);
            continue;
        }
        r -= I_BR;
        if (r < I_OUT) {
            const int cb = r >> 4, kb = r & 15;
            convert_item(a.in[13] + (size_t)layer * 1024 * 1024, 1024, 512 * cb, 64 * kb, (bf16_t*)(ws + WS_WOUT), 1024, 512 * cb, -1, lds, tid);
            continue;
        }
        r -= I_OUT;
        if (r < I_W13) {
            const int e = r >> 5, half = (r >> 4) & 1, kb = r & 15;
            const float* W = (half == 0 ? a.in[20] : a.in[21]) + ((size_t)layer * NEXP + e) * 1024 * 512;
            convert_item(W, 512, 0, 64 * kb, (bf16_t*)(ws + WS_W13), 1024, e * 1024, half, lds, tid);
            continue;
        }
        r -= I_W13;
        if (r < I_W2) {
            const int e = r >> 4, cb = (r >> 3) & 1, kb = r & 7;
            const float* W = a.in[22] + ((size_t)layer * NEXP + e) * 512 * 1024;
            convert_item(W, 1024, 512 * cb, 64 * kb, (bf16_t*)(ws + WS_W2), 512, e * 1024 + 512 * cb, -1, lds, tid);
            continue;
        }
        r -= I_W2;
        {
            const int g = r >> 3, d0 = (r & 7) * 128;
            const float* pw = a.in[7] + ((size_t)layer * 4 + g) * 128 * 128; const float* ps = a.in[8] + (size_t)layer * 512 + g * 128;
            const float* wc = a.in[11] + ((size_t)layer * 512 + g * 128) * 1024 + d0;
            LAS float* pws = (LAS float*)lds; LAS float* wcs = pws + 128 * 128;
            for (int i = tid; i < 128 * 128; i += NTHR) { pws[i] = pw[i] * ps[i & 127]; wcs[i] = wc[(size_t)(i >> 7) * 1024 + (i & 127)]; }
            __syncthreads();
            const int d = tid & 127, cg = __builtin_amdgcn_readfirstlane(tid >> 7);
            float acc[32];
#pragma unroll
            for (int j = 0; j < 32; ++j) acc[j] = 0.f;
            for (int c2 = 0; c2 < 128; ++c2) { const float wv = wcs[c2 * 128 + d];
#pragma unroll
                for (int j = 0; j < 32; ++j) acc[j] += pws[(cg * 32 + j) * 128 + c2] * wv; }
            bf16_t* dst = (bf16_t*)(ws + WS_WBR) + (size_t)2 * 1024 * 512 + (size_t)(d0 + d) * 512 + g * 128 + cg * 32;
#pragma unroll
            for (int j = 0; j < 4; ++j) { u32x4 o; o.x = pg8::cvt_pk_bf16(acc[8 * j], acc[8 * j + 1]); o.y = pg8::cvt_pk_bf16(acc[8 * j + 2], acc[8 * j + 3]); o.z = pg8::cvt_pk_bf16(acc[8 * j + 4], acc[8 * j + 5]); o.w = pg8::cvt_pk_bf16(acc[8 * j + 6], acc[8 * j + 7]);
                *(u32x4*)(dst + 8 * j) = o; }
            __syncthreads();
        }
    }
    {
        const float* we = a.in[18] + (size_t)layer * D * 32; const float* wgp = a.in[16] + (size_t)layer * D * 4;
        bf16_t* dst = (bf16_t*)(ws + WS_WRT);
        for (int i = gtid; i < 48 * 1024; i += GT) {
            const int n = i >> 10, k = i & 1023;
            const float w = (n < 32) ? we[(size_t)k * 32 + n] : (n < 36 ? wgp[(size_t)k * 4 + (n - 32)] : 0.f);
            const unsigned h = f2bf(w); const float lo = w - bf2f((unsigned short)h);
            dst[i] = (bf16_t)h; dst[48 * 1024 + i] = (bf16_t)f2bf(lo);
        }
    }
}

__device__ __forceinline__ void row_store_bf16(bf16_t* dst_row, const f32x4 (&v)[4], int lane) {
    unsigned long long* o8 = (unsigned long long*)dst_row + lane;
#pragma unroll
    for (int j = 0; j < 4; ++j) o8[64 * j] = (unsigned long long)pk2(v[j].x, v[j].y) | ((unsigned long long)pk2(v[j].z, v[j].w) << 32);
}
__device__ __forceinline__ void row_bd_logits(const f32x4 (&v)[4], const LAS float* wbd, float* bdl_row, int lane) {
    float acc[8];
#pragma unroll
    for (int i = 0; i < 8; ++i) acc[i] = 0.f;
#pragma unroll
    for (int j = 0; j < 4; ++j)
#pragma unroll
        for (int c = 0; c < 4; ++c) {
            const int k = 256 * j + 4 * lane + c; const float xv = v[j][c];
            const f32x4 w0 = *(const LAS f32x4*)(wbd + k * 8), w1 = *(const LAS f32x4*)(wbd + k * 8 + 4);
            acc[0] += xv * w0.x; acc[1] += xv * w0.y; acc[2] += xv * w0.z; acc[3] += xv * w0.w;
            acc[4] += xv * w1.x; acc[5] += xv * w1.y; acc[6] += xv * w1.z; acc[7] += xv * w1.w;
            if (c == 3) asm volatile("" ::: "memory");
        }
    float r = 0.f;
#pragma unroll
    for (int i = 0; i < 8; ++i) { const float s = wave_sum(acc[i]); r = (lane == i) ? s : r; }
    if (lane < 8) bdl_row[lane] = r;
}
__device__ __forceinline__ void stage_wbd(const float* w_in_layer, LAS float* wbd, int tid) {
    for (int k = tid; k < 1024; k += NTHR) {
        const f32x4 a0 = *(const f32x4*)(w_in_layer + (size_t)k * D_IN + OFF_BETA), a1 = *(const f32x4*)(w_in_layer + (size_t)k * D_IN + OFF_BETA + 4);
        *(LAS f32x4*)(wbd + k * 8) = a0; *(LAS f32x4*)(wbd + k * 8 + 4) = a1;
    }
    __syncthreads();
}

__device__ __forceinline__ void phase_xconv(const Args& a, LAS unsigned char* lds, int gw, int NGW, int lane, int tid) {
    LAS float* wbd = (LAS float*)(lds);
    stage_wbd(a.in[1], wbd, tid);
    const float* x = a.in[0]; bf16_t* XB = (bf16_t*)(a.ws + WS_XB); float* bdl = (float*)(a.ws + WS_BDL);
    for (int m = gw; m < T; m += NGW) {
        const f32x4* xr = (const f32x4*)(x + (size_t)m * D) + lane;
        f32x4 v[4];
#pragma unroll
        for (int j = 0; j < 4; ++j) v[j] = xr[64 * j];
        row_store_bf16(XB + (size_t)m * D, v, lane);
        row_bd_logits(v, wbd, bdl + (size_t)m * 8, lane);
    }
    __syncthreads();
}

__device__ __forceinline__ void phase_pool(const Args& a, int gw, int NGW, int lane) {
    const bf16_t* pool = (const bf16_t*)(a.ws + WS_POOL); bf16_t* pld = (bf16_t*)(a.ws + WS_PLD);
    const int g = lane >> 4, win = 2 << g;
    for (int blk = gw; blk < T / 32; blk += NGW) {
        const int m0 = blk * 32, tl0 = m0 & (SEQ - 1);
        float s[8];
#pragma unroll
        for (int i = 0; i < 8; ++i) s[i] = 0.f;
        for (int q = 1; q < 16; ++q) {
            if (q < win && tl0 - q >= 0) { const u32x4 w = *(const u32x4*)(pool + (size_t)(m0 - q) * 512 + 8 * lane);
                s[0] += bflo(w.x); s[1] += bfhi(w.x); s[2] += bflo(w.y); s[3] += bfhi(w.y); s[4] += bflo(w.z); s[5] += bfhi(w.z); s[6] += bflo(w.w); s[7] += bfhi(w.w); }
        }
        for (int r = 0; r < 32; ++r) {
            const int m = m0 + r, tl = tl0 + r;
            const u32x4 cur = *(const u32x4*)(pool + (size_t)m * 512 + 8 * lane);
            const int old = tl - win + 1;
            u32x4 w = {0u, 0u, 0u, 0u};
            if (old >= 0) w = *(const u32x4*)(pool + (size_t)(m - win + 1) * 512 + 8 * lane);
            s[0] += bflo(cur.x); s[1] += bfhi(cur.x); s[2] += bflo(cur.y); s[3] += bfhi(cur.y); s[4] += bflo(cur.z); s[5] += bfhi(cur.z); s[6] += bflo(cur.w); s[7] += bfhi(cur.w);
            const int n = (tl + 1 < win) ? tl + 1 : win;
            const float inv = 1.0f / (float)n;
            u32x4 o;
            o.x = pg8::cvt_pk_bf16(s[0] * inv - bflo(cur.x), s[1] * inv - bfhi(cur.x)); o.y = pg8::cvt_pk_bf16(s[2] * inv - bflo(cur.y), s[3] * inv - bfhi(cur.y));
            o.z = pg8::cvt_pk_bf16(s[4] * inv - bflo(cur.z), s[5] * inv - bfhi(cur.z)); o.w = pg8::cvt_pk_bf16(s[6] * inv - bflo(cur.w), s[7] * inv - bfhi(cur.w));
            *(u32x4*)(pld + (size_t)m * 512 + 8 * lane) = o;
            s[0] -= bflo(w.x); s[1] -= bfhi(w.x); s[2] -= bflo(w.y); s[3] -= bfhi(w.y); s[4] -= bflo(w.z); s[5] -= bfhi(w.z); s[6] -= bflo(w.w); s[7] -= bfhi(w.w);
        }
    }
}

__device__ __forceinline__ void phase_ln1(const Args& a, LAS unsigned char* lds, int layer, int gw, int NGW, int wave, int lane) {
    const float* xin = (layer == 0) ? a.in[0] : a.out;
    const bf16_t* mix = (const bf16_t*)(a.ws + WS_MIX);
    float* xo = a.out; bf16_t* XB = (bf16_t*)(a.ws + WS_XB);
    const float* lg_ = a.in[14] + (size_t)layer * D; const float* lb_ = a.in[15] + (size_t)layer * D;
    const float* bg = a.in[17] + (size_t)layer * 4; const float* be = a.in[19] + (size_t)layer * 32;
    const bf16_t* wrt = (const bf16_t*)(a.ws + WS_WRT);
    int* eid = (int*)(a.ws + WS_EID); float* wts = (float*)(a.ws + WS_WTS); int* hist = (int*)(a.ws + WS_HIST);
    LAS float* lgt = (LAS float*)(lds + wave * 4096);
    LAS int* hst = (LAS int*)(lds + wave * 4096 + 3072);
    if (lane < 32) hst[lane] = 0;
    f32x4 gv[4], bv[4];
#pragma unroll
    for (int j = 0; j < 4; ++j) { gv[j] = ((const f32x4*)lg_)[64 * j + lane]; bv[j] = ((const f32x4*)lb_)[64 * j + lane]; }
    const int fr = lane & 15, fq = lane >> 4;
    for (int grp = gw; grp < T / 16; grp += NGW) {
        f32x4 xa[4]; u32x2 ma[4];
        {
            const f32x4* xr = (const f32x4*)(xin + (size_t)(grp * 16) * D) + lane; const u32x2* mr = (const u32x2*)(mix + (size_t)(grp * 16) * D) + lane;
#pragma unroll
            for (int j = 0; j < 4; ++j) { xa[j] = xr[64 * j]; ma[j] = mr[64 * j]; }
        }
        for (int rr = 0; rr < 16; ++rr) {
            const int m = grp * 16 + rr;
            f32x4 v[4]; float s = 0.f;
#pragma unroll
            for (int j = 0; j < 4; ++j) { const f32x4 mf = {bflo(ma[j].x), bfhi(ma[j].x), bflo(ma[j].y), bfhi(ma[j].y)}; v[j] = xa[j] * DN_ALPHA + mf; s += (v[j].x + v[j].y) + (v[j].z + v[j].w); }
            if (rr + 1 < 16) {
                const f32x4* xr = (const f32x4*)(xin + (size_t)(m + 1) * D) + lane; const u32x2* mr = (const u32x2*)(mix + (size_t)(m + 1) * D) + lane;
#pragma unroll
                for (int j = 0; j < 4; ++j) { xa[j] = xr[64 * j]; ma[j] = mr[64 * j]; }
            }
            const float mean = wave_sum(s) * (1.f / D); float s2 = 0.f;
#pragma unroll
            for (int j = 0; j < 4; ++j) { v[j] = v[j] - mean; s2 += (v[j].x * v[j].x + v[j].y * v[j].y) + (v[j].z * v[j].z + v[j].w * v[j].w); }
            const float rstd = 1.f / sqrtf(wave_sum(s2) * (1.f / D) + LN_EPS);
#pragma unroll
            for (int j = 0; j < 4; ++j) v[j] = v[j] * rstd * gv[j] + bv[j];
            f32x4* orow = (f32x4*)(xo + (size_t)m * D) + lane;
#pragma unroll
            for (int j = 0; j < 4; ++j) orow[64 * j] = v[j];
            row_store_bf16(XB + (size_t)m * D, v, lane);
        }
        asm volatile("s_waitcnt vmcnt(0)" ::: "memory");
        f32x4 acc[3];
#pragma unroll
        for (int t = 0; t < 3; ++t) acc[t] = (f32x4){0.f, 0.f, 0.f, 0.f};
        const float* xrow = xo + (size_t)(grp * 16 + fr) * D + 8 * fq;
#pragma unroll 4
        for (int ks = 0; ks < 32; ++ks) {
            const f32x4 x0 = *(const f32x4*)(xrow + ks * 32), x1 = *(const f32x4*)(xrow + ks * 32 + 4);
            u32x4 hi; hi.x = pg8::cvt_pk_bf16(x0.x, x0.y); hi.y = pg8::cvt_pk_bf16(x0.z, x0.w); hi.z = pg8::cvt_pk_bf16(x1.x, x1.y); hi.w = pg8::cvt_pk_bf16(x1.z, x1.w);
            u32x4 lo; lo.x = pg8::cvt_pk_bf16(x0.x - bflo(hi.x), x0.y - bfhi(hi.x)); lo.y = pg8::cvt_pk_bf16(x0.z - bflo(hi.y), x0.w - bfhi(hi.y));
            lo.z = pg8::cvt_pk_bf16(x1.x - bflo(hi.z), x1.y - bfhi(hi.z)); lo.w = pg8::cvt_pk_bf16(x1.z - bflo(hi.w), x1.w - bfhi(hi.w));
            const bf16x8 Bh = __builtin_bit_cast(bf16x8, hi), Bl = __builtin_bit_cast(bf16x8, lo);
#pragma unroll
            for (int t = 0; t < 3; ++t) {
                const bf16x8 Ah = *(const bf16x8*)(wrt + (size_t)(t * 16 + fr) * 1024 + ks * 32 + 8 * fq), Al = *(const bf16x8*)(wrt + (size_t)(48 + t * 16 + fr) * 1024 + ks * 32 + 8 * fq);
                acc[t] = __builtin_amdgcn_mfma_f32_16x16x32_bf16(Ah, Bh, acc[t], 0, 0, 0);
                acc[t] = __builtin_amdgcn_mfma_f32_16x16x32_bf16(Ah, Bl, acc[t], 0, 0, 0);
                acc[t] = __builtin_amdgcn_mfma_f32_16x16x32_bf16(Al, Bh, acc[t], 0, 0, 0);
            }
        }
#pragma unroll
        for (int t = 0; t < 3; ++t) *(LAS f32x4*)(lgt + fr * 48 + t * 16 + 4 * fq) = acc[t];
        asm volatile("s_waitcnt lgkmcnt(0)" ::: "memory");
        if (lane < 16) {
            const int m = grp * 16 + lane; const LAS float* lr = lgt + lane * 48;
            float ag[4];
#pragma unroll
            for (int i = 0; i < 4; ++i) ag[i] = lr[32 + i] + bg[i];
            int gsel = 0; float gm = ag[0];
#pragma unroll
            for (int i = 1; i < 4; ++i) if (ag[i] > gm) { gm = ag[i]; gsel = i; }
            float gs = 0.f;
#pragma unroll
            for (int i = 0; i < 4; ++i) gs += expf(ag[i] - gm);
            const float p_top = 1.0f / gs;
            float le[8];
#pragma unroll
            for (int i = 0; i < 8; ++i) le[i] = lr[gsel * 8 + i] + be[gsel * 8 + i];
            int i0 = 0; float l0 = le[0];
#pragma unroll
            for (int i = 1; i < 8; ++i) if (le[i] > l0) { l0 = le[i]; i0 = i; }
            int i1 = -1; float l1 = -3.0e38f;
#pragma unroll
            for (int i = 0; i < 8; ++i) if (i != i0 && le[i] > l1) { l1 = le[i]; i1 = i; }
            const float ex = expf(l1 - l0); const float w0 = p_top / (1.0f + ex), w1 = p_top * ex / (1.0f + ex);
            const int e0 = gsel * 8 + i0, e1 = gsel * 8 + i1;
            eid[2 * m] = e0; eid[2 * m + 1] = e1; wts[2 * m] = w0; wts[2 * m + 1] = w1;
            __hip_atomic_fetch_add(hst + e0, 1, __ATOMIC_RELAXED, __HIP_MEMORY_SCOPE_WORKGROUP); __hip_atomic_fetch_add(hst + e1, 1, __ATOMIC_RELAXED, __HIP_MEMORY_SCOPE_WORKGROUP);
        }
        asm volatile("s_waitcnt lgkmcnt(0)" ::: "memory");
    }
    if (lane < 32) hist[gw * 32 + lane] = hst[lane];
}

__device__ __forceinline__ void phase_slots(const Args& a, LAS unsigned char* lds, int gw, int NGW, int wave, int lane, int tid) {
    LAS int* red = (LAS int*)lds;
    LAS int* tot = red + 1024;
    LAS int* bef = tot + 32;
    LAS int* pst = bef + 32;
    LAS int* base = pst + 64;
    const int* hist = (const int*)(a.ws + WS_HIST);
    const int nwv = NGW;
    const int wg0 = gw - wave;
    {
        const int e = tid & 31, part = tid >> 5;
        const int per = (nwv + 15) / 16; const int lo = part * per, hi = (lo + per < nwv) ? lo + per : nwv;
        int st = 0, sb = 0;
        for (int g = lo; g < hi; ++g) { const int v = hist[g * 32 + e]; st += v; sb += (g < wg0) ? v : 0; }
        red[part * 32 + e] = st; red[512 + part * 32 + e] = sb;
    }
    __syncthreads();
    if (tid < 32) { int st = 0, sb = 0; for (int p = 0; p < 16; ++p) { st += red[p * 32 + tid]; sb += red[512 + p * 32 + tid]; } tot[tid] = st; bef[tid] = sb; }
    __syncthreads();
    if (tid == 0) { int acc = 0; for (int e = 0; e < 32; ++e) { pst[e] = acc; acc += (tot[e] + MOE_BLOCK - 1) / MOE_BLOCK * MOE_BLOCK; } pst[32] = acc; }
    __syncthreads();
    if (tid < 32) { int acc = pst[tid] + bef[tid]; for (int w = 0; w < NWAVES; ++w) { base[w * 32 + tid] = acc; acc += hist[(wg0 + w) * 32 + tid]; } }
    __syncthreads();
    if (blockIdx.x == 0) {
        int* blk_e = (int*)(a.ws + WS_BLKE);
        const int nblk = pst[32] / MOE_BLOCK;
        if (tid == 0) blk_e[1023] = nblk;
        for (int b = tid; b < nblk; b += NTHR) { int e = 0; for (int q = 0; q < 32; ++q) if (pst[q] <= b * MOE_BLOCK) e = q; blk_e[b] = e; }
    }
    const int* eid = (const int*)(a.ws + WS_EID); int* slot = (int*)(a.ws + WS_SLOT);
    const bf16_t* XB = (const bf16_t*)(a.ws + WS_XB); bf16_t* xg = (bf16_t*)(a.ws + WS_XG);
    int cnt = (lane < 32) ? base[wave * 32 + lane] : 0;
    for (int grp = gw; grp < T / 16; grp += NGW)
    for (int rr = 0; rr < 16; ++rr) {
        const int m = grp * 16 + rr;
        const int e0 = eid[2 * m], e1 = eid[2 * m + 1];
        const int s0 = __shfl(cnt, e0); cnt += (lane == e0) ? 1 : 0;
        const int s1 = __shfl(cnt, e1); cnt += (lane == e1) ? 1 : 0;
        if (lane == 0) { slot[2 * m] = s0; slot[2 * m + 1] = s1; }
        const u32x4* src = (const u32x4*)(XB + (size_t)m * D) + lane;
        const u32x4 p0 = src[0], p1 = src[64];
        u32x4* d0 = (u32x4*)(xg + (size_t)s0 * D) + lane; u32x4* d1 = (u32x4*)(xg + (size_t)s1 * D) + lane;
        d0[0] = p0; d0[64] = p1; d1[0] = p0; d1[64] = p1;
    }
    __syncthreads();
}

__device__ __forceinline__ void phase_ln2(const Args& a, LAS unsigned char* lds, int layer, int gw, int NGW, int lane, int tid) {
    LAS float* wbd = (LAS float*)(lds);
    const bool has_next = (layer + 1 < DEPTH);
    if (has_next) stage_wbd(a.in[1] + (size_t)(layer + 1) * D * D_IN, wbd, tid);
    float* xo = a.out; bf16_t* XB = (bf16_t*)(a.ws + WS_XB); float* bdl = (float*)(a.ws + WS_BDL);
    const bf16_t* ymoe = (const bf16_t*)(a.ws + WS_YMOE);
    const int* slot = (const int*)(a.ws + WS_SLOT); const float* wts = (const float*)(a.ws + WS_WTS);
    const float* lg_ = a.in[23] + (size_t)layer * D; const float* lb_ = a.in[24] + (size_t)layer * D;
    LAS f32x4* gbl = (LAS f32x4*)(lds + 32768);
    for (int i = tid; i < 256; i += NTHR) { gbl[i] = ((const f32x4*)lg_)[i]; gbl[256 + i] = ((const f32x4*)lb_)[i]; }
    __syncthreads();
    const int nrows = (T - gw + NGW - 1) / NGW;
    for (int i0 = 0; i0 < nrows; i0 += 64) {
        const int nb = (nrows - i0 < 64) ? nrows - i0 : 64;
        int sl0 = 0, sl1 = 0; float ww0 = 0.f, ww1 = 0.f;
        if (lane < nb) { const int mm = gw + (i0 + lane) * NGW; sl0 = slot[2 * mm]; sl1 = slot[2 * mm + 1]; ww0 = wts[2 * mm]; ww1 = wts[2 * mm + 1]; }
        f32x4 xa[4]; unsigned long long ya0[4], ya1[4];
        {
            const int m = gw + i0 * NGW; const int s0 = __builtin_amdgcn_readlane(sl0, 0), s1 = __builtin_amdgcn_readlane(sl1, 0);
            const f32x4* xr = (const f32x4*)(xo + (size_t)m * D) + lane;
            const unsigned long long* y0 = (const unsigned long long*)(ymoe + (size_t)s0 * D) + lane; const unsigned long long* y1 = (const unsigned long long*)(ymoe + (size_t)s1 * D) + lane;
#pragma unroll
            for (int j = 0; j < 4; ++j) { xa[j] = xr[64 * j]; ya0[j] = y0[64 * j]; ya1[j] = y1[64 * j]; }
        }
        for (int i = 0; i < nb; ++i) {
            const int m = gw + (i0 + i) * NGW;
            const float w0 = __builtin_bit_cast(float, __builtin_amdgcn_readlane(__builtin_bit_cast(int, ww0), i)), w1 = __builtin_bit_cast(float, __builtin_amdgcn_readlane(__builtin_bit_cast(int, ww1), i));
            f32x4 xc[4]; unsigned long long yc0[4], yc1[4];
#pragma unroll
            for (int j = 0; j < 4; ++j) { xc[j] = xa[j]; yc0[j] = ya0[j]; yc1[j] = ya1[j]; }
            if (i + 1 < nb) {
                const int mn = m + NGW; const int s0 = __builtin_amdgcn_readlane(sl0, i + 1), s1 = __builtin_amdgcn_readlane(sl1, i + 1);
                const f32x4* xr = (const f32x4*)(xo + (size_t)mn * D) + lane;
                const unsigned long long* y0 = (const unsigned long long*)(ymoe + (size_t)s0 * D) + lane; const unsigned long long* y1 = (const unsigned long long*)(ymoe + (size_t)s1 * D) + lane;
#pragma unroll
                for (int j = 0; j < 4; ++j) { xa[j] = xr[64 * j]; ya0[j] = y0[64 * j]; ya1[j] = y1[64 * j]; }
            }
            f32x4 v[4]; float s = 0.f;
#pragma unroll
            for (int j = 0; j < 4; ++j) {
                const unsigned long long p = yc0[j], q = yc1[j];
                f32x4 f; f.x = w0 * bflo((unsigned)p) + w1 * bflo((unsigned)q); f.y = w0 * bfhi((unsigned)p) + w1 * bfhi((unsigned)q);
                f.z = w0 * bflo((unsigned)(p >> 32)) + w1 * bflo((unsigned)(q >> 32)); f.w = w0 * bfhi((unsigned)(p >> 32)) + w1 * bfhi((unsigned)(q >> 32));
                v[j] = xc[j] * DN_ALPHA + f; s += (v[j].x + v[j].y) + (v[j].z + v[j].w);
            }
            const float mean = wave_sum(s) * (1.f / D); float s2 = 0.f;
#pragma unroll
            for (int j = 0; j < 4; ++j) { v[j] = v[j] - mean; s2 += (v[j].x * v[j].x + v[j].y * v[j].y) + (v[j].z * v[j].z + v[j].w * v[j].w); }
            const float rstd = 1.f / sqrtf(wave_sum(s2) * (1.f / D) + LN_EPS);
#pragma unroll
            for (int j = 0; j < 4; ++j) v[j] = v[j] * rstd * gbl[64 * j + lane] + gbl[256 + 64 * j + lane];
            f32x4* orow = (f32x4*)(xo + (size_t)m * D) + lane;
#pragma unroll
            for (int j = 0; j < 4; ++j) orow[64 * j] = v[j];
            if (has_next) { row_store_bf16(XB + (size_t)m * D, v, lane); row_bd_logits(v, wbd, bdl + (size_t)m * 8, lane); }
        }
    }
    __syncthreads();
}


template <class F> struct EpiP8 { static constexpr bool PERM = true, AFTER_DRAIN = false; F f;
    __device__ __forceinline__ void operator()(const f32x4 (&acc)[2][2][4][2], const pg8::Unit& u, int wr, int wc, int fr, int fq) const {
        const int row0 = u.pm * 256 + wr * 64 + fr, col0 = u.pn * 256 + wc * 32 + 8 * fq;
#pragma unroll
        for (int ai = 0; ai < 2; ++ai)
#pragma unroll
            for (int m = 0; m < 4; ++m)
#pragma unroll
                for (int bj = 0; bj < 2; ++bj) f(row0 + ai * 128 + m * 16, col0 + bj * 128, u.pn, acc[ai][bj][m][0], acc[ai][bj][m][1]);
    } };
template <class F> struct EpiPair { static constexpr bool PERM = true, AFTER_DRAIN = false; F f;
    __device__ __forceinline__ void operator()(const f32x4 (&acc)[2][2][4][2], const pg8::Unit& u, int wr, int wc, int fr, int fq) const {
        const int row0 = u.pm * 256 + wr * 64 + fr, col0 = u.pn * 256 + wc * 32 + 8 * fq;
#pragma unroll
        for (int ai = 0; ai < 2; ++ai)
#pragma unroll
            for (int m = 0; m < 4; ++m) f(row0 + ai * 128 + m * 16, col0, acc[ai][0][m][0], acc[ai][0][m][1], acc[ai][1][m][0], acc[ai][1][m][1]);
    } };
template <class F> struct EpiP4 { static constexpr bool PERM = false, AFTER_DRAIN = false; F f;
    __device__ __forceinline__ void operator()(const f32x4 (&acc)[2][2][4][2], const pg8::Unit& u, int wr, int wc, int fr, int fq) const {
        const int row0 = u.pm * 256 + wr * 64 + fr, col0 = u.pn * 256 + wc * 32 + 4 * fq;
#pragma unroll
        for (int ai = 0; ai < 2; ++ai)
#pragma unroll
            for (int m = 0; m < 4; ++m)
#pragma unroll
                for (int bj = 0; bj < 2; ++bj)
#pragma unroll
                    for (int n = 0; n < 2; ++n) f(row0 + ai * 128 + m * 16, col0 + bj * 128 + n * 16, acc[ai][bj][m][n]);
    } };
__device__ __forceinline__ u32x4 pack8(f32x4 a, f32x4 b) { u32x4 w; w.x = pg8::cvt_pk_bf16(a.x, a.y); w.y = pg8::cvt_pk_bf16(a.z, a.w); w.z = pg8::cvt_pk_bf16(b.x, b.y); w.w = pg8::cvt_pk_bf16(b.z, b.w); return w; }
__device__ __forceinline__ float fsig(float x) { return __builtin_amdgcn_rcpf(1.0f + __expf(-x)); }
struct F_Proj1 { unsigned char* ws;
    __device__ __forceinline__ void operator()(int row, int col, int pn, f32x4 a, f32x4 b) const {
        bf16_t* p;
        if (pn < 2) p = (bf16_t*)(ws + WS_QA) + (size_t)row * 512 + col;
        else if (pn < 4) p = (bf16_t*)(ws + WS_KA) + (size_t)row * 512 + (col - 512);
        else if (pn < 10) p = (bf16_t*)(ws + WS_QKVB) + (size_t)row * 1536 + (col - 1024);
        else if (pn < 12) p = (bf16_t*)(ws + WS_GATEB) + (size_t)row * 512 + (col - 2560);
        else p = (bf16_t*)(ws + WS_POOL) + (size_t)row * 512 + (col - 3072);
        *(u32x4*)p = pack8(a, b); } };
struct F_Bf16 { bf16_t* O; int ldc, cmask;
    __device__ __forceinline__ void operator()(int row, int col, int, f32x4 a, f32x4 b) const { *(u32x4*)(O + (size_t)row * ldc + (col & cmask)) = pack8(a, b); } };
struct F_Gates { bf16_t* O; const float* gb;
    __device__ __forceinline__ void operator()(int row, int col, int, f32x4 a, f32x4 b) const { const f32x4 b0 = *(const f32x4*)(gb + col), b1 = *(const f32x4*)(gb + col + 4);
        a = a + b0; b = b + b1; a.x = fsig(a.x); a.y = fsig(a.y); a.z = fsig(a.z); a.w = fsig(a.w); b.x = fsig(b.x); b.y = fsig(b.y); b.z = fsig(b.z); b.w = fsig(b.w);
        *(u32x4*)(O + (size_t)row * 3072 + col) = pack8(a, b); } };
template <int WHICH> struct F_Branch { bf16_t* Y; const bf16_t* gates;
    __device__ __forceinline__ void operator()(int row, int col, int, f32x4 a, f32x4 b) const {
        const u32x4 g = *(const u32x4*)(gates + (size_t)row * 3072 + WHICH * 1024 + col);
        a.x *= bflo(g.x); a.y *= bfhi(g.x); a.z *= bflo(g.y); a.w *= bfhi(g.y); b.x *= bflo(g.z); b.y *= bfhi(g.z); b.z *= bflo(g.w); b.w *= bfhi(g.w);
        bf16_t* yp = Y + (size_t)row * 1024 + col;
        if (WHICH > 0) { const u32x4 o = *(const u32x4*)yp; a.x += bflo(o.x); a.y += bfhi(o.x); a.z += bflo(o.y); a.w += bfhi(o.y); b.x += bflo(o.z); b.y += bfhi(o.z); b.z += bflo(o.w); b.w += bfhi(o.w); }
        *(u32x4*)yp = pack8(a, b); } };
struct F_F32 { float* O; int ldc;
    __device__ __forceinline__ void operator()(int row, int col, f32x4 v) const { *(f32x4*)(O + (size_t)row * ldc + col) = v; } };
struct F_Hdn { bf16_t* H;
    __device__ __forceinline__ void operator()(int row, int col, f32x4 a0, f32x4 a1, f32x4 b0, f32x4 b1) const {
        const int hc = ((col >> 8) & 3) * 128 + (col & 127);
        a0.x = a0.x * fsig(a0.x) * b0.x; a0.y = a0.y * fsig(a0.y) * b0.y; a0.z = a0.z * fsig(a0.z) * b0.z; a0.w = a0.w * fsig(a0.w) * b0.w;
        a1.x = a1.x * fsig(a1.x) * b1.x; a1.y = a1.y * fsig(a1.y) * b1.y; a1.z = a1.z * fsig(a1.z) * b1.z; a1.w = a1.w * fsig(a1.w) * b1.w;
        *(u32x4*)(H + (size_t)row * 512 + hc) = pack8(a0, a1); } };
struct MoeOrder { const LAS int* tab; int nunits, G, c;
    __device__ __forceinline__ bool next(int i, pg8::Unit& u) const { const int L = i * G + c; if (L >= nunits) return false; const int blk = L >> 2; u.pm = blk; u.pn = tab[blk] * 4 + (L & 3); return true; }
    __device__ __forceinline__ void a_ready(const pg8::Unit&) const {}
    __device__ __forceinline__ void done(const pg8::Unit&) const {} };
constexpr int LDS_TAB_OFF = 131072;

__device__ __forceinline__ void phase_g_proj1(const Args& a, LAS unsigned char* lds, int G, int c, int wave, int lane) {
    const bf16_t* XB = (const bf16_t*)(a.ws + WS_XB);
    { pg8::Gemm g{XB, (const bf16_t*)(a.ws + WS_WIN1), T, N1, 1024}; pg8::StaticOrder S; S.init(T, N1, G, c); EpiP8<F_Proj1> E{F_Proj1{a.ws}};
      pg8::gemm_phase<EpiP8<F_Proj1>, pg8::StaticOrder, true, true>(lds, g, S, E, wave, lane); }
    { pg8::Gemm g{(const bf16_t*)(a.ws + WS_WV), XB, 512, T, 1024}; pg8::StaticOrder S; S.init(512, T, G, c); EpiP8<F_Bf16> E{F_Bf16{(bf16_t*)(a.ws + WS_VT), T, 0x7fffffff}};
      pg8::gemm_phase<EpiP8<F_Bf16>, pg8::StaticOrder, true, true>(lds, g, S, E, wave, lane); }
}
__device__ __forceinline__ void phase_g_gates(const Args& a, LAS unsigned char* lds, int layer, int G, int c, int wave, int lane) {
    pg8::Gemm g{(const bf16_t*)(a.ws + WS_XB), (const bf16_t*)(a.ws + WS_WG), T, 3072, 1024}; pg8::StaticOrder S; S.init(T, 3072, G, c);
    EpiP8<F_Gates> E{F_Gates{(bf16_t*)(a.ws + WS_GATES), a.in[12] + (size_t)layer * 3072}};
    pg8::gemm_phase<EpiP8<F_Gates>, pg8::StaticOrder, true, true>(lds, g, S, E, wave, lane);
}
__device__ __forceinline__ void phase_g_branch(const Args& a, LAS unsigned char* lds, int G, int c, int wave, int lane) {
    bf16_t* Y = (bf16_t*)(a.ws + WS_Y); const bf16_t* gates = (const bf16_t*)(a.ws + WS_GATES); const bf16_t* W = (const bf16_t*)(a.ws + WS_WBR);
    pg8::StaticOrder S; S.init(T, 1024, G, c);
    { pg8::Gemm g{(const bf16_t*)(a.ws + WS_OA), W, T, 1024, 512}; EpiP8<F_Branch<0>> E{F_Branch<0>{Y, gates}}; pg8::gemm_phase<EpiP8<F_Branch<0>>, pg8::StaticOrder, true, true>(lds, g, S, E, wave, lane); }
    { pg8::Gemm g{(const bf16_t*)(a.ws + WS_OB), W + (size_t)1024 * 512, T, 1024, 512}; EpiP8<F_Branch<1>> E{F_Branch<1>{Y, gates}}; pg8::gemm_phase<EpiP8<F_Branch<1>>, pg8::StaticOrder, true, true>(lds, g, S, E, wave, lane); }
    { pg8::Gemm g{(const bf16_t*)(a.ws + WS_PLD), W + (size_t)2 * 1024 * 512, T, 1024, 512}; EpiP8<F_Branch<2>> E{F_Branch<2>{Y, gates}}; pg8::gemm_phase<EpiP8<F_Branch<2>>, pg8::StaticOrder, true, true>(lds, g, S, E, wave, lane); }
}
__device__ __forceinline__ void phase_g_out(const Args& a, LAS unsigned char* lds, int G, int c, int wave, int lane) {
    pg8::Gemm g{(const bf16_t*)(a.ws + WS_Y), (const bf16_t*)(a.ws + WS_WOUT), T, 1024, 1024}; pg8::StaticOrder S; S.init(T, 1024, G, c);
    EpiP8<F_Bf16> E{F_Bf16{(bf16_t*)(a.ws + WS_MIX), 1024, 0x7fffffff}};
    pg8::gemm_phase<EpiP8<F_Bf16>, pg8::StaticOrder, true, true>(lds, g, S, E, wave, lane);
}
__device__ __forceinline__ void moe_table(const Args& a, LAS unsigned char* lds, MoeOrder& S, int G, int c, int tid) {
    const int* blk_e = (const int*)(a.ws + WS_BLKE); LAS int* tab = (LAS int*)(lds + LDS_TAB_OFF);
    const int nblk = blk_e[1023];
    for (int i = tid; i < nblk; i += NTHR) tab[i] = blk_e[i];
    __syncthreads();
    S.tab = tab; S.nunits = nblk * 4; S.G = G; S.c = c;
}
__device__ __forceinline__ void phase_moe1(const Args& a, LAS unsigned char* lds, int G, int c, int tid, int wave, int lane) {
    MoeOrder S; moe_table(a, lds, S, G, c, tid);
    pg8::Gemm g{(const bf16_t*)(a.ws + WS_XG), (const bf16_t*)(a.ws + WS_W13), CAP, NEXP * 1024, 1024};
    EpiPair<F_Hdn> E{F_Hdn{(bf16_t*)(a.ws + WS_HDN)}};
    pg8::gemm_phase<EpiPair<F_Hdn>, MoeOrder, true, true>(lds, g, S, E, wave, lane);
}
__device__ __forceinline__ void phase_moe2(const Args& a, LAS unsigned char* lds, int G, int c, int tid, int wave, int lane) {
    MoeOrder S; moe_table(a, lds, S, G, c, tid);
    pg8::Gemm g{(const bf16_t*)(a.ws + WS_HDN), (const bf16_t*)(a.ws + WS_W2), CAP, NEXP * 1024, 512};
    EpiP8<F_Bf16> E{F_Bf16{(bf16_t*)(a.ws + WS_YMOE), 1024, 1023}};
    pg8::gemm_phase<EpiP8<F_Bf16>, MoeOrder, true, true>(lds, g, S, E, wave, lane);
}


__device__ __forceinline__ void attn_stage_bias(const Args& a, LAS unsigned char* lds, int layer, int tid) {
    LAS float* rb = (LAS float*)lds;
    const float* relb = a.in[2] + (size_t)layer * A_HEADS * A_NREL;
    for (int i = tid; i < A_HEADS * 384; i += NTHR) { const int hh = i / 384, j = i % 384; rb[i] = relb[hh * A_NREL + (j < A_NREL - 1 ? j : A_NREL - 1)] * 1.4426950408889634f; }
    __syncthreads();
}
__device__ __forceinline__ void attn_item(const Args& a, const LAS float* rb, int item, int lane) {
    const bf16_t* qA = (const bf16_t*)(a.ws + WS_QA); const bf16_t* kA = (const bf16_t*)(a.ws + WS_KA); const bf16_t* vT = (const bf16_t*)(a.ws + WS_VT); bf16_t* oA = (bf16_t*)(a.ws + WS_OA);
    const int fr = lane & 15, fq = lane >> 4;
    const int hq = item & 1, ci = (item >> 1) & 31, h = (item >> 6) & 7, b = item >> 9;
    const size_t tokq = (size_t)b * SEQ + ci * 64 + hq * 32;
    bf16x8 Bq[2][2];
#pragma unroll
    for (int qt = 0; qt < 2; ++qt)
#pragma unroll
        for (int ks = 0; ks < 2; ++ks) Bq[qt][ks] = *(const bf16x8*)(qA + (tokq + qt * 16 + fr) * 512 + h * 64 + ks * 32 + 8 * fq);
    f32x4 O[4][2];
#pragma unroll
    for (int dt = 0; dt < 4; ++dt) { O[dt][0] = (f32x4){0.f, 0.f, 0.f, 0.f}; O[dt][1] = (f32x4){0.f, 0.f, 0.f, 0.f}; }
    float mrun[2] = {-1.0e30f, -1.0e30f}, lrun[2] = {0.f, 0.f};
    const LAS float* rbh = rb + h * A_NREL;
    const float SC = 0.125f * 1.4426950408889634f;
    const int kc_lo = ci >= 8 ? ci - 8 : 0;
    for (int kc = kc_lo; kc <= ci; ++kc) {
        const int t = ci - kc;
        const size_t tokk = (size_t)b * SEQ + kc * 64;
        f32x4 S[4][2];
#pragma unroll
        for (int kt = 0; kt < 4; ++kt) {
            const bf16_t* kp = kA + (tokk + kt * 16 + fr) * 512 + h * 64 + 8 * fq;
            const bf16x8 Ak0 = *(const bf16x8*)kp, Ak1 = *(const bf16x8*)(kp + 32);
#pragma unroll
            for (int qt = 0; qt < 2; ++qt) {
                f32x4 z = (f32x4){0.f, 0.f, 0.f, 0.f};
                z = __builtin_amdgcn_mfma_f32_16x16x32_bf16(Ak0, Bq[qt][0], z, 0, 0, 0);
                S[kt][qt] = __builtin_amdgcn_mfma_f32_16x16x32_bf16(Ak1, Bq[qt][1], z, 0, 0, 0);
            }
        }
        if (t >= 5) {
            const float cb = rbh[319];
#pragma unroll
            for (int kt = 0; kt < 4; ++kt)
#pragma unroll
                for (int qt = 0; qt < 2; ++qt) S[kt][qt] = S[kt][qt] * SC + cb;
        } else {
#pragma unroll
            for (int kt = 0; kt < 4; ++kt)
#pragma unroll
                for (int qt = 0; qt < 2; ++qt)
#pragma unroll
                    for (int r = 0; r < 4; ++r) {
                        int dist = (hq * 32 + qt * 16 + fr) - (kt * 16 + 4 * fq + r) + 64 * t; dist = dist > A_CLIP ? A_CLIP : dist;
                        S[kt][qt][r] = S[kt][qt][r] * SC + rbh[dist + 63];
                    }
        }
#pragma unroll
        for (int qt = 0; qt < 2; ++qt) {
            float mx = S[0][qt][0];
#pragma unroll
            for (int kt = 0; kt < 4; ++kt)
#pragma unroll
                for (int r = 0; r < 4; ++r) mx = fmaxf(mx, S[kt][qt][r]);
            mx = fmaxf(mx, __shfl_xor(mx, 16)); mx = fmaxf(mx, __shfl_xor(mx, 32));
            const float mn = fmaxf(mrun[qt], mx), al = __builtin_amdgcn_exp2f(mrun[qt] - mn); mrun[qt] = mn;
            float ps = 0.f;
#pragma unroll
            for (int kt = 0; kt < 4; ++kt)
#pragma unroll
                for (int r = 0; r < 4; ++r) { const float p = __builtin_amdgcn_exp2f(S[kt][qt][r] - mn); S[kt][qt][r] = p; ps += p; }
            lrun[qt] = lrun[qt] * al + ps;
#pragma unroll
            for (int dt = 0; dt < 4; ++dt) O[dt][qt] = O[dt][qt] * al;
        }
        bf16x8 Bp[2][2];
#pragma unroll
        for (int qt = 0; qt < 2; ++qt)
#pragma unroll
            for (int s2 = 0; s2 < 2; ++s2) { const u32x4 w = pack8(S[2 * s2][qt], S[2 * s2 + 1][qt]); Bp[qt][s2] = __builtin_bit_cast(bf16x8, w); }
#pragma unroll
        for (int dt = 0; dt < 4; ++dt)
#pragma unroll
            for (int s2 = 0; s2 < 2; ++s2) {
                const bf16_t* vp = vT + (size_t)(h * 64 + dt * 16 + fr) * T + tokk + 32 * s2 + 4 * fq;
                const u32x2 lo = *(const u32x2*)vp, hi = *(const u32x2*)(vp + 16);
                const u32x4 w = {lo.x, lo.y, hi.x, hi.y}; const bf16x8 Av = __builtin_bit_cast(bf16x8, w);
#pragma unroll
                for (int qt = 0; qt < 2; ++qt) O[dt][qt] = __builtin_amdgcn_mfma_f32_16x16x32_bf16(Av, Bp[qt][s2], O[dt][qt], 0, 0, 0);
            }
    }
#pragma unroll
    for (int qt = 0; qt < 2; ++qt) {
        float l = lrun[qt]; l += __shfl_xor(l, 16); l += __shfl_xor(l, 32);
        const float inv = 1.0f / l;
#pragma unroll
        for (int dt = 0; dt < 4; ++dt) {
            const f32x4 o = O[dt][qt] * inv; u32x2 w; w.x = pg8::cvt_pk_bf16(o.x, o.y); w.y = pg8::cvt_pk_bf16(o.z, o.w);
            *(u32x2*)(oA + (tokq + qt * 16 + fr) * 512 + h * 64 + dt * 16 + 4 * fq) = w;
        }
    }
}
constexpr int AT_KV = 16384, AT_PITCH = 144, AT_TILE = 64 * AT_PITCH, AT_BUF = 2 * AT_TILE;
static_assert(AT_KV + 2 * AT_BUF <= 65536, "attention LDS map");
__device__ __forceinline__ void attn_group(const Args& a, LAS unsigned char* lds, const LAS float* rb, int grp, int wave, int lane, int tid) {
    const bf16_t* qA = (const bf16_t*)(a.ws + WS_QA); const bf16_t* kA = (const bf16_t*)(a.ws + WS_KA); const bf16_t* vT = (const bf16_t*)(a.ws + WS_VT); bf16_t* oA = (bf16_t*)(a.ws + WS_OA);
    const int fr = lane & 15, fq = lane >> 4;
    const int cg = grp & 7, h = (grp >> 3) & 7, b = grp >> 6;
    const int ci = cg * 4 + (wave >> 1), hq = wave & 1;
    const size_t tokq = (size_t)b * SEQ + ci * 64 + hq * 32;
    bf16x8 Bq[2][2];
#pragma unroll
    for (int qt = 0; qt < 2; ++qt)
#pragma unroll
        for (int ks = 0; ks < 2; ++ks) Bq[qt][ks] = *(const bf16x8*)(qA + (tokq + qt * 16 + fr) * 512 + h * 64 + ks * 32 + 8 * fq);
    f32x4 O[4][2];
#pragma unroll
    for (int dt = 0; dt < 4; ++dt) { O[dt][0] = (f32x4){0.f, 0.f, 0.f, 0.f}; O[dt][1] = (f32x4){0.f, 0.f, 0.f, 0.f}; }
    float mrun[2] = {-1.0e30f, -1.0e30f}, lrun[2] = {0.f, 0.f};
    const LAS float* rbh = rb + h * 384;
    const float SC = 0.125f * 1.4426950408889634f;
    const int kc_first = (cg * 4 >= 8) ? cg * 4 - 8 : 0, kc_last = cg * 4 + 3;
    const int srow = tid >> 3, sch = tid & 7;
    const bf16_t* kg = kA + ((size_t)b * SEQ + srow) * 512 + h * 64 + sch * 8;
    const bf16_t* vg = vT + (size_t)(h * 64 + srow) * T + (size_t)b * SEQ + sch * 8;
    const int sdst = AT_KV + srow * AT_PITCH + sch * 16;
    for (int kc = kc_first, st = 0; kc <= kc_last; ++kc, ++st) {
        const int kbase = AT_KV, vbase = kbase + AT_TILE;
        { const u32x4 kreg = *(const u32x4*)(kg + (size_t)kc * 64 * 512), vreg = *(const u32x4*)(vg + (size_t)kc * 64);
          *(LAS u32x4*)(lds + sdst) = kreg; *(LAS u32x4*)(lds + sdst + AT_TILE) = vreg; }
        __syncthreads();
        const int t = ci - kc;
        if (t >= 0 && t <= 8) {
            f32x4 S[4][2];
#pragma unroll
            for (int kt = 0; kt < 4; ++kt) {
                const bf16x8 Ak0 = *(const LAS bf16x8*)(lds + kbase + (kt * 16 + fr) * AT_PITCH + fq * 16), Ak1 = *(const LAS bf16x8*)(lds + kbase + (kt * 16 + fr) * AT_PITCH + 64 + fq * 16);
#pragma unroll
                for (int qt = 0; qt < 2; ++qt) {
                    f32x4 z = (f32x4){0.f, 0.f, 0.f, 0.f};
                    z = __builtin_amdgcn_mfma_f32_16x16x32_bf16(Ak0, Bq[qt][0], z, 0, 0, 0);
                    S[kt][qt] = __builtin_amdgcn_mfma_f32_16x16x32_bf16(Ak1, Bq[qt][1], z, 0, 0, 0);
                }
            }
            if (t >= 5) {
                const float cb = rbh[319];
#pragma unroll
                for (int kt = 0; kt < 4; ++kt)
#pragma unroll
                    for (int qt = 0; qt < 2; ++qt) S[kt][qt] = S[kt][qt] * SC + cb;
            } else {
                int bi = hq * 32 + fr - 4 * fq + 64 * t + 12; asm volatile("" : "+v"(bi));
                const LAS float* pb = rbh + bi;
#pragma unroll
                for (int kt = 0; kt < 4; ++kt)
#pragma unroll
                    for (int qt = 0; qt < 2; ++qt) {
                        const f32x4 b4 = {pb[51 + 16 * qt - 16 * kt], pb[50 + 16 * qt - 16 * kt], pb[49 + 16 * qt - 16 * kt], pb[48 + 16 * qt - 16 * kt]};
                        S[kt][qt] = S[kt][qt] * SC + b4;
                    }
            }
#pragma unroll
            for (int qt = 0; qt < 2; ++qt) {
                const f32x4 m4 = __builtin_elementwise_max(__builtin_elementwise_max(S[0][qt], S[1][qt]), __builtin_elementwise_max(S[2][qt], S[3][qt]));
                float mx = fmaxf(fmaxf(m4.x, m4.y), fmaxf(m4.z, m4.w));
                mx = fmaxf(mx, __shfl_xor(mx, 16)); mx = fmaxf(mx, __shfl_xor(mx, 32));
                const float mn = fmaxf(mrun[qt], mx), al = __builtin_amdgcn_exp2f(mrun[qt] - mn); mrun[qt] = mn;
                f32x4 ps4 = {0.f, 0.f, 0.f, 0.f};
#pragma unroll
                for (int kt = 0; kt < 4; ++kt) { f32x4 d = S[kt][qt] - mn; d.x = __builtin_amdgcn_exp2f(d.x); d.y = __builtin_amdgcn_exp2f(d.y); d.z = __builtin_amdgcn_exp2f(d.z); d.w = __builtin_amdgcn_exp2f(d.w); S[kt][qt] = d; ps4 = ps4 + d; }
                lrun[qt] = lrun[qt] * al + ((ps4.x + ps4.y) + (ps4.z + ps4.w));
#pragma unroll
                for (int dt = 0; dt < 4; ++dt) O[dt][qt] = O[dt][qt] * al;
            }
            bf16x8 Bp[2][2];
#pragma unroll
            for (int qt = 0; qt < 2; ++qt)
#pragma unroll
                for (int s2 = 0; s2 < 2; ++s2) { const u32x4 w = pack8(S[2 * s2][qt], S[2 * s2 + 1][qt]); Bp[qt][s2] = __builtin_bit_cast(bf16x8, w); }
#pragma unroll
            for (int dt = 0; dt < 4; ++dt)
#pragma unroll
                for (int s2 = 0; s2 < 2; ++s2) {
                    const LAS unsigned char* vp = lds + vbase + (dt * 16 + fr) * AT_PITCH + (32 * s2 + 4 * fq) * 2;
                    const u32x2 lo = *(const LAS u32x2*)vp, hi = *(const LAS u32x2*)(vp + 32);
                    const u32x4 w = {lo.x, lo.y, hi.x, hi.y}; const bf16x8 Av = __builtin_bit_cast(bf16x8, w);
#pragma unroll
                    for (int qt = 0; qt < 2; ++qt) O[dt][qt] = __builtin_amdgcn_mfma_f32_16x16x32_bf16(Av, Bp[qt][s2], O[dt][qt], 0, 0, 0);
                }
        }
        __syncthreads();
    }
#pragma unroll
    for (int qt = 0; qt < 2; ++qt) {
        float l = lrun[qt]; l += __shfl_xor(l, 16); l += __shfl_xor(l, 32);
        const float inv = 1.0f / l;
#pragma unroll
        for (int dt = 0; dt < 4; ++dt) {
            const f32x4 o = O[dt][qt] * inv; u32x2 w; w.x = pg8::cvt_pk_bf16(o.x, o.y); w.y = pg8::cvt_pk_bf16(o.z, o.w);
            *(u32x2*)(oA + (tokq + qt * 16 + fr) * 512 + h * 64 + dt * 16 + 4 * fq) = w;
        }
    }
}
__device__ __forceinline__ void phase_attn(const Args& a, LAS unsigned char* lds, int layer, int wave, int lane, int tid, int G) {
    attn_stage_bias(a, lds, layer, tid);
    const LAS float* rb = (const LAS float*)lds;
    constexpr int NGRP = BATCH * A_HEADS * NCH / 4;
    const int per = (NGRP + G - 1) / G;
    for (int gi = 0; gi < per; ++gi) {
        const int grp = blockIdx.x * per + gi; if (grp >= NGRP) break;
        attn_item(a, rb, grp * 8 + wave, lane);
    }
    __syncthreads();
}


constexpr int PKR = 272, PKT = 144;
constexpr int G1_KR = 0, G1_LB = 4 * 64 * PKR, G1_CW = G1_LB + 65536, G1_GB = G1_CW + 8192, G1_BB = G1_GB + 1024, G1_GC = G1_BB + 1024, G1_END = G1_GC + 1024;
constexpr int G2_KR = 0, G2_QS = 17408, G2_KT = 34816, G2_VT = 53248, G2_VN = 71680, G2_QK = 90112, G2_ST = 99328, G2_CW = 134144, G2_SM = 140288, G2_WN = G2_SM + 2048, G2_END = G2_WN + 17408;
static_assert(G1_END <= LDS_BYTES - 16 && G2_END <= LDS_BYTES - 16, "gdn LDS maps");
#define MFMA16(a_, b_, c_) __builtin_amdgcn_mfma_f32_16x16x32_bf16((a_), (b_), (c_), 0, 0, 0)
#define LDSF(off) (*(const LAS bf16x8*)(lds + (off)))

__device__ __forceinline__ void gdn_pre_stage(const Args& a, LAS unsigned char* lds, int layer, int tid) {
    LAS float* cw = (LAS float*)(lds + G1_CW);
    const float* cwg = a.in[3] + (size_t)layer * 4 * 1536;
    for (int i = tid; i < 4 * 512; i += NTHR) cw[i] = cwg[(i >> 9) * 1536 + 512 + (i & 511)];
    __syncthreads();
}
__device__ __forceinline__ void gdn_pre_item(const Args& a, LAS unsigned char* lds, int layer, int item, int wave, int lane, int tid) {
    const int b = item >> 5, n = item & 31;
    const bf16_t* qkvB = (const bf16_t*)(a.ws + WS_QKVB); const float* bdl = (const float*)(a.ws + WS_BDL); float* gcg = (float*)(a.ws + WS_GC);
    const LAS float* cw = (const LAS float*)(lds + G1_CW); LAS float* gb = (LAS float*)(lds + G1_GB); LAS float* bb = (LAS float*)(lds + G1_BB); LAS float* gcb = (LAS float*)(lds + G1_GC);
    {
        const int tk = tid >> 3, cgp = tid & 7, hh = cgp >> 1, half = cgp & 1;
        const int tl = n * 64 + tk; const size_t r = (size_t)b * SEQ + tl;
        const int cbase = hh * 128 + half * 64;
        float kv[64];
#pragma unroll
        for (int c = 0; c < 64; ++c) kv[c] = 0.f;
#pragma unroll
        for (int i = 0; i < 4; ++i) {
            if (tl - 3 + i >= 0) {
                const u32x4* src = (const u32x4*)(qkvB + (r - 3 + i) * 1536 + 512 + cbase);
#pragma unroll
                for (int q = 0; q < 8; ++q) { const u32x4 w = src[q]; const LAS float* wp = cw + i * 512 + cbase + 8 * q;
                    const f32x4 w0 = *(const LAS f32x4*)wp, w1 = *(const LAS f32x4*)(wp + 4);
                    kv[8 * q + 0] += w0.x * bflo(w.x); kv[8 * q + 1] += w0.y * bfhi(w.x); kv[8 * q + 2] += w0.z * bflo(w.y); kv[8 * q + 3] += w0.w * bfhi(w.y);
                    kv[8 * q + 4] += w1.x * bflo(w.z); kv[8 * q + 5] += w1.y * bfhi(w.z); kv[8 * q + 6] += w1.z * bflo(w.w); kv[8 * q + 7] += w1.w * bfhi(w.w); }
            }
            asm volatile("" ::: "memory");
        }
        float ss = 0.f;
#pragma unroll
        for (int c = 0; c < 64; ++c) { kv[c] = siluf_(kv[c]); ss += kv[c] * kv[c]; }
        ss += __shfl_xor(ss, 1);
        const float rk = rsqrtf(ss + RMS_EPS);
        LAS unsigned char* dst = lds + G1_KR + hh * (64 * PKR) + tk * PKR + half * 128;
#pragma unroll
        for (int q = 0; q < 8; ++q) { f32x4 x0 = {kv[8 * q] * rk, kv[8 * q + 1] * rk, kv[8 * q + 2] * rk, kv[8 * q + 3] * rk}, x1 = {kv[8 * q + 4] * rk, kv[8 * q + 5] * rk, kv[8 * q + 6] * rk, kv[8 * q + 7] * rk};
            *(LAS u32x4*)(dst + 16 * q) = pack8(x0, x1); }
        if (half == 0) {
            const float Aexp = expf(a.in[4][layer * 4 + hh]), dtb = a.in[5][layer * 4 + hh];
            bb[hh * 64 + tk] = sigmoidf_(bdl[r * 8 + hh]);
            gb[hh * 64 + tk] = -Aexp * softplusf_(bdl[r * 8 + 4 + hh] + dtb);
        }
    }
    __syncthreads();
    {
        const int hh = wave >> 1, fr = lane & 15, fq = lane >> 4;
        float g = gb[hh * 64 + lane];
#pragma unroll
        for (int o = 1; o < 64; o <<= 1) { const float t = __shfl_up(g, o); if (lane >= o) g += t; }
        gcb[hh * 64 + lane] = g;
        if ((wave & 1) == 0) gcg[((size_t)b * SEQ + n * 64 + lane) * 4 + hh] = g;
        asm volatile("s_waitcnt lgkmcnt(0)" ::: "memory");
        const int kr = G1_KR + hh * (64 * PKR);
        LAS float* Lb = (LAS float*)(lds + G1_LB) + hh * 4096;
#pragma unroll
        for (int tt = 0; tt < 2; ++tt) {
            const int ti = 2 * (wave & 1) + tt;
            bf16x8 Af[4];
#pragma unroll
            for (int ks = 0; ks < 4; ++ks) Af[ks] = LDSF(kr + (ti * 16 + fr) * PKR + ks * 64 + fq * 16);
#pragma unroll
            for (int tj = 0; tj < 4; ++tj) {
                f32x4 acc = {0.f, 0.f, 0.f, 0.f};
                if (tj <= ti) {
#pragma unroll
                    for (int ks = 0; ks < 4; ++ks) acc = MFMA16(Af[ks], LDSF(kr + (tj * 16 + fr) * PKR + ks * 64 + fq * 16), acc);
                }
                const int j = tj * 16 + fr; const float gcj = gcb[hh * 64 + j];
#pragma unroll
                for (int rg = 0; rg < 4; ++rg) { const int i = ti * 16 + 4 * fq + rg;
                    Lb[i * 64 + j] = (i > j) ? bb[hh * 64 + i] * acc[rg] * __expf(gcb[hh * 64 + i] - gcj) : 0.f; }
            }
        }
    }
    __syncthreads();
    if (wave < 4) {
        const int hh = wave; const LAS float* Lb = (const LAS float*)(lds + G1_LB) + hh * 4096;
        float Tc[64];
        int ln = lane; asm volatile("" : "+v"(ln));
#pragma unroll
        for (int i = 0; i < 64; ++i) {
            float acc = (ln == i) ? 1.f : 0.f;
#pragma unroll
            for (int j4 = 0; j4 < (i + 3) / 4; ++j4) { const f32x4 l4 = *(const LAS f32x4*)(Lb + i * 64 + 4 * j4);
                if (4 * j4 + 0 < i) acc -= l4.x * Tc[4 * j4 + 0];
                if (4 * j4 + 1 < i) acc -= l4.y * Tc[4 * j4 + 1];
                if (4 * j4 + 2 < i) acc -= l4.z * Tc[4 * j4 + 2];
                if (4 * j4 + 3 < i) acc -= l4.w * Tc[4 * j4 + 3]; }
            Tc[i] = acc;
            if ((i & 3) == 3) asm volatile("" ::: "memory");
        }
        const float bc = bb[hh * 64 + lane], ec = bc * __expf(gcb[hh * 64 + lane]);
        bf16_t* tu = (bf16_t*)(a.ws + WS_TMU) + ((size_t)item * 4 + hh) * 4096; bf16_t* tw = (bf16_t*)(a.ws + WS_TMW) + ((size_t)item * 4 + hh) * 4096;
#pragma unroll
        for (int i = 0; i < 64; ++i) { tu[i * 64 + lane] = (bf16_t)f2bf(Tc[i] * bc); tw[i * 64 + lane] = (bf16_t)f2bf(Tc[i] * ec); }
    }
    __syncthreads();
}

__device__ __forceinline__ void st8(LAS unsigned char* p, f32x4 v) { u32x2 w; w.x = pg8::cvt_pk_bf16(v.x, v.y); w.y = pg8::cvt_pk_bf16(v.z, v.w); *(LAS u32x2*)p = w; }

__device__ __forceinline__ void gdn_scan_item(const Args& a, LAS unsigned char* lds, int layer, int item, int wave, int lane, int tid) {
    asm volatile("" : "+v"(tid), "+v"(lane));
    const int b = item >> 2, h = item & 3; int fr = lane & 15, fq = lane >> 4;
#define RELANE() asm volatile("" : "+v"(fr), "+v"(fq))
    const bf16_t* qkvB = (const bf16_t*)(a.ws + WS_QKVB); const float* bdl = (const float*)(a.ws + WS_BDL); const float* gcg = (const float*)(a.ws + WS_GC);
    const bf16_t* gateB = (const bf16_t*)(a.ws + WS_GATEB);
    bf16_t* oB = (bf16_t*)(a.ws + WS_OB);
    LAS float* cwl = (LAS float*)(lds + G2_CW);
    LAS float* gcs = (LAS float*)(lds + G2_SM); LAS float* egc = gcs + 64; LAS float* ekd = gcs + 128; LAS float* ng = gcs + 192; LAS float* red = gcs + 320;
    {
        const float* cwg = a.in[3] + (size_t)layer * 4 * 1536;
        for (int i = tid; i < 4 * 384; i += NTHR) { const int tap = i / 384, rem = i % 384, seg = rem >> 7, c = rem & 127; cwl[i] = cwg[tap * 1536 + seg * 512 + h * 128 + c]; }
        for (int i = tid; i < 128; i += NTHR) ng[i] = a.in[6][layer * 128 + i];
        for (int i = tid; i < 34816 / 16; i += NTHR) ((LAS u32x4*)(lds + G2_ST))[i] = (u32x4){0u, 0u, 0u, 0u};
    }
    f32x4 Sacc[8];
#pragma unroll
    for (int i = 0; i < 8; ++i) Sacc[i] = (f32x4){0.f, 0.f, 0.f, 0.f};
    __syncthreads();
#define G2_LBAR() asm volatile("s_waitcnt lgkmcnt(0)\n\ts_barrier" ::: "memory")
    for (int n = 0; n < NCH; ++n) {
        const size_t tok0 = (size_t)b * SEQ + n * 64;
        int zv_ = 0; asm volatile("" : "+v"(zv_));
        const float gcl = gcg[(tok0 + 63) * 4 + h + zv_];
        {
            asm volatile("" : "+v"(tid));
            const int tk = tid >> 3, cgp = tid & 7, c0 = cgp * 16;
            const int tl = n * 64 + tk; const size_t r = tok0 + tk;
            const LAS float* cwv = cwl; asm volatile("" : "+v"(cwv));
            const bf16_t* qkvb_it = qkvB + (size_t)tok0 * 1536 + h * 128;
            int rowo[4]; float vm[4];
#pragma unroll
            for (int i = 0; i < 4; ++i) { const bool ok = (tl - 3 + i >= 0); rowo[i] = (ok ? (tk - 3 + i) : tk) * 1536 + c0; vm[i] = ok ? 1.f : 0.f; }
#define rowp_(i) (qkvb_it + rowo[i])
#define G2_ACC16(d, x0, x1, wp, vm_) do { const f32x4 w0 = *(const LAS f32x4*)(wp) * (vm_), w1 = *(const LAS f32x4*)((wp) + 4) * (vm_), w2 = *(const LAS f32x4*)((wp) + 8) * (vm_), w3 = *(const LAS f32x4*)((wp) + 12) * (vm_); \
                d[0] += w0.x * bflo(x0.x); d[1] += w0.y * bfhi(x0.x); d[2] += w0.z * bflo(x0.y); d[3] += w0.w * bfhi(x0.y); d[4] += w1.x * bflo(x0.z); d[5] += w1.y * bfhi(x0.z); d[6] += w1.z * bflo(x0.w); d[7] += w1.w * bfhi(x0.w); \
                d[8] += w2.x * bflo(x1.x); d[9] += w2.y * bfhi(x1.x); d[10] += w2.z * bflo(x1.y); d[11] += w2.w * bfhi(x1.y); d[12] += w3.x * bflo(x1.z); d[13] += w3.y * bfhi(x1.z); d[14] += w3.z * bflo(x1.w); d[15] += w3.w * bfhi(x1.w); } while (0)
            u32x4 rw[4][2];
#define G2_LOAD8(segoff) do { _Pragma("unroll") for (int i = 0; i < 4; ++i) { rw[i][0] = *(const u32x4*)(rowp_(i) + (segoff)); rw[i][1] = *(const u32x4*)(rowp_(i) + (segoff) + 8); } } while (0)
            const int odd = tk & 1;
            const float gc = gcg[r * 4 + h];
            G2_LOAD8(0);
            {
                float q[16];
#pragma unroll
                for (int c = 0; c < 16; ++c) q[c] = 0.f;
#pragma unroll
                for (int i = 0; i < 4; ++i) G2_ACC16(q, rw[i][0], rw[i][1], cwv + i * 384 + c0, vm[i]);
                G2_LOAD8(512);
                float sq = 0.f;
#pragma unroll
                for (int c = 0; c < 16; ++c) { q[c] = siluf_(q[c]); sq += q[c] * q[c]; }
                sq += __shfl_xor(sq, 1); sq += __shfl_xor(sq, 2); sq += __shfl_xor(sq, 4);
                const float rq_ = rsqrtf(sq + RMS_EPS) * 0.08838834764831845f;
                f32x4 a0 = {q[0] * rq_, q[1] * rq_, q[2] * rq_, q[3] * rq_}, a1 = {q[4] * rq_, q[5] * rq_, q[6] * rq_, q[7] * rq_}, a2 = {q[8] * rq_, q[9] * rq_, q[10] * rq_, q[11] * rq_}, a3 = {q[12] * rq_, q[13] * rq_, q[14] * rq_, q[15] * rq_};
                *(LAS u32x4*)(lds + G2_QS + tk * PKR + c0 * 2) = pack8(a0, a1); *(LAS u32x4*)(lds + G2_QS + tk * PKR + c0 * 2 + 16) = pack8(a2, a3);
            }
            {
                float k[16];
#pragma unroll
                for (int c = 0; c < 16; ++c) k[c] = 0.f;
#pragma unroll
                for (int i = 0; i < 4; ++i) G2_ACC16(k, rw[i][0], rw[i][1], cwv + i * 384 + 128 + c0, vm[i]);
                G2_LOAD8(1024);
                float sk = 0.f;
#pragma unroll
                for (int c = 0; c < 16; ++c) { k[c] = siluf_(k[c]); sk += k[c] * k[c]; }
                sk += __shfl_xor(sk, 1); sk += __shfl_xor(sk, 2); sk += __shfl_xor(sk, 4);
                const float rk_ = rsqrtf(sk + RMS_EPS);
                unsigned kb[8];
#pragma unroll
                for (int c = 0; c < 8; ++c) kb[c] = pg8::cvt_pk_bf16(k[2 * c] * rk_, k[2 * c + 1] * rk_);
                *(LAS u32x4*)(lds + G2_KR + tk * PKR + c0 * 2) = (u32x4){kb[0], kb[1], kb[2], kb[3]}; *(LAS u32x4*)(lds + G2_KR + tk * PKR + c0 * 2 + 16) = (u32x4){kb[4], kb[5], kb[6], kb[7]};
#pragma unroll
                for (int c = 0; c < 8; ++c) {
                    const unsigned pk_ = (unsigned)__shfl_xor((int)kb[c], 8);
                    const unsigned wk = odd ? ((pk_ >> 16) | (kb[c] & 0xffff0000u)) : ((kb[c] & 0xffffu) | (pk_ << 16));
                    *(LAS unsigned*)(lds + G2_KT + (c0 + 2 * c + odd) * PKT + (tk & ~1) * 2) = wk;
                }
            }
            {
                float v[16];
#pragma unroll
                for (int c = 0; c < 16; ++c) v[c] = 0.f;
#pragma unroll
                for (int i = 0; i < 4; ++i) G2_ACC16(v, rw[i][0], rw[i][1], cwv + i * 384 + 256 + c0, vm[i]);
#pragma unroll
                for (int c = 0; c < 8; ++c) {
                    const unsigned vb = pg8::cvt_pk_bf16(siluf_(v[2 * c]), siluf_(v[2 * c + 1]));
                    const unsigned pv_ = (unsigned)__shfl_xor((int)vb, 8);
                    const unsigned wv = odd ? ((pv_ >> 16) | (vb & 0xffff0000u)) : ((vb & 0xffffu) | (pv_ << 16));
                    *(LAS unsigned*)(lds + G2_VT + (c0 + 2 * c + odd) * PKT + (tk & ~1) * 2) = wv;
                }
            }
#undef G2_LOAD8
#undef G2_ACC16
#undef rowp_
            if (cgp == 0) { gcs[tk] = gc; egc[tk] = __expf(gc); ekd[tk] = __expf(gcl - gc); }
        }
        const float gl = __expf(gcl);
        const bf16_t* tmu = (const bf16_t*)(a.ws + WS_TMU) + (((size_t)(b * 32 + n)) * 4 + h) * 4096; const bf16_t* tmw = (const bf16_t*)(a.ws + WS_TMW) + (((size_t)(b * 32 + n)) * 4 + h) * 4096;
        RELANE();
        bf16x8 TW[4][2];
#pragma unroll
        for (int it = 0; it < 4; ++it) { TW[it][0] = *(const bf16x8*)(tmw + (it * 16 + fr) * 64 + 8 * fq); TW[it][1] = *(const bf16x8*)(tmw + (it * 16 + fr) * 64 + 32 + 8 * fq); }
        G2_LBAR();
        RELANE();
        {
            const int tj = wave & 3;
#pragma unroll
            for (int tt = 0; tt < 2; ++tt) {
                const int ti = 2 * (wave >> 2) + tt;
                f32x4 acc = {0.f, 0.f, 0.f, 0.f};
                if (ti >= tj) {
#pragma unroll
                    for (int ks = 0; ks < 4; ++ks) acc = MFMA16(LDSF(G2_KR + (tj * 16 + fr) * PKR + ks * 64 + fq * 16), LDSF(G2_QS + (ti * 16 + fr) * PKR + ks * 64 + fq * 16), acc);
                }
                const int i = ti * 16 + fr; const float gci = gcs[i];
                f32x4 o;
#pragma unroll
                for (int rg = 0; rg < 4; ++rg) { const int j = tj * 16 + 4 * fq + rg; o[rg] = (i >= j) ? acc[rg] * __expf(gci - gcs[j]) : 0.f; }
                st8(lds + G2_QK + i * PKT + (tj * 16 + 4 * fq) * 2, o);
            }
        }
        RELANE();
        {
            const bf16x8 A0 = LDSF(G2_KT + (wave * 16 + fr) * PKT + fq * 16), A1 = LDSF(G2_KT + (wave * 16 + fr) * PKT + 64 + fq * 16);
#pragma unroll
            for (int it = 0; it < 4; ++it) {
                f32x4 acc = {0.f, 0.f, 0.f, 0.f};
                acc = MFMA16(A0, TW[it][0], acc); acc = MFMA16(A1, TW[it][1], acc);
                st8(lds + G2_WN + (it * 16 + fr) * PKR + (wave * 16 + 4 * fq) * 2, -acc);
            }
        }
        bf16x8 TU[4][2];
#pragma unroll
        for (int it = 0; it < 4; ++it) { TU[it][0] = *(const bf16x8*)(tmu + (it * 16 + fr) * 64 + 8 * fq); TU[it][1] = *(const bf16x8*)(tmu + (it * 16 + fr) * 64 + 32 + 8 * fq); }
        G2_LBAR();
        RELANE();
        f32x4 vn[4];
        {
            bf16x8 Bv[2], Bs[4];
#pragma unroll
            for (int ks = 0; ks < 2; ++ks) Bv[ks] = LDSF(G2_VT + (wave * 16 + fr) * PKT + ks * 64 + fq * 16);
#pragma unroll
            for (int ks = 0; ks < 4; ++ks) Bs[ks] = LDSF(G2_ST + (wave * 16 + fr) * PKR + ks * 64 + fq * 16);
#pragma unroll
            for (int it = 0; it < 4; ++it) {
                f32x4 acc = {0.f, 0.f, 0.f, 0.f};
#pragma unroll
                for (int ks = 0; ks < 2; ++ks) acc = MFMA16(TU[it][ks], Bv[ks], acc);
#pragma unroll
                for (int ks = 0; ks < 4; ++ks) acc = MFMA16(LDSF(G2_WN + (it * 16 + fr) * PKR + ks * 64 + fq * 16), Bs[ks], acc);
                vn[it] = acc;
            }
        }
        G2_LBAR();
        RELANE();
#pragma unroll
        for (int it = 0; it < 4; ++it) {
            st8(lds + G2_VN + (wave * 16 + fr) * PKT + (it * 16 + 4 * fq) * 2, vn[it]);
            const f32x4 e4 = *(const LAS f32x4*)(ekd + it * 16 + 4 * fq);
            st8(lds + G2_VT + (wave * 16 + fr) * PKT + (it * 16 + 4 * fq) * 2, vn[it] * e4);
        }
        G2_LBAR();
        RELANE();
        {
            const int it = wave & 3, dq = 4 * (wave >> 2);
            const size_t tok = tok0 + it * 16 + fr;
            u32x2 gt[4];
#pragma unroll
            for (int x = 0; x < 4; ++x) gt[x] = *(const u32x2*)(gateB + tok * 512 + h * 128 + (dq + x) * 16 + 4 * fq);
            bf16x8 Bq[4], Bk[2];
#pragma unroll
            for (int ks = 0; ks < 4; ++ks) Bq[ks] = LDSF(G2_QS + (it * 16 + fr) * PKR + ks * 64 + fq * 16);
#pragma unroll
            for (int ks = 0; ks < 2; ++ks) Bk[ks] = LDSF(G2_QK + (it * 16 + fr) * PKT + ks * 64 + fq * 16);
            const float eg = egc[it * 16 + fr];
            f32x4 O[4]; float ss = 0.f;
#pragma unroll
            for (int x = 0; x < 4; ++x) {
                f32x4 acc = {0.f, 0.f, 0.f, 0.f};
#pragma unroll
                for (int ks = 0; ks < 4; ++ks) acc = MFMA16(LDSF(G2_ST + ((dq + x) * 16 + fr) * PKR + ks * 64 + fq * 16), Bq[ks], acc);
                acc = acc * eg;
#pragma unroll
                for (int ks = 0; ks < 2; ++ks) acc = MFMA16(LDSF(G2_VN + ((dq + x) * 16 + fr) * PKT + ks * 64 + fq * 16), Bk[ks], acc);
                O[x] = acc; ss += (acc.x * acc.x + acc.y * acc.y) + (acc.z * acc.z + acc.w * acc.w);
            }
            ss += __shfl_xor(ss, 16); ss += __shfl_xor(ss, 32);
            if (fq == 0) red[(wave >> 2) * 64 + it * 16 + fr] = ss;
            RELANE();
            {
                const bf16x8 A0 = LDSF(G2_KT + (wave * 16 + fr) * PKT + fq * 16), A1 = LDSF(G2_KT + (wave * 16 + fr) * PKT + 64 + fq * 16);
#pragma unroll
                for (int dv = 0; dv < 8; ++dv) {
                    f32x4 acc = Sacc[dv] * gl;
                    acc = MFMA16(A0, LDSF(G2_VT + (dv * 16 + fr) * PKT + fq * 16), acc);
                    acc = MFMA16(A1, LDSF(G2_VT + (dv * 16 + fr) * PKT + 64 + fq * 16), acc);
                    Sacc[dv] = acc;
                }
            }
            G2_LBAR();
            RELANE();
            const float tot = red[it * 16 + fr] + red[64 + it * 16 + fr];
            const float rstd = rsqrtf(tot * (1.0f / 128.0f) + RMS_EPS);
#pragma unroll
            for (int x = 0; x < 4; ++x) {
                const f32x4 g4 = *(const LAS f32x4*)(ng + (dq + x) * 16 + 4 * fq);
                const float t0 = bflo(gt[x].x), t1 = bfhi(gt[x].x), t2 = bflo(gt[x].y), t3 = bfhi(gt[x].y);
                f32x4 o = O[x] * rstd * g4; o.x *= t0 * fsig(t0); o.y *= t1 * fsig(t1); o.z *= t2 * fsig(t2); o.w *= t3 * fsig(t3);
                u32x2 w; w.x = pg8::cvt_pk_bf16(o.x, o.y); w.y = pg8::cvt_pk_bf16(o.z, o.w);
                *(u32x2*)(oB + tok * 512 + h * 128 + (dq + x) * 16 + 4 * fq) = w;
            }
#pragma unroll
            for (int dv = 0; dv < 8; ++dv) st8(lds + G2_ST + (dv * 16 + fr) * PKR + (wave * 16 + 4 * fq) * 2, Sacc[dv]);
        }
        G2_LBAR();
    }
}
#undef G2_LBAR
#undef RELANE

constexpr int CW_ATTQ = 65536;
__device__ __forceinline__ void phase_pre(const Args& a, LAS unsigned char* lds, int layer, int gw, int NGW, int wave, int lane, int tid, int G) {
    gdn_pre_stage(a, lds, layer, tid);
    for (int item = blockIdx.x; item < BATCH * NCH; item += G) gdn_pre_item(a, lds, layer, item, wave, lane, tid);
    phase_pool(a, gw, NGW, lane);
}
__device__ __forceinline__ void phase_mix(const Args& a, LAS unsigned char* lds, int layer, int qsel, int wave, int lane, int tid, int G) {
    for (int rep_ = 0; rep_ < ((PROBE_MIX == 1 && layer == 0) ? 1 + PROBE_REP : 1); ++rep_)
    for (int item = blockIdx.x; item < BATCH * B_HEADS; item += G) gdn_scan_item(a, lds, layer, item, wave, lane, tid);
    __syncthreads();
    lane = fresh_lane(); tid = wave * 64 + lane;
    attn_stage_bias(a, lds, layer, tid);
    const LAS float* rb = (const LAS float*)lds;
    LAS int* qslot = (LAS int*)(lds + 15360);
    unsigned* qctr = (unsigned*)(a.ws + WS_CTL) + CW_ATTQ + qsel * 64;
    constexpr int NGRP = BATCH * A_HEADS * NCH / 4;
    for (int rep_ = 0; rep_ < ((PROBE_MIX == 2 && layer == 0) ? 1 + PROBE_REP : 1); ++rep_, qctr += 64)
    for (;;) {
        if (tid == 0) *qslot = (int)__hip_atomic_fetch_add(qctr, 1u, __ATOMIC_RELAXED, __HIP_MEMORY_SCOPE_AGENT);
        __syncthreads();
        const int grp = *qslot;
        __syncthreads();
        if (grp >= NGRP) break;
        attn_group(a, lds, rb, grp, wave, lane, tid);
    }
}

#define XB_TMO      128
#define XB_XCNT(j)  (256  + 64 * (j))
#define XB_XSUB(j)  (1280 + 64 * (j))
#define XB_XGEN(j)  (2304 + 64 * (j))
#define XB_TOP      3328
#define XB_TOPGEN   3392
#define XCD_BAR_WORDS 3456
#define XB_SPIN_CAP (1u << 18)

__device__ __forceinline__ unsigned xb_ld(unsigned* p)              { return __hip_atomic_load(p, __ATOMIC_RELAXED, __HIP_MEMORY_SCOPE_AGENT); }
__device__ __forceinline__ unsigned xb_add(unsigned* p, unsigned v) { return __hip_atomic_fetch_add(p, v, __ATOMIC_RELAXED, __HIP_MEMORY_SCOPE_AGENT); }
__device__ __forceinline__ unsigned xb_xcc_id() { return (unsigned)__builtin_amdgcn_s_getreg((3 << 11) | 20) & 0xFu; }
#define XB_SPIN(cond, bar) do { unsigned _sp = 0; while (cond) { __builtin_amdgcn_s_sleep(1); \
    if ((++_sp & 255u) == 0u) { if (xb_ld(&(bar)[XB_TMO])) break; if (_sp > XB_SPIN_CAP) { atomicAdd(&(bar)[XB_TMO], 1u); break; } } } } while (0)

struct XcdBarrier {
    unsigned* bar; unsigned x;
    volatile LAS unsigned* st;
};

__device__ __forceinline__ XcdBarrier xcd_barrier_post(unsigned* bar, volatile LAS unsigned* st) {
    XcdBarrier b; b.bar = bar; b.x = xb_xcc_id(); b.st = st;
    if (threadIdx.x == 0) (void)xb_add(&bar[XB_XCNT(b.x)], 1u);
    return b;
}
__device__ __forceinline__ void xcd_barrier_complete(unsigned* bar, unsigned x, unsigned& nloc, unsigned& nx) {
    const unsigned G = gridDim.x * gridDim.y * gridDim.z;
    unsigned sum, cnt, mine, sp = 0u;
    for (;;) {
        sum = 0u; cnt = 0u; mine = 0u;
#pragma unroll
        for (unsigned j = 0; j < 16; ++j) { const unsigned c = xb_ld(&bar[XB_XCNT(j)]); sum += c; cnt += (c > 0u) ? 1u : 0u; mine = (j == x) ? c : mine; }
        if (sum == G) break;
        __builtin_amdgcn_s_sleep(1);
        if ((++sp & 255u) == 0u) { if (xb_ld(&bar[XB_TMO])) break; if (sp > XB_SPIN_CAP) { atomicAdd(&bar[XB_TMO], 1u); break; } }
    }
    nloc = mine > 0u ? mine : 1u; nx = cnt > 0u ? cnt : 1u;
}

__device__ __forceinline__ void xcd_barrier(const XcdBarrier& b) {
    asm volatile("s_waitcnt vmcnt(0)" ::: "memory");
    __syncthreads();
    if (threadIdx.x == 0) {
        unsigned* bar = b.bar;
        __builtin_amdgcn_s_waitcnt(0);
        unsigned nloc = b.st[0], nx = b.st[1];
        if (nloc == 0u) { xcd_barrier_complete(bar, b.x, nloc, nx); b.st[0] = nloc; b.st[1] = nx; }
        const unsigned old = xb_add(&bar[XB_XSUB(b.x)], 1u);
        const unsigned gen = old / nloc;
        if (old + 1u == (gen + 1u) * nloc) {
            __builtin_amdgcn_fence(__ATOMIC_RELEASE, "agent");
            asm volatile("s_waitcnt vmcnt(0)" ::: "memory");
            const unsigned og = xb_add(&bar[XB_TOP], 1u);
            const unsigned tg = og / nx;
            if (og + 1u == (tg + 1u) * nx) xb_add(&bar[XB_TOPGEN], 1u);
            else XB_SPIN(xb_ld(&bar[XB_TOPGEN]) == tg, bar);
            __builtin_amdgcn_fence(__ATOMIC_ACQUIRE, "agent");
            xb_add(&bar[XB_XGEN(b.x)], 1u);
            asm volatile("s_waitcnt vmcnt(0)" ::: "memory");
        } else {
            XB_SPIN(xb_ld(&bar[XB_XGEN(b.x)]) == gen, bar);
            __builtin_amdgcn_fence(__ATOMIC_ACQUIRE, "agent");
            asm volatile("s_waitcnt vmcnt(0)" ::: "memory");
        }
    }
    __syncthreads();
}


constexpr int CW_BAR = 4096;
constexpr int LDS_BARW = LDS_BYTES - 16;
#define IN(k) (a.ph_lo <= (k) && (k) < a.ph_hi)
#define SEAM(k) do { if (fused && !((k) == PH_COUNT - 1 && layer == a.lay_hi - 1) && !((k) == a.ph_hi - 1 && a.ph_hi < PH_COUNT)) xcd_barrier(bar); } while (0)
template <int layer> __device__ __forceinline__ void layer_prog(const Args& a, LAS unsigned char* lds, const XcdBarrier& bar, bool fused, int gw, int NGW, int wave, int GT, int G) {
#define RUN(k, ...) if (IN(k)) { constexpr int nrep_ = (layer == 0 && (k) == PROBE_PH) ? 1 + PROBE_REP : 1; _Pragma("unroll") for (int rep = 0; rep < nrep_; ++rep) { \
        const int lane = fresh_lane(), tid = wave * 64 + lane, gtid = (int)blockIdx.x * NTHR + tid; (void)gtid; __VA_ARGS__; if (rep + 1 < nrep_) xcd_barrier(bar); } SEAM(k); }
    RUN(PH_CONVERT, phase_convert(a, lds, layer, gw, NGW, wave, lane, tid, gtid, GT); if (layer == 0) { __syncthreads(); phase_xconv(a, lds, gw, NGW, lane, tid); })
    RUN(PH_PROJ1, phase_g_proj1(a, lds, G, (int)blockIdx.x, wave, lane))
    RUN(PH_PRE, phase_pre(a, lds, layer, gw, NGW, wave, lane, tid, G))
    RUN(PH_MIX, phase_mix(a, lds, layer, layer * 4 + rep, wave, lane, tid, G))
    RUN(PH_GATES, phase_g_gates(a, lds, layer, G, (int)blockIdx.x, wave, lane))
    RUN(PH_BRANCH, phase_g_branch(a, lds, G, (int)blockIdx.x, wave, lane))
    RUN(PH_OUT, phase_g_out(a, lds, G, (int)blockIdx.x, wave, lane))
    RUN(PH_LN1, phase_ln1(a, lds, layer, gw, NGW, wave, lane))
    RUN(PH_SLOTS, phase_slots(a, lds, gw, NGW, wave, lane, tid))
    RUN(PH_MOE1, phase_moe1(a, lds, G, (int)blockIdx.x, tid, wave, lane))
    RUN(PH_MOE2, phase_moe2(a, lds, G, (int)blockIdx.x, tid, wave, lane))
    RUN(PH_LN2, phase_ln2(a, lds, layer, gw, NGW, lane, tid))
#undef RUN
}
#undef IN
#undef SEAM
__global__ void __launch_bounds__(NTHR, 2) mk(Args a) {
    extern __shared__ __attribute__((aligned(16))) unsigned char lds_raw[];
    LAS unsigned char* lds = (LAS unsigned char*)lds_raw;
    const int tid = threadIdx.x, lane = tid & 63, wave = __builtin_amdgcn_readfirstlane(tid >> 6);
    const int G = gridDim.x, gw = blockIdx.x * NWAVES + wave, NGW = G * NWAVES, gtid = blockIdx.x * NTHR + tid, GT = G * NTHR;
    const bool fused = (a.ph_hi - a.ph_lo > 1) || (a.lay_hi - a.lay_lo > 1);
    if (tid == 0) *(LAS u32x4*)(lds + LDS_BARW) = (u32x4){0u, 0u, 0u, 0u};
    __syncthreads();
    XcdBarrier bar; bar.bar = (unsigned*)(a.ws + WS_CTL) + CW_BAR; bar.x = 0; bar.st = (volatile LAS unsigned*)(lds + LDS_BARW);
    if (fused) bar = xcd_barrier_post((unsigned*)(a.ws + WS_CTL) + CW_BAR, (volatile LAS unsigned*)(lds + LDS_BARW));
    if (a.lay_lo <= 0 && 0 < a.lay_hi) layer_prog<0>(a, lds, bar, fused, gw, NGW, wave, GT, G);
    if (a.lay_lo <= 1 && 1 < a.lay_hi) layer_prog<1>(a, lds, bar, fused, gw, NGW, wave, GT, G);
}

extern "C" void kernel_launch(void* const* d_in, const int* in_sizes, int n_in, void* d_out, int out_size, void* d_ws, size_t ws_size, hipStream_t stream) {
    static int grid = 0;
    if (grid == 0) {
        if (n_in != 25 || in_sizes[0] != T * D || out_size != T * D || ws_size < WS_END) { fprintf(stderr, "kernel_launch: unexpected shapes (n_in %d, in0 %d, out %d, ws %zu < %zu)\n", n_in, n_in > 0 ? in_sizes[0] : -1, out_size, ws_size, (size_t)WS_END); grid = -1; return; }
        int dev = 0, cus = 0;
        if (hipGetDevice(&dev) != hipSuccess || hipDeviceGetAttribute(&cus, hipDeviceAttributeMultiprocessorCount, dev) != hipSuccess) { grid = -1; return; }
        if (hipFuncSetAttribute((const void*)mk, hipFuncAttributeMaxDynamicSharedMemorySize, LDS_BYTES) != hipSuccess) { fprintf(stderr, "kernel_launch: hipFuncSetAttribute failed\n"); grid = -1; return; }
        grid = cus;
    }
    if (grid < 0) return;
    unsigned char* ws = (unsigned char*)d_ws;
    (void)hipMemsetAsync(ws + WS_CTL, 0, 1 * MiB, stream);
    Args a{};
    for (int i = 0; i < 25; ++i) a.in[i] = (const float*)d_in[i];
    a.out = (float*)d_out; a.ws = ws;
#if MK_N_LAUNCHES == 1
    a.lay_lo = 0; a.lay_hi = DEPTH; a.ph_lo = 0; a.ph_hi = PH_COUNT;
    hipLaunchKernelGGL(mk, dim3(grid), dim3(NTHR), LDS_BYTES, stream, a);
#else
    for (int layer = 0; layer < DEPTH; ++layer) for (int ph = 0; ph < PH_COUNT; ++ph) { a.lay_lo = layer; a.lay_hi = layer + 1; a.ph_lo = ph; a.ph_hi = ph + 1; hipLaunchKernelGGL(mk, dim3(grid), dim3(NTHR), LDS_BYTES, stream, a); }
#endif
}
```

```cpp
#include <hip/hip_runtime.h>
#include <cstdio>
#include <cstdint>
#ifndef PROBE_PH
#define PROBE_PH (-1)
#endif
#ifndef PROBE_MIX
#define PROBE_MIX 0
#endif
#ifndef PROBE_REP
#define PROBE_REP 2
#endif
#ifndef MK_N_LAUNCHES
#define MK_N_LAUNCHES 1
#endif

#define GAS __attribute__((address_space(1)))
#define LAS __attribute__((address_space(3)))
typedef unsigned short bf16_t;
typedef short bf16x8 __attribute__((ext_vector_type(8)));
typedef float f32x4 __attribute__((ext_vector_type(4)));
typedef float f32x2 __attribute__((ext_vector_type(2)));
typedef unsigned u32x4 __attribute__((ext_vector_type(4)));
typedef unsigned u32x2 __attribute__((ext_vector_type(2)));

namespace pg8 {
#define PG8_LAS __attribute__((address_space(3)))
typedef unsigned short bf16_t;
typedef short bf16x8 __attribute__((ext_vector_type(8)));
typedef float f32x4 __attribute__((ext_vector_type(4)));
typedef unsigned u32x4 __attribute__((ext_vector_type(4)));
constexpr int BM = 256, BK = 64, HALF = 128, HTB = HALF * BK * 2  , STAGE_BYTES = 8 * HTB, NXCD = 8, WGM = 8;

__host__ __device__ __forceinline__ int lds_byte(int r, int c) { const int st = (r >> 4) * 2 + (c >> 5), rr = r & 15, cc = c & 31, ob = rr * 64 + cc * 2; return st * 1024 + (ob ^ (((ob >> 9) & 1) << 5)); }
__host__ __device__ __forceinline__ void stage_rc(int b, int& R, int& C) { const int st = b / 1024, sb = b % 1024, swz = sb ^ (((sb >> 9) & 1) << 5); R = (st >> 1) * 16 + swz / 64; C = (st & 1) * 32 + (swz % 64) / 2; }
__host__ __device__ __forceinline__ int perm32(int rho) { const int n = rho >> 4, i = rho & 15; return 8 * (i >> 2) + 4 * n + (i & 3); }

struct Unit { int pm, pn; };
struct Gemm { const bf16_t* A; const bf16_t* Bt; int M, N, K; };

struct StaticOrder {
    int nM, nN, nwg, G, c;
    __host__ __device__ void init(int M, int N, int G_, int c_) { nM = M / BM; nN = N / BM; nwg = nM * nN; G = G_; c = c_; }
    __host__ __device__ bool next(int i, Unit& u) const {
        const long L = (long)i * G + c; if (L >= nwg) return false;
        int wgid = (int)L; { const int q = nwg / NXCD, r = nwg % NXCD, xcd = wgid % NXCD, off = wgid / NXCD; wgid = (xcd < r ? xcd * (q + 1) : r * (q + 1) + (xcd - r) * q) + off; }
        const int nig = WGM * nN, gid = wgid / nig, fm = gid * WGM, gsz = (nM - fm) < WGM ? (nM - fm) : WGM;
        u.pm = fm + ((wgid % nig) % gsz); u.pn = (wgid % nig) / gsz; return true;
    }
    __device__ __forceinline__ void a_ready(const Unit&) const {}
    __device__ __forceinline__ void done(const Unit&) const {}
};
typedef float f32x2_ __attribute__((ext_vector_type(2)));
typedef __bf16 bf16x2_ __attribute__((ext_vector_type(2)));
__device__ __forceinline__ unsigned cvt_pk_bf16(float lo, float hi) { const f32x2_ v = {lo, hi}; return __builtin_bit_cast(unsigned, __builtin_convertvector(v, bf16x2_)); }
template <class Epi, class Sched, bool ALIGN_EPI = false, bool SP2 = false>
__device__ __forceinline__ void gemm_phase(PG8_LAS unsigned char* lds, const Gemm g, const Sched& S, const Epi& E, const int wid, const int lane) {
    const int tid = wid * 64 + lane, wr = wid >> 2, wc = wid & 3, fr = lane & 15, fq = lane >> 4;
    const int K = g.K, nt = K / BK;
    unsigned voffA[2], voffB[2];
#pragma unroll
    for (int i = 0; i < 2; ++i) { int R, C; stage_rc(tid * 16 + i * 8192, R, C); const int Rb = Epi::PERM ? ((R & ~31) + perm32(R & 31)) : R;
        voffA[i] = (unsigned)(R * K + C) * 2u; voffB[i] = (unsigned)(Rb * K + C) * 2u; }
    const size_t kstep = (size_t)(BK * 2);
    const size_t hstep = (size_t)HALF * K * 2;
    const size_t tstep = 2 * hstep;
    const unsigned ldsw = (unsigned)wid * 1024u;
    const int aoff = lds_byte(wr * 64 + fr, fq * 8), boff = lds_byte(wc * 32 + fr, fq * 8);
#define PG8_SA(b, h) (((b) * 2 + (h)) * HTB)
#define PG8_SB(b, h) ((4 + (b) * 2 + (h)) * HTB)
#define PG8_STAGE(bufoff, gbase, voff) do { _Pragma("unroll") for (int _i = 0; _i < 2; ++_i) \
        __builtin_amdgcn_global_load_lds((const unsigned*)((const char*)(gbase) + (voff)[_i]), (PG8_LAS unsigned*)(lds + (bufoff) + ldsw + _i * 8192), 16, 0, 0); } while (0)
#define PG8_LDA(dst, b, h) do { _Pragma("unroll") for (int m = 0; m < 4; ++m) _Pragma("unroll") for (int k = 0; k < 2; ++k) dst[m][k] = *(const PG8_LAS bf16x8*)(lds + PG8_SA(b, h) + aoff + m * 2048 + k * 1024); } while (0)
#define PG8_LDB(dst, b, h) do { _Pragma("unroll") for (int n = 0; n < 2; ++n) _Pragma("unroll") for (int k = 0; k < 2; ++k) dst[n][k] = *(const PG8_LAS bf16x8*)(lds + PG8_SB(b, h) + boff + n * 2048 + k * 1024); } while (0)
#define PG8_MMA(ai, bj, At, Bt) do { __builtin_amdgcn_s_setprio(1); _Pragma("unroll") for (int m = 0; m < 4; ++m) _Pragma("unroll") for (int n = 0; n < 2; ++n) _Pragma("unroll") for (int k = 0; k < 2; ++k) \
        acc[ai][bj][m][n] = __builtin_amdgcn_mfma_f32_16x16x32_bf16(Bt[n][k], At[m][k], acc[ai][bj][m][n], 0, 0, 0); __builtin_amdgcn_s_setprio(0); } while (0)
#define PG8_WAIT_V(n) asm volatile("s_waitcnt vmcnt(" #n ")" ::: "memory")
#define PG8_WAIT_L(n) asm volatile("s_waitcnt lgkmcnt(" #n ")" ::: "memory")
#define PG8_BAR __builtin_amdgcn_s_barrier()
#define PG8_SCHED __builtin_amdgcn_sched_barrier(0)
    Unit cur, nxt; int ui = 0;
    if (!S.next(0, cur)) return;
    f32x4 acc[2][2][4][2];
#pragma unroll
    for (int a = 0; a < 2; ++a)
#pragma unroll
        for (int b = 0; b < 2; ++b)
#pragma unroll
            for (int m = 0; m < 4; ++m)
#pragma unroll
                for (int n = 0; n < 2; ++n) acc[a][b][m][n] = (f32x4){0.f, 0.f, 0.f, 0.f};
    bf16x8 At[4][2], B0[2][2], B1[2][2];
    const char* cA = (const char*)g.A + (size_t)cur.pm * tstep; const char* cB = (const char*)g.Bt + (size_t)cur.pn * tstep;
    S.a_ready(cur);
    if constexpr (SP2) {
        PG8_STAGE(PG8_SB(0, 0), cB, voffB); PG8_STAGE(PG8_SB(0, 1), cB + hstep, voffB); PG8_STAGE(PG8_SA(0, 0), cA, voffA); PG8_STAGE(PG8_SA(0, 1), cA + hstep, voffA);
        if (wr == 1) PG8_BAR;
        PG8_WAIT_V(2); PG8_BAR;
        PG8_STAGE(PG8_SB(1, 0), cB + kstep, voffB); PG8_STAGE(PG8_SA(1, 0), cA + kstep, voffA); PG8_STAGE(PG8_SB(1, 1), cB + hstep + kstep, voffB);
        PG8_WAIT_V(6); PG8_BAR;
    } else {
        PG8_STAGE(PG8_SB(0, 0), cB, voffB); PG8_STAGE(PG8_SA(0, 0), cA, voffA); PG8_STAGE(PG8_SB(0, 1), cB + hstep, voffB); PG8_STAGE(PG8_SA(0, 1), cA + hstep, voffA);
        if (wr == 1) PG8_BAR;
        PG8_WAIT_V(4); PG8_BAR;
        PG8_STAGE(PG8_SB(1, 0), cB + kstep, voffB); PG8_STAGE(PG8_SA(1, 0), cA + kstep, voffA); PG8_STAGE(PG8_SB(1, 1), cB + hstep + kstep, voffB);
        PG8_WAIT_V(6); PG8_BAR;
    }
    for (;;) {
        const bool has_next = S.next(ui + 1, nxt);
        const char* nA = has_next ? (const char*)g.A + (size_t)nxt.pm * tstep : cA; const char* nB = has_next ? (const char*)g.Bt + (size_t)nxt.pn * tstep : cB;
        for (int t = 0; t < nt; t += 2) {
            const bool last = (t == nt - 2);
            const char* a1 = cA + (size_t)(t + 1) * kstep;
            const char* a2 = last ? nA : cA + (size_t)(t + 2) * kstep; const char* b2 = last ? nB : cB + (size_t)(t + 2) * kstep;
            const char* a3 = a2 + kstep; const char* b3 = b2 + kstep;
            if (last && has_next) S.a_ready(nxt);
            if constexpr (SP2) {
            PG8_LDB(B0, 0, 0); PG8_LDB(B1, 0, 1); PG8_SCHED; PG8_LDA(At, 0, 0); PG8_STAGE(PG8_SA(1, 1), a1 + hstep, voffA);
            PG8_WAIT_V(8); PG8_WAIT_L(0); PG8_BAR; PG8_MMA(0, 0, At, B0); PG8_MMA(0, 1, At, B1); PG8_BAR; PG8_SCHED;
            PG8_LDA(At, 0, 1); PG8_STAGE(PG8_SB(0, 0), b2, voffB); PG8_STAGE(PG8_SB(0, 1), b2 + hstep, voffB); PG8_STAGE(PG8_SA(0, 0), a2, voffA);
            PG8_WAIT_V(8); PG8_WAIT_L(0); PG8_BAR; PG8_MMA(1, 0, At, B0); PG8_MMA(1, 1, At, B1); PG8_BAR; PG8_SCHED;
            PG8_LDB(B0, 1, 0); PG8_LDB(B1, 1, 1); PG8_SCHED; PG8_LDA(At, 1, 0); PG8_STAGE(PG8_SA(0, 1), a2 + hstep, voffA);
            PG8_WAIT_V(8); PG8_WAIT_L(0); PG8_BAR; PG8_MMA(0, 0, At, B0); PG8_MMA(0, 1, At, B1); PG8_BAR; PG8_SCHED;
            PG8_LDA(At, 1, 1); PG8_STAGE(PG8_SB(1, 0), b3, voffB); PG8_STAGE(PG8_SB(1, 1), b3 + hstep, voffB); PG8_STAGE(PG8_SA(1, 0), a3, voffA);
            PG8_WAIT_V(8); PG8_WAIT_L(0); PG8_BAR; PG8_MMA(1, 0, At, B0); PG8_MMA(1, 1, At, B1); PG8_BAR; PG8_SCHED;
            } else {
            PG8_LDB(B0, 0, 0); PG8_SCHED; PG8_LDA(At, 0, 0); PG8_STAGE(PG8_SA(1, 1), a1 + hstep, voffA);
            PG8_WAIT_L(8); PG8_BAR; PG8_WAIT_L(0); PG8_MMA(0, 0, At, B0); PG8_BAR; PG8_SCHED;
            PG8_LDB(B1, 0, 1); PG8_STAGE(PG8_SB(0, 0), b2, voffB);
            PG8_BAR; PG8_WAIT_L(0); PG8_MMA(0, 1, At, B1); PG8_BAR;
            PG8_LDA(At, 0, 1); PG8_STAGE(PG8_SA(0, 0), a2, voffA);
            PG8_BAR; PG8_WAIT_L(0); PG8_MMA(1, 0, At, B0); PG8_BAR; PG8_SCHED;
            PG8_STAGE(PG8_SB(0, 1), b2 + hstep, voffB);
            PG8_WAIT_V(6); PG8_BAR; PG8_MMA(1, 1, At, B1); PG8_BAR;
            PG8_LDB(B0, 1, 0); PG8_SCHED; PG8_LDA(At, 1, 0); PG8_STAGE(PG8_SA(0, 1), a2 + hstep, voffA);
            PG8_WAIT_L(8); PG8_BAR; PG8_WAIT_L(0); PG8_MMA(0, 0, At, B0); PG8_BAR; PG8_SCHED;
            PG8_LDB(B1, 1, 1); PG8_STAGE(PG8_SB(1, 0), b3, voffB);
            PG8_BAR; PG8_WAIT_L(0); PG8_MMA(0, 1, At, B1); PG8_BAR;
            PG8_LDA(At, 1, 1); PG8_STAGE(PG8_SA(1, 0), a3, voffA);
            PG8_BAR; PG8_WAIT_L(0); PG8_MMA(1, 0, At, B0); PG8_BAR; PG8_SCHED;
            PG8_STAGE(PG8_SB(1, 1), b3 + hstep, voffB);
            PG8_WAIT_V(6); PG8_BAR; PG8_MMA(1, 1, At, B1); PG8_BAR;
            }
        }
        if constexpr (ALIGN_EPI) { if (wr == 0) PG8_BAR; }
        if constexpr (!Epi::AFTER_DRAIN) { E(acc, cur, wr, wc, fr, fq); S.done(cur); }
        if (!has_next) break;
#pragma unroll
        for (int a = 0; a < 2; ++a)
#pragma unroll
            for (int b = 0; b < 2; ++b)
#pragma unroll
                for (int m = 0; m < 4; ++m)
#pragma unroll
                    for (int n = 0; n < 2; ++n) acc[a][b][m][n] = (f32x4){0.f, 0.f, 0.f, 0.f};
        cur = nxt; cA = nA; cB = nB; ++ui;
        if constexpr (ALIGN_EPI) { if (wr == 1) PG8_BAR; }
    }
    PG8_WAIT_V(0);
    if constexpr (!ALIGN_EPI) { if (wr == 0) PG8_BAR; }
    PG8_BAR;
    if constexpr (Epi::AFTER_DRAIN) { E.fused(acc, cur, wr, wc, fr, fq, lds, wid, lane); S.done(cur); }
#undef PG8_SA
#undef PG8_SB
#undef PG8_STAGE
#undef PG8_LDA
#undef PG8_LDB
#undef PG8_MMA
#undef PG8_WAIT_V
#undef PG8_WAIT_L
#undef PG8_BAR
#undef PG8_SCHED
}
}

constexpr int BATCH = 32, SEQ = 2048, D = 1024, T = BATCH * SEQ, DEPTH = 2, CHUNK = 64, NCH = SEQ / CHUNK;
constexpr int A_HEADS = 8, A_HD = 64, A_W = 512, A_LEFT = 8, A_BAND = 576, A_CLIP = 256, A_NREL = 320;
constexpr int B_HEADS = 4, B_HD = 128, B_W = 512;
constexpr int C_W = 512;
constexpr int D_IN = 7176;
constexpr int OFF_QA = 0, OFF_KA = 512, OFF_VA = 1024, OFF_QKVB = 1536, OFF_BETA = 3072, OFF_DEC = 3076, OFF_GATEB = 3080, OFF_POOL = 3592, OFF_GATES = 4104;
constexpr int NEXP = 32, MOE_FF = 512, MOE_BLOCK = 256;
constexpr int NPAIR = 2 * T, NBLK_MAX = NPAIR / MOE_BLOCK + NEXP, CAP = NBLK_MAX * MOE_BLOCK;
constexpr float DN_ALPHA = 1.4142135623730951f;
constexpr float LN_EPS = 1e-5f, RMS_EPS = 1e-6f;
constexpr int N1 = 3584;

constexpr size_t MiB = 1ull << 20, U = 128 * MiB;
constexpr size_t WS_CTL = 0;
constexpr size_t WS_WIN1 = 1 * MiB, WS_WV = 8 * MiB, WS_WG = 9 * MiB, WS_WBR = 15 * MiB, WS_WOUT = 18 * MiB, WS_W13 = 20 * MiB, WS_W2 = 84 * MiB;
constexpr size_t WS_XB = U;
constexpr size_t WS_P = 2 * U;
constexpr size_t WS_QA = WS_P, WS_KA = WS_P + U / 2, WS_VT = WS_P + U, WS_QKVB = WS_P + 3 * U / 2, WS_GATEB = WS_P + 3 * U, WS_POOL = WS_P + 7 * U / 2;
constexpr size_t WS_OA = WS_P + 4 * U, WS_OB = WS_P + 9 * U / 2, WS_PLD = WS_P + 5 * U;
constexpr size_t WS_SM = 116 * MiB;
constexpr size_t WS_BDL = WS_SM, WS_EID = WS_SM + 2 * MiB, WS_WTS = WS_SM + 5 * MiB / 2, WS_SLOT = WS_SM + 3 * MiB, WS_HIST = WS_SM + 7 * MiB / 2, WS_BLKE = WS_SM + 15 * MiB / 4, WS_GC = WS_SM + 4 * MiB;
constexpr size_t WS_TMU = WS_P + 11 * U / 2, WS_TMW = WS_TMU + 32 * MiB;
constexpr size_t WS_GATES = WS_P, WS_Y = WS_P + 3 * U, WS_MIX = WS_P;
constexpr size_t WS_XG = WS_P, WS_HDN = WS_P + (size_t)CAP * 2048, WS_YMOE = WS_HDN + (size_t)CAP * 1024;
constexpr size_t WS_END = 8 * U;
static_assert(WS_YMOE + (size_t)CAP * 2048 <= WS_TMU, "moe buffers");
static_assert(WS_GC + 1 * MiB <= U, "small tables");
constexpr size_t WS_WRT = WS_SM + 5 * MiB;
static_assert(WS_WRT + 2 * 48 * 1024 * 2 <= U, "router weights");
static_assert(WS_W2 + 32 * MiB <= U, "weights");

__device__ __forceinline__ unsigned f2bf(float f) { unsigned u = __builtin_bit_cast(unsigned, f); return (u + 0x7fffu + ((u >> 16) & 1u)) >> 16; }
__device__ __forceinline__ unsigned pk2(float lo, float hi) { return f2bf(lo) | (f2bf(hi) << 16); }
__device__ __forceinline__ float bf2f(unsigned short b) { return __builtin_bit_cast(float, ((unsigned)b) << 16); }
__device__ __forceinline__ float bflo(unsigned w) { return __builtin_bit_cast(float, w << 16); }
__device__ __forceinline__ float bfhi(unsigned w) { return __builtin_bit_cast(float, w & 0xffff0000u); }
__device__ __forceinline__ float wave_sum(float v) {
#pragma unroll
    for (int o = 1; o < 64; o <<= 1) v += __shfl_xor(v, o);
    return v;
}
__device__ __forceinline__ float sigmoidf_(float x) { return 1.0f / (1.0f + __expf(-x)); }
__device__ __forceinline__ float siluf_(float x) { return x / (1.0f + __expf(-x)); }
__device__ __forceinline__ float softplusf_(float x) { return x > 20.f ? x : log1pf(expf(x)); }

__device__ __forceinline__ int fresh_lane() { int l; asm volatile("v_mbcnt_lo_u32_b32 %0, -1, 0\n\tv_mbcnt_hi_u32_b32 %0, -1, %0" : "=v"(l)); return l; }
struct Args { const float* in[25]; float* out; unsigned char* ws; int lay_lo, lay_hi, ph_lo, ph_hi; };

enum Phase { PH_CONVERT = 0, PH_PROJ1 = 1, PH_PRE = 2, PH_MIX = 3, PH_GATES = 4, PH_BRANCH = 5, PH_OUT = 6, PH_LN1 = 7, PH_SLOTS = 8, PH_MOE1 = 9, PH_MOE2 = 10, PH_LN2 = 11, PH_COUNT = 12 };

constexpr int NWAVES = 8, NTHR = 512;
constexpr int LDS_BYTES = 163840;

__device__ __forceinline__ void convert_item(const float* W, int ldw, int col0, int k0, bf16_t* WT, int Kd, int rowbase, int ilv_half, LAS unsigned char* lds, int tid) {
    LAS float* scr = (LAS float*)lds;
#pragma unroll
    for (int i = 0; i < 16; ++i) { const int k = 4 * i + (tid >> 7), c4 = (tid & 127) * 4;
        *(LAS f32x4*)(scr + k * 516 + c4) = *(const f32x4*)(W + (size_t)(k0 + k) * ldw + col0 + c4); }
    __syncthreads();
    const int nlo = tid & 31, cch = (tid >> 5) & 7, nhi = tid >> 8;
#pragma unroll
    for (int j = 0; j < 8; ++j) {
        const int n = nlo + 32 * (nhi + 2 * j); const LAS float* sp = scr + (8 * cch) * 516 + n;
        u32x4 o; o.x = pg8::cvt_pk_bf16(sp[0], sp[516]); o.y = pg8::cvt_pk_bf16(sp[2 * 516], sp[3 * 516]); o.z = pg8::cvt_pk_bf16(sp[4 * 516], sp[5 * 516]); o.w = pg8::cvt_pk_bf16(sp[6 * 516], sp[7 * 516]);
        const int fr_ = (ilv_half < 0) ? n : ((n >> 7) * 256 + ilv_half * 128 + (n & 127));
        *(u32x4*)(WT + (size_t)(rowbase + fr_) * Kd + k0 + 8 * cch) = o;
    }
    __syncthreads();
}
__device__ __forceinline__ void phase_convert(const Args& a, LAS unsigned char* lds, int layer, int gw, int NGW, int wave, int lane, int tid, int gtid, int GT) {
    unsigned char* ws = a.ws;
    const float* w_in = a.in[1] + (size_t)layer * D * D_IN;
    constexpr int I_IN = 14 * 16, I_BR = 2 * 2 * 8, I_OUT = 2 * 16, I_W13 = NEXP * 2 * 16, I_W2 = NEXP * 2 * 8, I_FOLD = 32, NITEMS = I_IN + I_BR + I_OUT + I_W13 + I_W2 + I_FOLD;
    const int G_ = NGW / NWAVES;
    for (int it = blockIdx.x; it < NITEMS; it += G_) {
        int r = it;
        if (r < I_IN) {
            const int kb = r & 15, cb = r >> 4;
            int c0, r0; size_t dd;
            if (cb == 0) { c0 = OFF_QA; r0 = 0; dd = WS_WIN1; } else if (cb == 1) { c0 = OFF_KA; r0 = 512; dd = WS_WIN1; }
            else if (cb < 5) { c0 = OFF_QKVB + 512 * (cb - 2); r0 = 1024 + 512 * (cb - 2); dd = WS_WIN1; }
            else if (cb == 5) { c0 = OFF_GATEB; r0 = 2560; dd = WS_WIN1; } else if (cb == 6) { c0 = OFF_POOL; r0 = 3072; dd = WS_WIN1; }
            else if (cb == 7) { c0 = OFF_VA; r0 = 0; dd = WS_WV; } else { c0 = OFF_GATES + 512 * (cb - 8); r0 = 512 * (cb - 8); dd = WS_WG; }
            convert_item(w_in, D_IN, c0, 64 * kb, (bf16_t*)(ws + dd), 1024, r0, -1, lds, tid);
            continue;
        }
        r -= I_IN;
        if (r < I_BR) {
            const int which = r >> 4, cb = (r >> 3) & 1, kb = r & 7;
            const float* W = (which == 0 ? a.in[9] : a.in[10]) + (size_t)layer * 512 * 1024;
            convert_item(W, 1024, 512 * cb, 64 * kb, (bf16_t*)(ws + WS_WBR) + (size_t)which * 1024 * 512, 512, 512 * cb, -1, lds, tid);
            continue;
        }
        r -= I_BR;
        if (r < I_OUT) {
            const int cb = r >> 4, kb = r & 15;
            convert_item(a.in[13] + (size_t)layer * 1024 * 1024, 1024, 512 * cb, 64 * kb, (bf16_t*)(ws + WS_WOUT), 1024, 512 * cb, -1, lds, tid);
            continue;
        }
        r -= I_OUT;
        if (r < I_W13) {
            const int e = r >> 5, half = (r >> 4) & 1, kb = r & 15;
            const float* W = (half == 0 ? a.in[20] : a.in[21]) + ((size_t)layer * NEXP + e) * 1024 * 512;
            convert_item(W, 512, 0, 64 * kb, (bf16_t*)(ws + WS_W13), 1024, e * 1024, half, lds, tid);
            continue;
        }
        r -= I_W13;
        if (r < I_W2) {
            const int e = r >> 4, cb = (r >> 3) & 1, kb = r & 7;
            const float* W = a.in[22] + ((size_t)layer * NEXP + e) * 512 * 1024;
            convert_item(W, 1024, 512 * cb, 64 * kb, (bf16_t*)(ws + WS_W2), 512, e * 1024 + 512 * cb, -1, lds, tid);
            continue;
        }
        r -= I_W2;
        {
            const int g = r >> 3, d0 = (r & 7) * 128;
            const float* pw = a.in[7] + ((size_t)layer * 4 + g) * 128 * 128; const float* ps = a.in[8] + (size_t)layer * 512 + g * 128;
            const float* wc = a.in[11] + ((size_t)layer * 512 + g * 128) * 1024 + d0;
            LAS float* pws = (LAS float*)lds; LAS float* wcs = pws + 128 * 128;
            for (int i = tid; i < 128 * 128; i += NTHR) { pws[i] = pw[i] * ps[i & 127]; wcs[i] = wc[(size_t)(i >> 7) * 1024 + (i & 127)]; }
            __syncthreads();
            const int d = tid & 127, cg = __builtin_amdgcn_readfirstlane(tid >> 7);
            float acc[32];
#pragma unroll
            for (int j = 0; j < 32; ++j) acc[j] = 0.f;
            for (int c2 = 0; c2 < 128; ++c2) { const float wv = wcs[c2 * 128 + d];
#pragma unroll
                for (int j = 0; j < 32; ++j) acc[j] += pws[(cg * 32 + j) * 128 + c2] * wv; }
            bf16_t* dst = (bf16_t*)(ws + WS_WBR) + (size_t)2 * 1024 * 512 + (size_t)(d0 + d) * 512 + g * 128 + cg * 32;
#pragma unroll
            for (int j = 0; j < 4; ++j) { u32x4 o; o.x = pg8::cvt_pk_bf16(acc[8 * j], acc[8 * j + 1]); o.y = pg8::cvt_pk_bf16(acc[8 * j + 2], acc[8 * j + 3]); o.z = pg8::cvt_pk_bf16(acc[8 * j + 4], acc[8 * j + 5]); o.w = pg8::cvt_pk_bf16(acc[8 * j + 6], acc[8 * j + 7]);
                *(u32x4*)(dst + 8 * j) = o; }
            __syncthreads();
        }
    }
    {
        const float* we = a.in[18] + (size_t)layer * D * 32; const float* wgp = a.in[16] + (size_t)layer * D * 4;
        bf16_t* dst = (bf16_t*)(ws + WS_WRT);
        for (int i = gtid; i < 48 * 1024; i += GT) {
            const int n = i >> 10, k = i & 1023;
            const float w = (n < 32) ? we[(size_t)k * 32 + n] : (n < 36 ? wgp[(size_t)k * 4 + (n - 32)] : 0.f);
            const unsigned h = f2bf(w); const float lo = w - bf2f((unsigned short)h);
            dst[i] = (bf16_t)h; dst[48 * 1024 + i] = (bf16_t)f2bf(lo);
        }
    }
}

__device__ __forceinline__ void row_store_bf16(bf16_t* dst_row, const f32x4 (&v)[4], int lane) {
    unsigned long long* o8 = (unsigned long long*)dst_row + lane;
#pragma unroll
    for (int j = 0; j < 4; ++j) o8[64 * j] = (unsigned long long)pk2(v[j].x, v[j].y) | ((unsigned long long)pk2(v[j].z, v[j].w) << 32);
}
__device__ __forceinline__ void row_bd_logits(const f32x4 (&v)[4], const LAS float* wbd, float* bdl_row, int lane) {
    float acc[8];
#pragma unroll
    for (int i = 0; i < 8; ++i) acc[i] = 0.f;
#pragma unroll
    for (int j = 0; j < 4; ++j)
#pragma unroll
        for (int c = 0; c < 4; ++c) {
            const int k = 256 * j + 4 * lane + c; const float xv = v[j][c];
            const f32x4 w0 = *(const LAS f32x4*)(wbd + k * 8), w1 = *(const LAS f32x4*)(wbd + k * 8 + 4);
            acc[0] += xv * w0.x; acc[1] += xv * w0.y; acc[2] += xv * w0.z; acc[3] += xv * w0.w;
            acc[4] += xv * w1.x; acc[5] += xv * w1.y; acc[6] += xv * w1.z; acc[7] += xv * w1.w;
            if (c == 3) asm volatile("" ::: "memory");
        }
    float r = 0.f;
#pragma unroll
    for (int i = 0; i < 8; ++i) { const float s = wave_sum(acc[i]); r = (lane == i) ? s : r; }
    if (lane < 8) bdl_row[lane] = r;
}
__device__ __forceinline__ void stage_wbd(const float* w_in_layer, LAS float* wbd, int tid) {
    for (int k = tid; k < 1024; k += NTHR) {
        const f32x4 a0 = *(const f32x4*)(w_in_layer + (size_t)k * D_IN + OFF_BETA), a1 = *(const f32x4*)(w_in_layer + (size_t)k * D_IN + OFF_BETA + 4);
        *(LAS f32x4*)(wbd + k * 8) = a0; *(LAS f32x4*)(wbd + k * 8 + 4) = a1;
    }
    __syncthreads();
}

__device__ __forceinline__ void phase_xconv(const Args& a, LAS unsigned char* lds, int gw, int NGW, int lane, int tid) {
    LAS float* wbd = (LAS float*)(lds);
    stage_wbd(a.in[1], wbd, tid);
    const float* x = a.in[0]; bf16_t* XB = (bf16_t*)(a.ws + WS_XB); float* bdl = (float*)(a.ws + WS_BDL);
    for (int m = gw; m < T; m += NGW) {
        const f32x4* xr = (const f32x4*)(x + (size_t)m * D) + lane;
        f32x4 v[4];
#pragma unroll
        for (int j = 0; j < 4; ++j) v[j] = xr[64 * j];
        row_store_bf16(XB + (size_t)m * D, v, lane);
        row_bd_logits(v, wbd, bdl + (size_t)m * 8, lane);
    }
    __syncthreads();
}

__device__ __forceinline__ void phase_pool(const Args& a, int gw, int NGW, int lane) {
    const bf16_t* pool = (const bf16_t*)(a.ws + WS_POOL); bf16_t* pld = (bf16_t*)(a.ws + WS_PLD);
    const int g = lane >> 4, win = 2 << g;
    for (int blk = gw; blk < T / 32; blk += NGW) {
        const int m0 = blk * 32, tl0 = m0 & (SEQ - 1);
        float s[8];
#pragma unroll
        for (int i = 0; i < 8; ++i) s[i] = 0.f;
        for (int q = 1; q < 16; ++q) {
            if (q < win && tl0 - q >= 0) { const u32x4 w = *(const u32x4*)(pool + (size_t)(m0 - q) * 512 + 8 * lane);
                s[0] += bflo(w.x); s[1] += bfhi(w.x); s[2] += bflo(w.y); s[3] += bfhi(w.y); s[4] += bflo(w.z); s[5] += bfhi(w.z); s[6] += bflo(w.w); s[7] += bfhi(w.w); }
        }
        for (int r = 0; r < 32; ++r) {
            const int m = m0 + r, tl = tl0 + r;
            const u32x4 cur = *(const u32x4*)(pool + (size_t)m * 512 + 8 * lane);
            const int old = tl - win + 1;
            u32x4 w = {0u, 0u, 0u, 0u};
            if (old >= 0) w = *(const u32x4*)(pool + (size_t)(m - win + 1) * 512 + 8 * lane);
            s[0] += bflo(cur.x); s[1] += bfhi(cur.x); s[2] += bflo(cur.y); s[3] += bfhi(cur.y); s[4] += bflo(cur.z); s[5] += bfhi(cur.z); s[6] += bflo(cur.w); s[7] += bfhi(cur.w);
            const int n = (tl + 1 < win) ? tl + 1 : win;
            const float inv = 1.0f / (float)n;
            u32x4 o;
            o.x = pg8::cvt_pk_bf16(s[0] * inv - bflo(cur.x), s[1] * inv - bfhi(cur.x)); o.y = pg8::cvt_pk_bf16(s[2] * inv - bflo(cur.y), s[3] * inv - bfhi(cur.y));
            o.z = pg8::cvt_pk_bf16(s[4] * inv - bflo(cur.z), s[5] * inv - bfhi(cur.z)); o.w = pg8::cvt_pk_bf16(s[6] * inv - bflo(cur.w), s[7] * inv - bfhi(cur.w));
            *(u32x4*)(pld + (size_t)m * 512 + 8 * lane) = o;
            s[0] -= bflo(w.x); s[1] -= bfhi(w.x); s[2] -= bflo(w.y); s[3] -= bfhi(w.y); s[4] -= bflo(w.z); s[5] -= bfhi(w.z); s[6] -= bflo(w.w); s[7] -= bfhi(w.w);
        }
    }
}

__device__ __forceinline__ void phase_ln1(const Args& a, LAS unsigned char* lds, int layer, int gw, int NGW, int wave, int lane) {
    const float* xin = (layer == 0) ? a.in[0] : a.out;
    const bf16_t* mix = (const bf16_t*)(a.ws + WS_MIX);
    float* xo = a.out; bf16_t* XB = (bf16_t*)(a.ws + WS_XB);
    const float* lg_ = a.in[14] + (size_t)layer * D; const float* lb_ = a.in[15] + (size_t)layer * D;
    const float* bg = a.in[17] + (size_t)layer * 4; const float* be = a.in[19] + (size_t)layer * 32;
    const bf16_t* wrt = (const bf16_t*)(a.ws + WS_WRT);
    int* eid = (int*)(a.ws + WS_EID); float* wts = (float*)(a.ws + WS_WTS); int* hist = (int*)(a.ws + WS_HIST);
    LAS float* lgt = (LAS float*)(lds + wave * 4096);
    LAS int* hst = (LAS int*)(lds + wave * 4096 + 3072);
    if (lane < 32) hst[lane] = 0;
    f32x4 gv[4], bv[4];
#pragma unroll
    for (int j = 0; j < 4; ++j) { gv[j] = ((const f32x4*)lg_)[64 * j + lane]; bv[j] = ((const f32x4*)lb_)[64 * j + lane]; }
    const int fr = lane & 15, fq = lane >> 4;
    for (int grp = gw; grp < T / 16; grp += NGW) {
        f32x4 xa[4]; u32x2 ma[4];
        {
            const f32x4* xr = (const f32x4*)(xin + (size_t)(grp * 16) * D) + lane; const u32x2* mr = (const u32x2*)(mix + (size_t)(grp * 16) * D) + lane;
#pragma unroll
            for (int j = 0; j < 4; ++j) { xa[j] = xr[64 * j]; ma[j] = mr[64 * j]; }
        }
        for (int rr = 0; rr < 16; ++rr) {
            const int m = grp * 16 + rr;
            f32x4 v[4]; float s = 0.f;
#pragma unroll
            for (int j = 0; j < 4; ++j) { const f32x4 mf = {bflo(ma[j].x), bfhi(ma[j].x), bflo(ma[j].y), bfhi(ma[j].y)}; v[j] = xa[j] * DN_ALPHA + mf; s += (v[j].x + v[j].y) + (v[j].z + v[j].w); }
            if (rr + 1 < 16) {
                const f32x4* xr = (const f32x4*)(xin + (size_t)(m + 1) * D) + lane; const u32x2* mr = (const u32x2*)(mix + (size_t)(m + 1) * D) + lane;
#pragma unroll
                for (int j = 0; j < 4; ++j) { xa[j] = xr[64 * j]; ma[j] = mr[64 * j]; }
            }
            const float mean = wave_sum(s) * (1.f / D); float s2 = 0.f;
#pragma unroll
            for (int j = 0; j < 4; ++j) { v[j] = v[j] - mean; s2 += (v[j].x * v[j].x + v[j].y * v[j].y) + (v[j].z * v[j].z + v[j].w * v[j].w); }
            const float rstd = 1.f / sqrtf(wave_sum(s2) * (1.f / D) + LN_EPS);
#pragma unroll
            for (int j = 0; j < 4; ++j) v[j] = v[j] * rstd * gv[j] + bv[j];
            f32x4* orow = (f32x4*)(xo + (size_t)m * D) + lane;
#pragma unroll
            for (int j = 0; j < 4; ++j) orow[64 * j] = v[j];
            row_store_bf16(XB + (size_t)m * D, v, lane);
        }
        asm volatile("s_waitcnt vmcnt(0)" ::: "memory");
        f32x4 acc[3];
#pragma unroll
        for (int t = 0; t < 3; ++t) acc[t] = (f32x4){0.f, 0.f, 0.f, 0.f};
        const float* xrow = xo + (size_t)(grp * 16 + fr) * D + 8 * fq;
#pragma unroll 4
        for (int ks = 0; ks < 32; ++ks) {
            const f32x4 x0 = *(const f32x4*)(xrow + ks * 32), x1 = *(const f32x4*)(xrow + ks * 32 + 4);
            u32x4 hi; hi.x = pg8::cvt_pk_bf16(x0.x, x0.y); hi.y = pg8::cvt_pk_bf16(x0.z, x0.w); hi.z = pg8::cvt_pk_bf16(x1.x, x1.y); hi.w = pg8::cvt_pk_bf16(x1.z, x1.w);
            u32x4 lo; lo.x = pg8::cvt_pk_bf16(x0.x - bflo(hi.x), x0.y - bfhi(hi.x)); lo.y = pg8::cvt_pk_bf16(x0.z - bflo(hi.y), x0.w - bfhi(hi.y));
            lo.z = pg8::cvt_pk_bf16(x1.x - bflo(hi.z), x1.y - bfhi(hi.z)); lo.w = pg8::cvt_pk_bf16(x1.z - bflo(hi.w), x1.w - bfhi(hi.w));
            const bf16x8 Bh = __builtin_bit_cast(bf16x8, hi), Bl = __builtin_bit_cast(bf16x8, lo);
#pragma unroll
            for (int t = 0; t < 3; ++t) {
                const bf16x8 Ah = *(const bf16x8*)(wrt + (size_t)(t * 16 + fr) * 1024 + ks * 32 + 8 * fq), Al = *(const bf16x8*)(wrt + (size_t)(48 + t * 16 + fr) * 1024 + ks * 32 + 8 * fq);
                acc[t] = __builtin_amdgcn_mfma_f32_16x16x32_bf16(Ah, Bh, acc[t], 0, 0, 0);
                acc[t] = __builtin_amdgcn_mfma_f32_16x16x32_bf16(Ah, Bl, acc[t], 0, 0, 0);
                acc[t] = __builtin_amdgcn_mfma_f32_16x16x32_bf16(Al, Bh, acc[t], 0, 0, 0);
            }
        }
#pragma unroll
        for (int t = 0; t < 3; ++t) *(LAS f32x4*)(lgt + fr * 48 + t * 16 + 4 * fq) = acc[t];
        asm volatile("s_waitcnt lgkmcnt(0)" ::: "memory");
        if (lane < 16) {
            const int m = grp * 16 + lane; const LAS float* lr = lgt + lane * 48;
            float ag[4];
#pragma unroll
            for (int i = 0; i < 4; ++i) ag[i] = lr[32 + i] + bg[i];
            int gsel = 0; float gm = ag[0];
#pragma unroll
            for (int i = 1; i < 4; ++i) if (ag[i] > gm) { gm = ag[i]; gsel = i; }
            float gs = 0.f;
#pragma unroll
            for (int i = 0; i < 4; ++i) gs += expf(ag[i] - gm);
            const float p_top = 1.0f / gs;
            float le[8];
#pragma unroll
            for (int i = 0; i < 8; ++i) le[i] = lr[gsel * 8 + i] + be[gsel * 8 + i];
            int i0 = 0; float l0 = le[0];
#pragma unroll
            for (int i = 1; i < 8; ++i) if (le[i] > l0) { l0 = le[i]; i0 = i; }
            int i1 = -1; float l1 = -3.0e38f;
#pragma unroll
            for (int i = 0; i < 8; ++i) if (i != i0 && le[i] > l1) { l1 = le[i]; i1 = i; }
            const float ex = expf(l1 - l0); const float w0 = p_top / (1.0f + ex), w1 = p_top * ex / (1.0f + ex);
            const int e0 = gsel * 8 + i0, e1 = gsel * 8 + i1;
            eid[2 * m] = e0; eid[2 * m + 1] = e1; wts[2 * m] = w0; wts[2 * m + 1] = w1;
            __hip_atomic_fetch_add(hst + e0, 1, __ATOMIC_RELAXED, __HIP_MEMORY_SCOPE_WORKGROUP); __hip_atomic_fetch_add(hst + e1, 1, __ATOMIC_RELAXED, __HIP_MEMORY_SCOPE_WORKGROUP);
        }
        asm volatile("s_waitcnt lgkmcnt(0)" ::: "memory");
    }
    if (lane < 32) hist[gw * 32 + lane] = hst[lane];
}

__device__ __forceinline__ void phase_slots(const Args& a, LAS unsigned char* lds, int gw, int NGW, int wave, int lane, int tid) {
    LAS int* red = (LAS int*)lds;
    LAS int* tot = red + 1024;
    LAS int* bef = tot + 32;
    LAS int* pst = bef + 32;
    LAS int* base = pst + 64;
    const int* hist = (const int*)(a.ws + WS_HIST);
    const int nwv = NGW;
    const int wg0 = gw - wave;
    {
        const int e = tid & 31, part = tid >> 5;
        const int per = (nwv + 15) / 16; const int lo = part * per, hi = (lo + per < nwv) ? lo + per : nwv;
        int st = 0, sb = 0;
        for (int g = lo; g < hi; ++g) { const int v = hist[g * 32 + e]; st += v; sb += (g < wg0) ? v : 0; }
        red[part * 32 + e] = st; red[512 + part * 32 + e] = sb;
    }
    __syncthreads();
    if (tid < 32) { int st = 0, sb = 0; for (int p = 0; p < 16; ++p) { st += red[p * 32 + tid]; sb += red[512 + p * 32 + tid]; } tot[tid] = st; bef[tid] = sb; }
    __syncthreads();
    if (tid == 0) { int acc = 0; for (int e = 0; e < 32; ++e) { pst[e] = acc; acc += (tot[e] + MOE_BLOCK - 1) / MOE_BLOCK * MOE_BLOCK; } pst[32] = acc; }
    __syncthreads();
    if (tid < 32) { int acc = pst[tid] + bef[tid]; for (int w = 0; w < NWAVES; ++w) { base[w * 32 + tid] = acc; acc += hist[(wg0 + w) * 32 + tid]; } }
    __syncthreads();
    if (blockIdx.x == 0) {
        int* blk_e = (int*)(a.ws + WS_BLKE);
        const int nblk = pst[32] / MOE_BLOCK;
        if (tid == 0) blk_e[1023] = nblk;
        for (int b = tid; b < nblk; b += NTHR) { int e = 0; for (int q = 0; q < 32; ++q) if (pst[q] <= b * MOE_BLOCK) e = q; blk_e[b] = e; }
    }
    const int* eid = (const int*)(a.ws + WS_EID); int* slot = (int*)(a.ws + WS_SLOT);
    const bf16_t* XB = (const bf16_t*)(a.ws + WS_XB); bf16_t* xg = (bf16_t*)(a.ws + WS_XG);
    int cnt = (lane < 32) ? base[wave * 32 + lane] : 0;
    for (int grp = gw; grp < T / 16; grp += NGW)
    for (int rr = 0; rr < 16; ++rr) {
        const int m = grp * 16 + rr;
        const int e0 = eid[2 * m], e1 = eid[2 * m + 1];
        const int s0 = __shfl(cnt, e0); cnt += (lane == e0) ? 1 : 0;
        const int s1 = __shfl(cnt, e1); cnt += (lane == e1) ? 1 : 0;
        if (lane == 0) { slot[2 * m] = s0; slot[2 * m + 1] = s1; }
        const u32x4* src = (const u32x4*)(XB + (size_t)m * D) + lane;
        const u32x4 p0 = src[0], p1 = src[64];
        u32x4* d0 = (u32x4*)(xg + (size_t)s0 * D) + lane; u32x4* d1 = (u32x4*)(xg + (size_t)s1 * D) + lane;
        d0[0] = p0; d0[64] = p1; d1[0] = p0; d1[64] = p1;
    }
    __syncthreads();
}

__device__ __forceinline__ void phase_ln2(const Args& a, LAS unsigned char* lds, int layer, int gw, int NGW, int lane, int tid) {
    LAS float* wbd = (LAS float*)(lds);
    const bool has_next = (layer + 1 < DEPTH);
    if (has_next) stage_wbd(a.in[1] + (size_t)(layer + 1) * D * D_IN, wbd, tid);
    float* xo = a.out; bf16_t* XB = (bf16_t*)(a.ws + WS_XB); float* bdl = (float*)(a.ws + WS_BDL);
    const bf16_t* ymoe = (const bf16_t*)(a.ws + WS_YMOE);
    const int* slot = (const int*)(a.ws + WS_SLOT); const float* wts = (const float*)(a.ws + WS_WTS);
    const float* lg_ = a.in[23] + (size_t)layer * D; const float* lb_ = a.in[24] + (size_t)layer * D;
    LAS f32x4* gbl = (LAS f32x4*)(lds + 32768);
    for (int i = tid; i < 256; i += NTHR) { gbl[i] = ((const f32x4*)lg_)[i]; gbl[256 + i] = ((const f32x4*)lb_)[i]; }
    __syncthreads();
    const int nrows = (T - gw + NGW - 1) / NGW;
    for (int i0 = 0; i0 < nrows; i0 += 64) {
        const int nb = (nrows - i0 < 64) ? nrows - i0 : 64;
        int sl0 = 0, sl1 = 0; float ww0 = 0.f, ww1 = 0.f;
        if (lane < nb) { const int mm = gw + (i0 + lane) * NGW; sl0 = slot[2 * mm]; sl1 = slot[2 * mm + 1]; ww0 = wts[2 * mm]; ww1 = wts[2 * mm + 1]; }
        f32x4 xa[4]; unsigned long long ya0[4], ya1[4];
        {
            const int m = gw + i0 * NGW; const int s0 = __builtin_amdgcn_readlane(sl0, 0), s1 = __builtin_amdgcn_readlane(sl1, 0);
            const f32x4* xr = (const f32x4*)(xo + (size_t)m * D) + lane;
            const unsigned long long* y0 = (const unsigned long long*)(ymoe + (size_t)s0 * D) + lane; const unsigned long long* y1 = (const unsigned long long*)(ymoe + (size_t)s1 * D) + lane;
#pragma unroll
            for (int j = 0; j < 4; ++j) { xa[j] = xr[64 * j]; ya0[j] = y0[64 * j]; ya1[j] = y1[64 * j]; }
        }
        for (int i = 0; i < nb; ++i) {
            const int m = gw + (i0 + i) * NGW;
            const float w0 = __builtin_bit_cast(float, __builtin_amdgcn_readlane(__builtin_bit_cast(int, ww0), i)), w1 = __builtin_bit_cast(float, __builtin_amdgcn_readlane(__builtin_bit_cast(int, ww1), i));
            f32x4 xc[4]; unsigned long long yc0[4], yc1[4];
#pragma unroll
            for (int j = 0; j < 4; ++j) { xc[j] = xa[j]; yc0[j] = ya0[j]; yc1[j] = ya1[j]; }
            if (i + 1 < nb) {
                const int mn = m + NGW; const int s0 = __builtin_amdgcn_readlane(sl0, i + 1), s1 = __builtin_amdgcn_readlane(sl1, i + 1);
                const f32x4* xr = (const f32x4*)(xo + (size_t)mn * D) + lane;
                const unsigned long long* y0 = (const unsigned long long*)(ymoe + (size_t)s0 * D) + lane; const unsigned long long* y1 = (const unsigned long long*)(ymoe + (size_t)s1 * D) + lane;
#pragma unroll
                for (int j = 0; j < 4; ++j) { xa[j] = xr[64 * j]; ya0[j] = y0[64 * j]; ya1[j] = y1[64 * j]; }
            }
            f32x4 v[4]; float s = 0.f;
#pragma unroll
            for (int j = 0; j < 4; ++j) {
                const unsigned long long p = yc0[j], q = yc1[j];
                f32x4 f; f.x = w0 * bflo((unsigned)p) + w1 * bflo((unsigned)q); f.y = w0 * bfhi((unsigned)p) + w1 * bfhi((unsigned)q);
                f.z = w0 * bflo((unsigned)(p >> 32)) + w1 * bflo((unsigned)(q >> 32)); f.w = w0 * bfhi((unsigned)(p >> 32)) + w1 * bfhi((unsigned)(q >> 32));
                v[j] = xc[j] * DN_ALPHA + f; s += (v[j].x + v[j].y) + (v[j].z + v[j].w);
            }
            const float mean = wave_sum(s) * (1.f / D); float s2 = 0.f;
#pragma unroll
            for (int j = 0; j < 4; ++j) { v[j] = v[j] - mean; s2 += (v[j].x * v[j].x + v[j].y * v[j].y) + (v[j].z * v[j].z + v[j].w * v[j].w); }
            const float rstd = 1.f / sqrtf(wave_sum(s2) * (1.f / D) + LN_EPS);
#pragma unroll
            for (int j = 0; j < 4; ++j) v[j] = v[j] * rstd * gbl[64 * j + lane] + gbl[256 + 64 * j + lane];
            f32x4* orow = (f32x4*)(xo + (size_t)m * D) + lane;
#pragma unroll
            for (int j = 0; j < 4; ++j) orow[64 * j] = v[j];
            if (has_next) { row_store_bf16(XB + (size_t)m * D, v, lane); row_bd_logits(v, wbd, bdl + (size_t)m * 8, lane); }
        }
    }
    __syncthreads();
}


template <class F> struct EpiP8 { static constexpr bool PERM = true, AFTER_DRAIN = false; F f;
    __device__ __forceinline__ void operator()(const f32x4 (&acc)[2][2][4][2], const pg8::Unit& u, int wr, int wc, int fr, int fq) const {
        const int row0 = u.pm * 256 + wr * 64 + fr, col0 = u.pn * 256 + wc * 32 + 8 * fq;
#pragma unroll
        for (int ai = 0; ai < 2; ++ai)
#pragma unroll
            for (int m = 0; m < 4; ++m)
#pragma unroll
                for (int bj = 0; bj < 2; ++bj) f(row0 + ai * 128 + m * 16, col0 + bj * 128, u.pn, acc[ai][bj][m][0], acc[ai][bj][m][1]);
    } };
template <class F> struct EpiPair { static constexpr bool PERM = true, AFTER_DRAIN = false; F f;
    __device__ __forceinline__ void operator()(const f32x4 (&acc)[2][2][4][2], const pg8::Unit& u, int wr, int wc, int fr, int fq) const {
        const int row0 = u.pm * 256 + wr * 64 + fr, col0 = u.pn * 256 + wc * 32 + 8 * fq;
#pragma unroll
        for (int ai = 0; ai < 2; ++ai)
#pragma unroll
            for (int m = 0; m < 4; ++m) f(row0 + ai * 128 + m * 16, col0, acc[ai][0][m][0], acc[ai][0][m][1], acc[ai][1][m][0], acc[ai][1][m][1]);
    } };
template <class F> struct EpiP4 { static constexpr bool PERM = false, AFTER_DRAIN = false; F f;
    __device__ __forceinline__ void operator()(const f32x4 (&acc)[2][2][4][2], const pg8::Unit& u, int wr, int wc, int fr, int fq) const {
        const int row0 = u.pm * 256 + wr * 64 + fr, col0 = u.pn * 256 + wc * 32 + 4 * fq;
#pragma unroll
        for (int ai = 0; ai < 2; ++ai)
#pragma unroll
            for (int m = 0; m < 4; ++m)
#pragma unroll
                for (int bj = 0; bj < 2; ++bj)
#pragma unroll
                    for (int n = 0; n < 2; ++n) f(row0 + ai * 128 + m * 16, col0 + bj * 128 + n * 16, acc[ai][bj][m][n]);
    } };
__device__ __forceinline__ u32x4 pack8(f32x4 a, f32x4 b) { u32x4 w; w.x = pg8::cvt_pk_bf16(a.x, a.y); w.y = pg8::cvt_pk_bf16(a.z, a.w); w.z = pg8::cvt_pk_bf16(b.x, b.y); w.w = pg8::cvt_pk_bf16(b.z, b.w); return w; }
__device__ __forceinline__ float fsig(float x) { return __builtin_amdgcn_rcpf(1.0f + __expf(-x)); }
struct F_Proj1 { unsigned char* ws;
    __device__ __forceinline__ void operator()(int row, int col, int pn, f32x4 a, f32x4 b) const {
        bf16_t* p;
        if (pn < 2) p = (bf16_t*)(ws + WS_QA) + (size_t)row * 512 + col;
        else if (pn < 4) p = (bf16_t*)(ws + WS_KA) + (size_t)row * 512 + (col - 512);
        else if (pn < 10) p = (bf16_t*)(ws + WS_QKVB) + (size_t)row * 1536 + (col - 1024);
        else if (pn < 12) p = (bf16_t*)(ws + WS_GATEB) + (size_t)row * 512 + (col - 2560);
        else p = (bf16_t*)(ws + WS_POOL) + (size_t)row * 512 + (col - 3072);
        *(u32x4*)p = pack8(a, b); } };
struct F_Bf16 { bf16_t* O; int ldc, cmask;
    __device__ __forceinline__ void operator()(int row, int col, int, f32x4 a, f32x4 b) const { *(u32x4*)(O + (size_t)row * ldc + (col & cmask)) = pack8(a, b); } };
struct F_Gates { bf16_t* O; const float* gb;
    __device__ __forceinline__ void operator()(int row, int col, int, f32x4 a, f32x4 b) const { const f32x4 b0 = *(const f32x4*)(gb + col), b1 = *(const f32x4*)(gb + col + 4);
        a = a + b0; b = b + b1; a.x = fsig(a.x); a.y = fsig(a.y); a.z = fsig(a.z); a.w = fsig(a.w); b.x = fsig(b.x); b.y = fsig(b.y); b.z = fsig(b.z); b.w = fsig(b.w);
        *(u32x4*)(O + (size_t)row * 3072 + col) = pack8(a, b); } };
template <int WHICH> struct F_Branch { bf16_t* Y; const bf16_t* gates;
    __device__ __forceinline__ void operator()(int row, int col, int, f32x4 a, f32x4 b) const {
        const u32x4 g = *(const u32x4*)(gates + (size_t)row * 3072 + WHICH * 1024 + col);
        a.x *= bflo(g.x); a.y *= bfhi(g.x); a.z *= bflo(g.y); a.w *= bfhi(g.y); b.x *= bflo(g.z); b.y *= bfhi(g.z); b.z *= bflo(g.w); b.w *= bfhi(g.w);
        bf16_t* yp = Y + (size_t)row * 1024 + col;
        if (WHICH > 0) { const u32x4 o = *(const u32x4*)yp; a.x += bflo(o.x); a.y += bfhi(o.x); a.z += bflo(o.y); a.w += bfhi(o.y); b.x += bflo(o.z); b.y += bfhi(o.z); b.z += bflo(o.w); b.w += bfhi(o.w); }
        *(u32x4*)yp = pack8(a, b); } };
struct F_F32 { float* O; int ldc;
    __device__ __forceinline__ void operator()(int row, int col, f32x4 v) const { *(f32x4*)(O + (size_t)row * ldc + col) = v; } };
struct F_Hdn { bf16_t* H;
    __device__ __forceinline__ void operator()(int row, int col, f32x4 a0, f32x4 a1, f32x4 b0, f32x4 b1) const {
        const int hc = ((col >> 8) & 3) * 128 + (col & 127);
        a0.x = a0.x * fsig(a0.x) * b0.x; a0.y = a0.y * fsig(a0.y) * b0.y; a0.z = a0.z * fsig(a0.z) * b0.z; a0.w = a0.w * fsig(a0.w) * b0.w;
        a1.x = a1.x * fsig(a1.x) * b1.x; a1.y = a1.y * fsig(a1.y) * b1.y; a1.z = a1.z * fsig(a1.z) * b1.z; a1.w = a1.w * fsig(a1.w) * b1.w;
        *(u32x4*)(H + (size_t)row * 512 + hc) = pack8(a0, a1); } };
struct MoeOrder { const LAS int* tab; int nunits, G, c;
    __device__ __forceinline__ bool next(int i, pg8::Unit& u) const { const int L = i * G + c; if (L >= nunits) return false; const int blk = L >> 2; u.pm = blk; u.pn = tab[blk] * 4 + (L & 3); return true; }
    __device__ __forceinline__ void a_ready(const pg8::Unit&) const {}
    __device__ __forceinline__ void done(const pg8::Unit&) const {} };
constexpr int LDS_TAB_OFF = 131072;

__device__ __forceinline__ void phase_g_proj1(const Args& a, LAS unsigned char* lds, int G, int c, int wave, int lane) {
    const bf16_t* XB = (const bf16_t*)(a.ws + WS_XB);
    { pg8::Gemm g{XB, (const bf16_t*)(a.ws + WS_WIN1), T, N1, 1024}; pg8::StaticOrder S; S.init(T, N1, G, c); EpiP8<F_Proj1> E{F_Proj1{a.ws}};
      pg8::gemm_phase<EpiP8<F_Proj1>, pg8::StaticOrder, true, true>(lds, g, S, E, wave, lane); }
    { pg8::Gemm g{(const bf16_t*)(a.ws + WS_WV), XB, 512, T, 1024}; pg8::StaticOrder S; S.init(512, T, G, c); EpiP8<F_Bf16> E{F_Bf16{(bf16_t*)(a.ws + WS_VT), T, 0x7fffffff}};
      pg8::gemm_phase<EpiP8<F_Bf16>, pg8::StaticOrder, true, true>(lds, g, S, E, wave, lane); }
}
__device__ __forceinline__ void phase_g_gates(const Args& a, LAS unsigned char* lds, int layer, int G, int c, int wave, int lane) {
    pg8::Gemm g{(const bf16_t*)(a.ws + WS_XB), (const bf16_t*)(a.ws + WS_WG), T, 3072, 1024}; pg8::StaticOrder S; S.init(T, 3072, G, c);
    EpiP8<F_Gates> E{F_Gates{(bf16_t*)(a.ws + WS_GATES), a.in[12] + (size_t)layer * 3072}};
    pg8::gemm_phase<EpiP8<F_Gates>, pg8::StaticOrder, true, true>(lds, g, S, E, wave, lane);
}
__device__ __forceinline__ void phase_g_branch(const Args& a, LAS unsigned char* lds, int G, int c, int wave, int lane) {
    bf16_t* Y = (bf16_t*)(a.ws + WS_Y); const bf16_t* gates = (const bf16_t*)(a.ws + WS_GATES); const bf16_t* W = (const bf16_t*)(a.ws + WS_WBR);
    pg8::StaticOrder S; S.init(T, 1024, G, c);
    { pg8::Gemm g{(const bf16_t*)(a.ws + WS_OA), W, T, 1024, 512}; EpiP8<F_Branch<0>> E{F_Branch<0>{Y, gates}}; pg8::gemm_phase<EpiP8<F_Branch<0>>, pg8::StaticOrder, true, true>(lds, g, S, E, wave, lane); }
    { pg8::Gemm g{(const bf16_t*)(a.ws + WS_OB), W + (size_t)1024 * 512, T, 1024, 512}; EpiP8<F_Branch<1>> E{F_Branch<1>{Y, gates}}; pg8::gemm_phase<EpiP8<F_Branch<1>>, pg8::StaticOrder, true, true>(lds, g, S, E, wave, lane); }
    { pg8::Gemm g{(const bf16_t*)(a.ws + WS_PLD), W + (size_t)2 * 1024 * 512, T, 1024, 512}; EpiP8<F_Branch<2>> E{F_Branch<2>{Y, gates}}; pg8::gemm_phase<EpiP8<F_Branch<2>>, pg8::StaticOrder, true, true>(lds, g, S, E, wave, lane); }
}
__device__ __forceinline__ void phase_g_out(const Args& a, LAS unsigned char* lds, int G, int c, int wave, int lane) {
    pg8::Gemm g{(const bf16_t*)(a.ws + WS_Y), (const bf16_t*)(a.ws + WS_WOUT), T, 1024, 1024}; pg8::StaticOrder S; S.init(T, 1024, G, c);
    EpiP8<F_Bf16> E{F_Bf16{(bf16_t*)(a.ws + WS_MIX), 1024, 0x7fffffff}};
    pg8::gemm_phase<EpiP8<F_Bf16>, pg8::StaticOrder, true, true>(lds, g, S, E, wave, lane);
}
__device__ __forceinline__ void moe_table(const Args& a, LAS unsigned char* lds, MoeOrder& S, int G, int c, int tid) {
    const int* blk_e = (const int*)(a.ws + WS_BLKE); LAS int* tab = (LAS int*)(lds + LDS_TAB_OFF);
    const int nblk = blk_e[1023];
    for (int i = tid; i < nblk; i += NTHR) tab[i] = blk_e[i];
    __syncthreads();
    S.tab = tab; S.nunits = nblk * 4; S.G = G; S.c = c;
}
__device__ __forceinline__ void phase_moe1(const Args& a, LAS unsigned char* lds, int G, int c, int tid, int wave, int lane) {
    MoeOrder S; moe_table(a, lds, S, G, c, tid);
    pg8::Gemm g{(const bf16_t*)(a.ws + WS_XG), (const bf16_t*)(a.ws + WS_W13), CAP, NEXP * 1024, 1024};
    EpiPair<F_Hdn> E{F_Hdn{(bf16_t*)(a.ws + WS_HDN)}};
    pg8::gemm_phase<EpiPair<F_Hdn>, MoeOrder, true, true>(lds, g, S, E, wave, lane);
}
__device__ __forceinline__ void phase_moe2(const Args& a, LAS unsigned char* lds, int G, int c, int tid, int wave, int lane) {
    MoeOrder S; moe_table(a, lds, S, G, c, tid);
    pg8::Gemm g{(const bf16_t*)(a.ws + WS_HDN), (const bf16_t*)(a.ws + WS_W2), CAP, NEXP * 1024, 512};
    EpiP8<F_Bf16> E{F_Bf16{(bf16_t*)(a.ws + WS_YMOE), 1024, 1023}};
    pg8::gemm_phase<EpiP8<F_Bf16>, MoeOrder, true, true>(lds, g, S, E, wave, lane);
}


__device__ __forceinline__ void attn_stage_bias(const Args& a, LAS unsigned char* lds, int layer, int tid) {
    LAS float* rb = (LAS float*)lds;
    const float* relb = a.in[2] + (size_t)layer * A_HEADS * A_NREL;
    for (int i = tid; i < A_HEADS * 384; i += NTHR) { const int hh = i / 384, j = i % 384; rb[i] = relb[hh * A_NREL + (j < A_NREL - 1 ? j : A_NREL - 1)] * 1.4426950408889634f; }
    __syncthreads();
}
__device__ __forceinline__ void attn_item(const Args& a, const LAS float* rb, int item, int lane) {
    const bf16_t* qA = (const bf16_t*)(a.ws + WS_QA); const bf16_t* kA = (const bf16_t*)(a.ws + WS_KA); const bf16_t* vT = (const bf16_t*)(a.ws + WS_VT); bf16_t* oA = (bf16_t*)(a.ws + WS_OA);
    const int fr = lane & 15, fq = lane >> 4;
    const int hq = item & 1, ci = (item >> 1) & 31, h = (item >> 6) & 7, b = item >> 9;
    const size_t tokq = (size_t)b * SEQ + ci * 64 + hq * 32;
    bf16x8 Bq[2][2];
#pragma unroll
    for (int qt = 0; qt < 2; ++qt)
#pragma unroll
        for (int ks = 0; ks < 2; ++ks) Bq[qt][ks] = *(const bf16x8*)(qA + (tokq + qt * 16 + fr) * 512 + h * 64 + ks * 32 + 8 * fq);
    f32x4 O[4][2];
#pragma unroll
    for (int dt = 0; dt < 4; ++dt) { O[dt][0] = (f32x4){0.f, 0.f, 0.f, 0.f}; O[dt][1] = (f32x4){0.f, 0.f, 0.f, 0.f}; }
    float mrun[2] = {-1.0e30f, -1.0e30f}, lrun[2] = {0.f, 0.f};
    const LAS float* rbh = rb + h * A_NREL;
    const float SC = 0.125f * 1.4426950408889634f;
    const int kc_lo = ci >= 8 ? ci - 8 : 0;
    for (int kc = kc_lo; kc <= ci; ++kc) {
        const int t = ci - kc;
        const size_t tokk = (size_t)b * SEQ + kc * 64;
        f32x4 S[4][2];
#pragma unroll
        for (int kt = 0; kt < 4; ++kt) {
            const bf16_t* kp = kA + (tokk + kt * 16 + fr) * 512 + h * 64 + 8 * fq;
            const bf16x8 Ak0 = *(const bf16x8*)kp, Ak1 = *(const bf16x8*)(kp + 32);
#pragma unroll
            for (int qt = 0; qt < 2; ++qt) {
                f32x4 z = (f32x4){0.f, 0.f, 0.f, 0.f};
                z = __builtin_amdgcn_mfma_f32_16x16x32_bf16(Ak0, Bq[qt][0], z, 0, 0, 0);
                S[kt][qt] = __builtin_amdgcn_mfma_f32_16x16x32_bf16(Ak1, Bq[qt][1], z, 0, 0, 0);
            }
        }
        if (t >= 5) {
            const float cb = rbh[319];
#pragma unroll
            for (int kt = 0; kt < 4; ++kt)
#pragma unroll
                for (int qt = 0; qt < 2; ++qt) S[kt][qt] = S[kt][qt] * SC + cb;
        } else {
#pragma unroll
            for (int kt = 0; kt < 4; ++kt)
#pragma unroll
                for (int qt = 0; qt < 2; ++qt)
#pragma unroll
                    for (int r = 0; r < 4; ++r) {
                        int dist = (hq * 32 + qt * 16 + fr) - (kt * 16 + 4 * fq + r) + 64 * t; dist = dist > A_CLIP ? A_CLIP : dist;
                        S[kt][qt][r] = S[kt][qt][r] * SC + rbh[dist + 63];
                    }
        }
#pragma unroll
        for (int qt = 0; qt < 2; ++qt) {
            float mx = S[0][qt][0];
#pragma unroll
            for (int kt = 0; kt < 4; ++kt)
#pragma unroll
                for (int r = 0; r < 4; ++r) mx = fmaxf(mx, S[kt][qt][r]);
            mx = fmaxf(mx, __shfl_xor(mx, 16)); mx = fmaxf(mx, __shfl_xor(mx, 32));
            const float mn = fmaxf(mrun[qt], mx), al = __builtin_amdgcn_exp2f(mrun[qt] - mn); mrun[qt] = mn;
            float ps = 0.f;
#pragma unroll
            for (int kt = 0; kt < 4; ++kt)
#pragma unroll
                for (int r = 0; r < 4; ++r) { const float p = __builtin_amdgcn_exp2f(S[kt][qt][r] - mn); S[kt][qt][r] = p; ps += p; }
            lrun[qt] = lrun[qt] * al + ps;
#pragma unroll
            for (int dt = 0; dt < 4; ++dt) O[dt][qt] = O[dt][qt] * al;
        }
        bf16x8 Bp[2][2];
#pragma unroll
        for (int qt = 0; qt < 2; ++qt)
#pragma unroll
            for (int s2 = 0; s2 < 2; ++s2) { const u32x4 w = pack8(S[2 * s2][qt], S[2 * s2 + 1][qt]); Bp[qt][s2] = __builtin_bit_cast(bf16x8, w); }
#pragma unroll
        for (int dt = 0; dt < 4; ++dt)
#pragma unroll
            for (int s2 = 0; s2 < 2; ++s2) {
                const bf16_t* vp = vT + (size_t)(h * 64 + dt * 16 + fr) * T + tokk + 32 * s2 + 4 * fq;
                const u32x2 lo = *(const u32x2*)vp, hi = *(const u32x2*)(vp + 16);
                const u32x4 w = {lo.x, lo.y, hi.x, hi.y}; const bf16x8 Av = __builtin_bit_cast(bf16x8, w);
#pragma unroll
                for (int qt = 0; qt < 2; ++qt) O[dt][qt] = __builtin_amdgcn_mfma_f32_16x16x32_bf16(Av, Bp[qt][s2], O[dt][qt], 0, 0, 0);
            }
    }
#pragma unroll
    for (int qt = 0; qt < 2; ++qt) {
        float l = lrun[qt]; l += __shfl_xor(l, 16); l += __shfl_xor(l, 32);
        const float inv = 1.0f / l;
#pragma unroll
        for (int dt = 0; dt < 4; ++dt) {
            const f32x4 o = O[dt][qt] * inv; u32x2 w; w.x = pg8::cvt_pk_bf16(o.x, o.y); w.y = pg8::cvt_pk_bf16(o.z, o.w);
            *(u32x2*)(oA + (tokq + qt * 16 + fr) * 512 + h * 64 + dt * 16 + 4 * fq) = w;
        }
    }
}
constexpr int AT_KV = 16384, AT_PITCH = 144, AT_TILE = 64 * AT_PITCH, AT_BUF = 2 * AT_TILE;
static_assert(AT_KV + 4 * AT_BUF <= 131072, "attention LDS map");
__device__ __forceinline__ void attn_group(const Args& a, LAS unsigned char* lds, const LAS float* rb, int grp, int wave, int lane, int tid) {
    const bf16_t* qA = (const bf16_t*)(a.ws + WS_QA); const bf16_t* kA = (const bf16_t*)(a.ws + WS_KA); const bf16_t* vT = (const bf16_t*)(a.ws + WS_VT); bf16_t* oA = (bf16_t*)(a.ws + WS_OA);
    const int fr = lane & 15, fq = lane >> 4;
    const int cg = grp & 7, h = (grp >> 3) & 7, b = grp >> 6;
    const int ci = cg * 4 + (wave >> 1), hq = wave & 1;
    const size_t tokq = (size_t)b * SEQ + ci * 64 + hq * 32;
    bf16x8 Bq[2][2];
#pragma unroll
    for (int qt = 0; qt < 2; ++qt)
#pragma unroll
        for (int ks = 0; ks < 2; ++ks) Bq[qt][ks] = *(const bf16x8*)(qA + (tokq + qt * 16 + fr) * 512 + h * 64 + ks * 32 + 8 * fq);
    f32x4 O[4][2];
#pragma unroll
    for (int dt = 0; dt < 4; ++dt) { O[dt][0] = (f32x4){0.f, 0.f, 0.f, 0.f}; O[dt][1] = (f32x4){0.f, 0.f, 0.f, 0.f}; }
    float mrun[2] = {-1.0e30f, -1.0e30f}, lrun[2] = {0.f, 0.f};
    const LAS float* rbh = rb + h * 384;
    const float SC = 0.125f * 1.4426950408889634f;
    const int kc_first = (cg * 4 >= 8) ? cg * 4 - 8 : 0, kc_last = cg * 4 + 3;
    const int srow = tid >> 3, sch = tid & 7;
    const bf16_t* kg = kA + ((size_t)b * SEQ + srow) * 512 + h * 64 + sch * 8;
    const bf16_t* vg = vT + (size_t)(h * 64 + srow) * T + (size_t)b * SEQ + sch * 8;
    const int sdst = AT_KV + srow * AT_PITCH + sch * 16;
    for (int k0 = kc_first; k0 <= kc_last; k0 += 4) {
        {
            u32x4 kr[4], vr[4];
#pragma unroll
            for (int j = 0; j < 4; ++j) { kr[j] = *(const u32x4*)(kg + (size_t)(k0 + j) * 64 * 512); vr[j] = *(const u32x4*)(vg + (size_t)(k0 + j) * 64); }
#pragma unroll
            for (int j = 0; j < 4; ++j) { *(LAS u32x4*)(lds + sdst + j * AT_BUF) = kr[j]; *(LAS u32x4*)(lds + sdst + j * AT_BUF + AT_TILE) = vr[j]; }
        }
        __syncthreads();
#pragma unroll 1
        for (int j = 0; j < 4; ++j) {
        const int kc = k0 + j, t = ci - kc;
        const int kbase = AT_KV + j * AT_BUF, vbase = kbase + AT_TILE;
        if (t >= 0 && t <= 8) {
            f32x4 S[4][2];
#pragma unroll
            for (int kt = 0; kt < 4; ++kt) {
                const bf16x8 Ak0 = *(const LAS bf16x8*)(lds + kbase + (kt * 16 + fr) * AT_PITCH + fq * 16), Ak1 = *(const LAS bf16x8*)(lds + kbase + (kt * 16 + fr) * AT_PITCH + 64 + fq * 16);
#pragma unroll
                for (int qt = 0; qt < 2; ++qt) {
                    f32x4 z = (f32x4){0.f, 0.f, 0.f, 0.f};
                    z = __builtin_amdgcn_mfma_f32_16x16x32_bf16(Ak0, Bq[qt][0], z, 0, 0, 0);
                    S[kt][qt] = __builtin_amdgcn_mfma_f32_16x16x32_bf16(Ak1, Bq[qt][1], z, 0, 0, 0);
                }
            }
            if (t >= 5) {
                const float cb = rbh[319];
#pragma unroll
                for (int kt = 0; kt < 4; ++kt)
#pragma unroll
                    for (int qt = 0; qt < 2; ++qt) S[kt][qt] = S[kt][qt] * SC + cb;
            } else {
                int bi = hq * 32 + fr - 4 * fq + 64 * t + 12; asm volatile("" : "+v"(bi));
                const LAS float* pb = rbh + bi;
#pragma unroll
                for (int kt = 0; kt < 4; ++kt)
#pragma unroll
                    for (int qt = 0; qt < 2; ++qt) {
                        const f32x4 b4 = {pb[51 + 16 * qt - 16 * kt], pb[50 + 16 * qt - 16 * kt], pb[49 + 16 * qt - 16 * kt], pb[48 + 16 * qt - 16 * kt]};
                        S[kt][qt] = S[kt][qt] * SC + b4;
                    }
            }
#pragma unroll
            for (int qt = 0; qt < 2; ++qt) {
                const f32x4 m4 = __builtin_elementwise_max(__builtin_elementwise_max(S[0][qt], S[1][qt]), __builtin_elementwise_max(S[2][qt], S[3][qt]));
                float mx = fmaxf(fmaxf(m4.x, m4.y), fmaxf(m4.z, m4.w));
                mx = fmaxf(mx, __shfl_xor(mx, 16)); mx = fmaxf(mx, __shfl_xor(mx, 32));
                const float mn = fmaxf(mrun[qt], mx), al = __builtin_amdgcn_exp2f(mrun[qt] - mn); mrun[qt] = mn;
                f32x4 ps4 = {0.f, 0.f, 0.f, 0.f};
#pragma unroll
                for (int kt = 0; kt < 4; ++kt) { f32x4 d = S[kt][qt] - mn; d.x = __builtin_amdgcn_exp2f(d.x); d.y = __builtin_amdgcn_exp2f(d.y); d.z = __builtin_amdgcn_exp2f(d.z); d.w = __builtin_amdgcn_exp2f(d.w); S[kt][qt] = d; ps4 = ps4 + d; }
                lrun[qt] = lrun[qt] * al + ((ps4.x + ps4.y) + (ps4.z + ps4.w));
#pragma unroll
                for (int dt = 0; dt < 4; ++dt) O[dt][qt] = O[dt][qt] * al;
            }
            bf16x8 Bp[2][2];
#pragma unroll
            for (int qt = 0; qt < 2; ++qt)
#pragma unroll
                for (int s2 = 0; s2 < 2; ++s2) { const u32x4 w = pack8(S[2 * s2][qt], S[2 * s2 + 1][qt]); Bp[qt][s2] = __builtin_bit_cast(bf16x8, w); }
#pragma unroll
            for (int dt = 0; dt < 4; ++dt)
#pragma unroll
                for (int s2 = 0; s2 < 2; ++s2) {
                    const LAS unsigned char* vp = lds + vbase + (dt * 16 + fr) * AT_PITCH + (32 * s2 + 4 * fq) * 2;
                    const u32x2 lo = *(const LAS u32x2*)vp, hi = *(const LAS u32x2*)(vp + 32);
                    const u32x4 w = {lo.x, lo.y, hi.x, hi.y}; const bf16x8 Av = __builtin_bit_cast(bf16x8, w);
#pragma unroll
                    for (int qt = 0; qt < 2; ++qt) O[dt][qt] = __builtin_amdgcn_mfma_f32_16x16x32_bf16(Av, Bp[qt][s2], O[dt][qt], 0, 0, 0);
                }
        }
        }
        __syncthreads();
    }
#pragma unroll
    for (int qt = 0; qt < 2; ++qt) {
        float l = lrun[qt]; l += __shfl_xor(l, 16); l += __shfl_xor(l, 32);
        const float inv = 1.0f / l;
#pragma unroll
        for (int dt = 0; dt < 4; ++dt) {
            const f32x4 o = O[dt][qt] * inv; u32x2 w; w.x = pg8::cvt_pk_bf16(o.x, o.y); w.y = pg8::cvt_pk_bf16(o.z, o.w);
            *(u32x2*)(oA + (tokq + qt * 16 + fr) * 512 + h * 64 + dt * 16 + 4 * fq) = w;
        }
    }
}
__device__ __forceinline__ void phase_attn(const Args& a, LAS unsigned char* lds, int layer, int wave, int lane, int tid, int G) {
    attn_stage_bias(a, lds, layer, tid);
    const LAS float* rb = (const LAS float*)lds;
    constexpr int NGRP = BATCH * A_HEADS * NCH / 4;
    const int per = (NGRP + G - 1) / G;
    for (int gi = 0; gi < per; ++gi) {
        const int grp = blockIdx.x * per + gi; if (grp >= NGRP) break;
        attn_item(a, rb, grp * 8 + wave, lane);
    }
    __syncthreads();
}


constexpr int PKR = 272, PKT = 144;
constexpr int G1_KR = 0, G1_LB = 4 * 64 * PKR, G1_CW = G1_LB + 65536, G1_GB = G1_CW + 8192, G1_BB = G1_GB + 1024, G1_GC = G1_BB + 1024, G1_END = G1_GC + 1024;
constexpr int G2_KR = 0, G2_QS = 17408, G2_KT = 34816, G2_VT = 53248, G2_VN = 71680, G2_QK = 90112, G2_ST = 99328, G2_CW = 134144, G2_SM = 140288, G2_WN = G2_SM + 2048, G2_END = G2_WN + 17408;
static_assert(G1_END <= LDS_BYTES - 16 && G2_END <= LDS_BYTES - 16, "gdn LDS maps");
#define MFMA16(a_, b_, c_) __builtin_amdgcn_mfma_f32_16x16x32_bf16((a_), (b_), (c_), 0, 0, 0)
#define LDSF(off) (*(const LAS bf16x8*)(lds + (off)))

__device__ __forceinline__ void gdn_pre_stage(const Args& a, LAS unsigned char* lds, int layer, int tid) {
    LAS float* cw = (LAS float*)(lds + G1_CW);
    const float* cwg = a.in[3] + (size_t)layer * 4 * 1536;
    for (int i = tid; i < 4 * 512; i += NTHR) cw[i] = cwg[(i >> 9) * 1536 + 512 + (i & 511)];
    __syncthreads();
}
__device__ __forceinline__ void gdn_pre_item(const Args& a, LAS unsigned char* lds, int layer, int item, int wave, int lane, int tid) {
    const int b = item >> 5, n = item & 31;
    const bf16_t* qkvB = (const bf16_t*)(a.ws + WS_QKVB); const float* bdl = (const float*)(a.ws + WS_BDL); float* gcg = (float*)(a.ws + WS_GC);
    const LAS float* cw = (const LAS float*)(lds + G1_CW); LAS float* gb = (LAS float*)(lds + G1_GB); LAS float* bb = (LAS float*)(lds + G1_BB); LAS float* gcb = (LAS float*)(lds + G1_GC);
    {
        const int tk = tid >> 3, cgp = tid & 7, hh = cgp >> 1, half = cgp & 1;
        const int tl = n * 64 + tk; const size_t r = (size_t)b * SEQ + tl;
        const int cbase = hh * 128 + half * 64;
        float kv[64];
#pragma unroll
        for (int c = 0; c < 64; ++c) kv[c] = 0.f;
#pragma unroll
        for (int i = 0; i < 4; ++i) {
            if (tl - 3 + i >= 0) {
                const u32x4* src = (const u32x4*)(qkvB + (r - 3 + i) * 1536 + 512 + cbase);
#pragma unroll
                for (int q = 0; q < 8; ++q) { const u32x4 w = src[q]; const LAS float* wp = cw + i * 512 + cbase + 8 * q;
                    const f32x4 w0 = *(const LAS f32x4*)wp, w1 = *(const LAS f32x4*)(wp + 4);
                    kv[8 * q + 0] += w0.x * bflo(w.x); kv[8 * q + 1] += w0.y * bfhi(w.x); kv[8 * q + 2] += w0.z * bflo(w.y); kv[8 * q + 3] += w0.w * bfhi(w.y);
                    kv[8 * q + 4] += w1.x * bflo(w.z); kv[8 * q + 5] += w1.y * bfhi(w.z); kv[8 * q + 6] += w1.z * bflo(w.w); kv[8 * q + 7] += w1.w * bfhi(w.w); }
            }
            asm volatile("" ::: "memory");
        }
        float ss = 0.f;
#pragma unroll
        for (int c = 0; c < 64; ++c) { kv[c] = siluf_(kv[c]); ss += kv[c] * kv[c]; }
        ss += __shfl_xor(ss, 1);
        const float rk = rsqrtf(ss + RMS_EPS);
        LAS unsigned char* dst = lds + G1_KR + hh * (64 * PKR) + tk * PKR + half * 128;
#pragma unroll
        for (int q = 0; q < 8; ++q) { f32x4 x0 = {kv[8 * q] * rk, kv[8 * q + 1] * rk, kv[8 * q + 2] * rk, kv[8 * q + 3] * rk}, x1 = {kv[8 * q + 4] * rk, kv[8 * q + 5] * rk, kv[8 * q + 6] * rk, kv[8 * q + 7] * rk};
            *(LAS u32x4*)(dst + 16 * q) = pack8(x0, x1); }
        if (half == 0) {
            const float Aexp = expf(a.in[4][layer * 4 + hh]), dtb = a.in[5][layer * 4 + hh];
            bb[hh * 64 + tk] = sigmoidf_(bdl[r * 8 + hh]);
            gb[hh * 64 + tk] = -Aexp * softplusf_(bdl[r * 8 + 4 + hh] + dtb);
        }
    }
    __syncthreads();
    {
        const int hh = wave >> 1, fr = lane & 15, fq = lane >> 4;
        float g = gb[hh * 64 + lane];
#pragma unroll
        for (int o = 1; o < 64; o <<= 1) { const float t = __shfl_up(g, o); if (lane >= o) g += t; }
        gcb[hh * 64 + lane] = g;
        if ((wave & 1) == 0) gcg[((size_t)b * SEQ + n * 64 + lane) * 4 + hh] = g;
        asm volatile("s_waitcnt lgkmcnt(0)" ::: "memory");
        const int kr = G1_KR + hh * (64 * PKR);
        LAS float* Lb = (LAS float*)(lds + G1_LB) + hh * 4096;
#pragma unroll
        for (int tt = 0; tt < 2; ++tt) {
            const int ti = 2 * (wave & 1) + tt;
            bf16x8 Af[4];
#pragma unroll
            for (int ks = 0; ks < 4; ++ks) Af[ks] = LDSF(kr + (ti * 16 + fr) * PKR + ks * 64 + fq * 16);
#pragma unroll
            for (int tj = 0; tj < 4; ++tj) {
                f32x4 acc = {0.f, 0.f, 0.f, 0.f};
                if (tj <= ti) {
#pragma unroll
                    for (int ks = 0; ks < 4; ++ks) acc = MFMA16(Af[ks], LDSF(kr + (tj * 16 + fr) * PKR + ks * 64 + fq * 16), acc);
                }
                const int j = tj * 16 + fr; const float gcj = gcb[hh * 64 + j];
#pragma unroll
                for (int rg = 0; rg < 4; ++rg) { const int i = ti * 16 + 4 * fq + rg;
                    Lb[i * 64 + j] = (i > j) ? bb[hh * 64 + i] * acc[rg] * __expf(gcb[hh * 64 + i] - gcj) : 0.f; }
            }
        }
    }
    __syncthreads();
    if (wave < 4) {
        const int hh = wave; const LAS float* Lb = (const LAS float*)(lds + G1_LB) + hh * 4096;
        float Tc[64];
        int ln = lane; asm volatile("" : "+v"(ln));
#pragma unroll
        for (int i = 0; i < 64; ++i) {
            float acc = (ln == i) ? 1.f : 0.f;
#pragma unroll
            for (int j4 = 0; j4 < (i + 3) / 4; ++j4) { const f32x4 l4 = *(const LAS f32x4*)(Lb + i * 64 + 4 * j4);
                if (4 * j4 + 0 < i) acc -= l4.x * Tc[4 * j4 + 0];
                if (4 * j4 + 1 < i) acc -= l4.y * Tc[4 * j4 + 1];
                if (4 * j4 + 2 < i) acc -= l4.z * Tc[4 * j4 + 2];
                if (4 * j4 + 3 < i) acc -= l4.w * Tc[4 * j4 + 3]; }
            Tc[i] = acc;
            if ((i & 3) == 3) asm volatile("" ::: "memory");
        }
        const float bc = bb[hh * 64 + lane], ec = bc * __expf(gcb[hh * 64 + lane]);
        bf16_t* tu = (bf16_t*)(a.ws + WS_TMU) + ((size_t)item * 4 + hh) * 4096; bf16_t* tw = (bf16_t*)(a.ws + WS_TMW) + ((size_t)item * 4 + hh) * 4096;
#pragma unroll
        for (int i = 0; i < 64; ++i) { tu[i * 64 + lane] = (bf16_t)f2bf(Tc[i] * bc); tw[i * 64 + lane] = (bf16_t)f2bf(Tc[i] * ec); }
    }
    __syncthreads();
}

__device__ __forceinline__ void st8(LAS unsigned char* p, f32x4 v) { u32x2 w; w.x = pg8::cvt_pk_bf16(v.x, v.y); w.y = pg8::cvt_pk_bf16(v.z, v.w); *(LAS u32x2*)p = w; }

__device__ __forceinline__ void gdn_scan_item(const Args& a, LAS unsigned char* lds, int layer, int item, int wave, int lane, int tid) {
    asm volatile("" : "+v"(tid), "+v"(lane));
    const int b = item >> 2, h = item & 3; int fr = lane & 15, fq = lane >> 4;
#define RELANE() asm volatile("" : "+v"(fr), "+v"(fq))
    const bf16_t* qkvB = (const bf16_t*)(a.ws + WS_QKVB); const float* bdl = (const float*)(a.ws + WS_BDL); const float* gcg = (const float*)(a.ws + WS_GC);
    const bf16_t* gateB = (const bf16_t*)(a.ws + WS_GATEB);
    bf16_t* oB = (bf16_t*)(a.ws + WS_OB);
    LAS float* cwl = (LAS float*)(lds + G2_CW);
    LAS float* gcs = (LAS float*)(lds + G2_SM); LAS float* egc = gcs + 64; LAS float* ekd = gcs + 128; LAS float* ng = gcs + 192; LAS float* red = gcs + 320;
    {
        const float* cwg = a.in[3] + (size_t)layer * 4 * 1536;
        for (int i = tid; i < 4 * 384; i += NTHR) { const int tap = i / 384, rem = i % 384, seg = rem >> 7, c = rem & 127; cwl[i] = cwg[tap * 1536 + seg * 512 + h * 128 + c]; }
        for (int i = tid; i < 128; i += NTHR) ng[i] = a.in[6][layer * 128 + i];
        for (int i = tid; i < 34816 / 16; i += NTHR) ((LAS u32x4*)(lds + G2_ST))[i] = (u32x4){0u, 0u, 0u, 0u};
    }
    f32x4 Sacc[8];
#pragma unroll
    for (int i = 0; i < 8; ++i) Sacc[i] = (f32x4){0.f, 0.f, 0.f, 0.f};
    __syncthreads();
#define G2_LBAR() asm volatile("s_waitcnt lgkmcnt(0)\n\ts_barrier" ::: "memory")
    for (int n = 0; n < NCH; ++n) {
        const size_t tok0 = (size_t)b * SEQ + n * 64;
        int zv_ = 0; asm volatile("" : "+v"(zv_));
        const float gcl = gcg[(tok0 + 63) * 4 + h + zv_];
        {
            asm volatile("" : "+v"(tid));
            const int tk = tid >> 3, cgp = tid & 7, c0 = cgp * 16;
            const int tl = n * 64 + tk; const size_t r = tok0 + tk;
            const LAS float* cwv = cwl; asm volatile("" : "+v"(cwv));
            const bf16_t* qkvb_it = qkvB + (size_t)tok0 * 1536 + h * 128;
            int rowo[4]; float vm[4];
#pragma unroll
            for (int i = 0; i < 4; ++i) { const bool ok = (tl - 3 + i >= 0); rowo[i] = (ok ? (tk - 3 + i) : tk) * 1536 + c0; vm[i] = ok ? 1.f : 0.f; }
#define rowp_(i) (qkvb_it + rowo[i])
#define G2_ACC16(d, x0, x1, wp, vm_) do { const f32x4 w0 = *(const LAS f32x4*)(wp) * (vm_), w1 = *(const LAS f32x4*)((wp) + 4) * (vm_), w2 = *(const LAS f32x4*)((wp) + 8) * (vm_), w3 = *(const LAS f32x4*)((wp) + 12) * (vm_); \
                d[0] += w0.x * bflo(x0.x); d[1] += w0.y * bfhi(x0.x); d[2] += w0.z * bflo(x0.y); d[3] += w0.w * bfhi(x0.y); d[4] += w1.x * bflo(x0.z); d[5] += w1.y * bfhi(x0.z); d[6] += w1.z * bflo(x0.w); d[7] += w1.w * bfhi(x0.w); \
                d[8] += w2.x * bflo(x1.x); d[9] += w2.y * bfhi(x1.x); d[10] += w2.z * bflo(x1.y); d[11] += w2.w * bfhi(x1.y); d[12] += w3.x * bflo(x1.z); d[13] += w3.y * bfhi(x1.z); d[14] += w3.z * bflo(x1.w); d[15] += w3.w * bfhi(x1.w); } while (0)
            u32x4 rw[4][2];
#define G2_LOAD8(segoff) do { _Pragma("unroll") for (int i = 0; i < 4; ++i) { rw[i][0] = *(const u32x4*)(rowp_(i) + (segoff)); rw[i][1] = *(const u32x4*)(rowp_(i) + (segoff) + 8); } } while (0)
            const int odd = tk & 1;
            const float gc = gcg[r * 4 + h];
            G2_LOAD8(0);
            {
                float q[16];
#pragma unroll
                for (int c = 0; c < 16; ++c) q[c] = 0.f;
#pragma unroll
                for (int i = 0; i < 4; ++i) G2_ACC16(q, rw[i][0], rw[i][1], cwv + i * 384 + c0, vm[i]);
                G2_LOAD8(512);
                float sq = 0.f;
#pragma unroll
                for (int c = 0; c < 16; ++c) { q[c] = siluf_(q[c]); sq += q[c] * q[c]; }
                sq += __shfl_xor(sq, 1); sq += __shfl_xor(sq, 2); sq += __shfl_xor(sq, 4);
                const float rq_ = rsqrtf(sq + RMS_EPS) * 0.08838834764831845f;
                f32x4 a0 = {q[0] * rq_, q[1] * rq_, q[2] * rq_, q[3] * rq_}, a1 = {q[4] * rq_, q[5] * rq_, q[6] * rq_, q[7] * rq_}, a2 = {q[8] * rq_, q[9] * rq_, q[10] * rq_, q[11] * rq_}, a3 = {q[12] * rq_, q[13] * rq_, q[14] * rq_, q[15] * rq_};
                *(LAS u32x4*)(lds + G2_QS + tk * PKR + c0 * 2) = pack8(a0, a1); *(LAS u32x4*)(lds + G2_QS + tk * PKR + c0 * 2 + 16) = pack8(a2, a3);
            }
            {
                float k[16];
#pragma unroll
                for (int c = 0; c < 16; ++c) k[c] = 0.f;
#pragma unroll
                for (int i = 0; i < 4; ++i) G2_ACC16(k, rw[i][0], rw[i][1], cwv + i * 384 + 128 + c0, vm[i]);
                G2_LOAD8(1024);
                float sk = 0.f;
#pragma unroll
                for (int c = 0; c < 16; ++c) { k[c] = siluf_(k[c]); sk += k[c] * k[c]; }
                sk += __shfl_xor(sk, 1); sk += __shfl_xor(sk, 2); sk += __shfl_xor(sk, 4);
                const float rk_ = rsqrtf(sk + RMS_EPS);
                unsigned kb[8];
#pragma unroll
                for (int c = 0; c < 8; ++c) kb[c] = pg8::cvt_pk_bf16(k[2 * c] * rk_, k[2 * c + 1] * rk_);
                *(LAS u32x4*)(lds + G2_KR + tk * PKR + c0 * 2) = (u32x4){kb[0], kb[1], kb[2], kb[3]}; *(LAS u32x4*)(lds + G2_KR + tk * PKR + c0 * 2 + 16) = (u32x4){kb[4], kb[5], kb[6], kb[7]};
#pragma unroll
                for (int c = 0; c < 8; ++c) {
                    const unsigned pk_ = (unsigned)__shfl_xor((int)kb[c], 8);
                    const unsigned wk = odd ? ((pk_ >> 16) | (kb[c] & 0xffff0000u)) : ((kb[c] & 0xffffu) | (pk_ << 16));
                    *(LAS unsigned*)(lds + G2_KT + (c0 + 2 * c + odd) * PKT + (tk & ~1) * 2) = wk;
                }
            }
            {
                float v[16];
#pragma unroll
                for (int c = 0; c < 16; ++c) v[c] = 0.f;
#pragma unroll
                for (int i = 0; i < 4; ++i) G2_ACC16(v, rw[i][0], rw[i][1], cwv + i * 384 + 256 + c0, vm[i]);
#pragma unroll
                for (int c = 0; c < 8; ++c) {
                    const unsigned vb = pg8::cvt_pk_bf16(siluf_(v[2 * c]), siluf_(v[2 * c + 1]));
                    const unsigned pv_ = (unsigned)__shfl_xor((int)vb, 8);
                    const unsigned wv = odd ? ((pv_ >> 16) | (vb & 0xffff0000u)) : ((vb & 0xffffu) | (pv_ << 16));
                    *(LAS unsigned*)(lds + G2_VT + (c0 + 2 * c + odd) * PKT + (tk & ~1) * 2) = wv;
                }
            }
#undef G2_LOAD8
#undef G2_ACC16
#undef rowp_
            if (cgp == 0) { gcs[tk] = gc; egc[tk] = __expf(gc); ekd[tk] = __expf(gcl - gc); }
        }
        const float gl = __expf(gcl);
        const bf16_t* tmu = (const bf16_t*)(a.ws + WS_TMU) + (((size_t)(b * 32 + n)) * 4 + h) * 4096; const bf16_t* tmw = (const bf16_t*)(a.ws + WS_TMW) + (((size_t)(b * 32 + n)) * 4 + h) * 4096;
        RELANE();
        bf16x8 TW[4][2];
#pragma unroll
        for (int it = 0; it < 4; ++it) { TW[it][0] = *(const bf16x8*)(tmw + (it * 16 + fr) * 64 + 8 * fq); TW[it][1] = *(const bf16x8*)(tmw + (it * 16 + fr) * 64 + 32 + 8 * fq); }
        G2_LBAR();
        RELANE();
        {
            const int tj = wave & 3;
#pragma unroll
            for (int tt = 0; tt < 2; ++tt) {
                const int ti = 2 * (wave >> 2) + tt;
                f32x4 acc = {0.f, 0.f, 0.f, 0.f};
                if (ti >= tj) {
#pragma unroll
                    for (int ks = 0; ks < 4; ++ks) acc = MFMA16(LDSF(G2_KR + (tj * 16 + fr) * PKR + ks * 64 + fq * 16), LDSF(G2_QS + (ti * 16 + fr) * PKR + ks * 64 + fq * 16), acc);
                }
                const int i = ti * 16 + fr; const float gci = gcs[i];
                f32x4 o;
#pragma unroll
                for (int rg = 0; rg < 4; ++rg) { const int j = tj * 16 + 4 * fq + rg; o[rg] = (i >= j) ? acc[rg] * __expf(gci - gcs[j]) : 0.f; }
                st8(lds + G2_QK + i * PKT + (tj * 16 + 4 * fq) * 2, o);
            }
        }
        RELANE();
        {
            const bf16x8 A0 = LDSF(G2_KT + (wave * 16 + fr) * PKT + fq * 16), A1 = LDSF(G2_KT + (wave * 16 + fr) * PKT + 64 + fq * 16);
#pragma unroll
            for (int it = 0; it < 4; ++it) {
                f32x4 acc = {0.f, 0.f, 0.f, 0.f};
                acc = MFMA16(A0, TW[it][0], acc); acc = MFMA16(A1, TW[it][1], acc);
                st8(lds + G2_WN + (it * 16 + fr) * PKR + (wave * 16 + 4 * fq) * 2, -acc);
            }
        }
        bf16x8 TU[4][2];
#pragma unroll
        for (int it = 0; it < 4; ++it) { TU[it][0] = *(const bf16x8*)(tmu + (it * 16 + fr) * 64 + 8 * fq); TU[it][1] = *(const bf16x8*)(tmu + (it * 16 + fr) * 64 + 32 + 8 * fq); }
        G2_LBAR();
        RELANE();
        f32x4 vn[4];
        {
            bf16x8 Bv[2], Bs[4];
#pragma unroll
            for (int ks = 0; ks < 2; ++ks) Bv[ks] = LDSF(G2_VT + (wave * 16 + fr) * PKT + ks * 64 + fq * 16);
#pragma unroll
            for (int ks = 0; ks < 4; ++ks) Bs[ks] = LDSF(G2_ST + (wave * 16 + fr) * PKR + ks * 64 + fq * 16);
#pragma unroll
            for (int it = 0; it < 4; ++it) {
                f32x4 acc = {0.f, 0.f, 0.f, 0.f};
#pragma unroll
                for (int ks = 0; ks < 2; ++ks) acc = MFMA16(TU[it][ks], Bv[ks], acc);
#pragma unroll
                for (int ks = 0; ks < 4; ++ks) acc = MFMA16(LDSF(G2_WN + (it * 16 + fr) * PKR + ks * 64 + fq * 16), Bs[ks], acc);
                vn[it] = acc;
            }
        }
        G2_LBAR();
        RELANE();
#pragma unroll
        for (int it = 0; it < 4; ++it) {
            st8(lds + G2_VN + (wave * 16 + fr) * PKT + (it * 16 + 4 * fq) * 2, vn[it]);
            const f32x4 e4 = *(const LAS f32x4*)(ekd + it * 16 + 4 * fq);
            st8(lds + G2_VT + (wave * 16 + fr) * PKT + (it * 16 + 4 * fq) * 2, vn[it] * e4);
        }
        G2_LBAR();
        RELANE();
        {
            const int it = wave & 3, dq = 4 * (wave >> 2);
            const size_t tok = tok0 + it * 16 + fr;
            u32x2 gt[4];
#pragma unroll
            for (int x = 0; x < 4; ++x) gt[x] = *(const u32x2*)(gateB + tok * 512 + h * 128 + (dq + x) * 16 + 4 * fq);
            bf16x8 Bq[4], Bk[2];
#pragma unroll
            for (int ks = 0; ks < 4; ++ks) Bq[ks] = LDSF(G2_QS + (it * 16 + fr) * PKR + ks * 64 + fq * 16);
#pragma unroll
            for (int ks = 0; ks < 2; ++ks) Bk[ks] = LDSF(G2_QK + (it * 16 + fr) * PKT + ks * 64 + fq * 16);
            const float eg = egc[it * 16 + fr];
            f32x4 O[4]; float ss = 0.f;
#pragma unroll
            for (int x = 0; x < 4; ++x) {
                f32x4 acc = {0.f, 0.f, 0.f, 0.f};
#pragma unroll
                for (int ks = 0; ks < 4; ++ks) acc = MFMA16(LDSF(G2_ST + ((dq + x) * 16 + fr) * PKR + ks * 64 + fq * 16), Bq[ks], acc);
                acc = acc * eg;
#pragma unroll
                for (int ks = 0; ks < 2; ++ks) acc = MFMA16(LDSF(G2_VN + ((dq + x) * 16 + fr) * PKT + ks * 64 + fq * 16), Bk[ks], acc);
                O[x] = acc; ss += (acc.x * acc.x + acc.y * acc.y) + (acc.z * acc.z + acc.w * acc.w);
            }
            ss += __shfl_xor(ss, 16); ss += __shfl_xor(ss, 32);
            if (fq == 0) red[(wave >> 2) * 64 + it * 16 + fr] = ss;
            RELANE();
            {
                const bf16x8 A0 = LDSF(G2_KT + (wave * 16 + fr) * PKT + fq * 16), A1 = LDSF(G2_KT + (wave * 16 + fr) * PKT + 64 + fq * 16);
#pragma unroll
                for (int dv = 0; dv < 8; ++dv) {
                    f32x4 acc = Sacc[dv] * gl;
                    acc = MFMA16(A0, LDSF(G2_VT + (dv * 16 + fr) * PKT + fq * 16), acc);
                    acc = MFMA16(A1, LDSF(G2_VT + (dv * 16 + fr) * PKT + 64 + fq * 16), acc);
                    Sacc[dv] = acc;
                }
            }
            G2_LBAR();
            RELANE();
            const float tot = red[it * 16 + fr] + red[64 + it * 16 + fr];
            const float rstd = rsqrtf(tot * (1.0f / 128.0f) + RMS_EPS);
#pragma unroll
            for (int x = 0; x < 4; ++x) {
                const f32x4 g4 = *(const LAS f32x4*)(ng + (dq + x) * 16 + 4 * fq);
                const float t0 = bflo(gt[x].x), t1 = bfhi(gt[x].x), t2 = bflo(gt[x].y), t3 = bfhi(gt[x].y);
                f32x4 o = O[x] * rstd * g4; o.x *= t0 * fsig(t0); o.y *= t1 * fsig(t1); o.z *= t2 * fsig(t2); o.w *= t3 * fsig(t3);
                u32x2 w; w.x = pg8::cvt_pk_bf16(o.x, o.y); w.y = pg8::cvt_pk_bf16(o.z, o.w);
                *(u32x2*)(oB + tok * 512 + h * 128 + (dq + x) * 16 + 4 * fq) = w;
            }
#pragma unroll
            for (int dv = 0; dv < 8; ++dv) st8(lds + G2_ST + (dv * 16 + fr) * PKR + (wave * 16 + 4 * fq) * 2, Sacc[dv]);
        }
        G2_LBAR();
    }
}
#undef G2_LBAR
#undef RELANE

constexpr int CW_ATTQ = 65536;
__device__ __forceinline__ void phase_pre(const Args& a, LAS unsigned char* lds, int layer, int gw, int NGW, int wave, int lane, int tid, int G) {
    gdn_pre_stage(a, lds, layer, tid);
    for (int item = blockIdx.x; item < BATCH * NCH; item += G) gdn_pre_item(a, lds, layer, item, wave, lane, tid);
    phase_pool(a, gw, NGW, lane);
}
__device__ __forceinline__ void phase_mix(const Args& a, LAS unsigned char* lds, int layer, int qsel, int wave, int lane, int tid, int G) {
    (void)qsel;
    constexpr int NSEQ = BATCH * B_HEADS, NGRP = BATCH * A_HEADS * NCH / 4;
    const bool split = G > NSEQ;
    if (!split || (int)blockIdx.x < NSEQ) {
        for (int item = blockIdx.x; item < NSEQ; item += G) gdn_scan_item(a, lds, layer, item, wave, lane, tid);
        __syncthreads();
        if (split) return;
        lane = fresh_lane(); tid = wave * 64 + lane;
    }
    attn_stage_bias(a, lds, layer, tid);
    const LAS float* rb = (const LAS float*)lds;
    const int nA = split ? G - NSEQ : G, aw = split ? (int)blockIdx.x - NSEQ : (int)blockIdx.x;
    const int per = (NGRP + nA - 1) / nA;
    for (int i = 0; i < per; ++i) {
        const int grp = aw * per + i;
        if (grp >= NGRP) break;
        attn_group(a, lds, rb, grp, wave, lane, tid);
    }
}

#define XB_TMO      128
#define XB_XCNT(j)  (256  + 64 * (j))
#define XB_XSUB(j)  (1280 + 64 * (j))
#define XB_XGEN(j)  (2304 + 64 * (j))
#define XB_TOP      3328
#define XB_TOPGEN   3392
#define XCD_BAR_WORDS 3456
#define XB_SPIN_CAP (1u << 18)

__device__ __forceinline__ unsigned xb_ld(unsigned* p)              { return __hip_atomic_load(p, __ATOMIC_RELAXED, __HIP_MEMORY_SCOPE_AGENT); }
__device__ __forceinline__ unsigned xb_add(unsigned* p, unsigned v) { return __hip_atomic_fetch_add(p, v, __ATOMIC_RELAXED, __HIP_MEMORY_SCOPE_AGENT); }
__device__ __forceinline__ unsigned xb_xcc_id() { return (unsigned)__builtin_amdgcn_s_getreg((3 << 11) | 20) & 0xFu; }
#define XB_SPIN(cond, bar) do { unsigned _sp = 0; while (cond) { __builtin_amdgcn_s_sleep(1); \
    if ((++_sp & 255u) == 0u) { if (xb_ld(&(bar)[XB_TMO])) break; if (_sp > XB_SPIN_CAP) { atomicAdd(&(bar)[XB_TMO], 1u); break; } } } } while (0)

struct XcdBarrier {
    unsigned* bar; unsigned x;
    volatile LAS unsigned* st;
};

__device__ __forceinline__ XcdBarrier xcd_barrier_post(unsigned* bar, volatile LAS unsigned* st) {
    XcdBarrier b; b.bar = bar; b.x = xb_xcc_id(); b.st = st;
    if (threadIdx.x == 0) (void)xb_add(&bar[XB_XCNT(b.x)], 1u);
    return b;
}
__device__ __forceinline__ void xcd_barrier_complete(unsigned* bar, unsigned x, unsigned& nloc, unsigned& nx) {
    const unsigned G = gridDim.x * gridDim.y * gridDim.z;
    unsigned sum, cnt, mine, sp = 0u;
    for (;;) {
        sum = 0u; cnt = 0u; mine = 0u;
#pragma unroll
        for (unsigned j = 0; j < 16; ++j) { const unsigned c = xb_ld(&bar[XB_XCNT(j)]); sum += c; cnt += (c > 0u) ? 1u : 0u; mine = (j == x) ? c : mine; }
        if (sum == G) break;
        __builtin_amdgcn_s_sleep(1);
        if ((++sp & 255u) == 0u) { if (xb_ld(&bar[XB_TMO])) break; if (sp > XB_SPIN_CAP) { atomicAdd(&bar[XB_TMO], 1u); break; } }
    }
    nloc = mine > 0u ? mine : 1u; nx = cnt > 0u ? cnt : 1u;
}

__device__ __forceinline__ void xcd_barrier(const XcdBarrier& b) {
    asm volatile("s_waitcnt vmcnt(0)" ::: "memory");
    __syncthreads();
    if (threadIdx.x == 0) {
        unsigned* bar = b.bar;
        __builtin_amdgcn_s_waitcnt(0);
        unsigned nloc = b.st[0], nx = b.st[1];
        if (nloc == 0u) { xcd_barrier_complete(bar, b.x, nloc, nx); b.st[0] = nloc; b.st[1] = nx; }
        const unsigned old = xb_add(&bar[XB_XSUB(b.x)], 1u);
        const unsigned gen = old / nloc;
        if (old + 1u == (gen + 1u) * nloc) {
            __builtin_amdgcn_fence(__ATOMIC_RELEASE, "agent");
            asm volatile("s_waitcnt vmcnt(0)" ::: "memory");
            const unsigned og = xb_add(&bar[XB_TOP], 1u);
            const unsigned tg = og / nx;
            if (og + 1u == (tg + 1u) * nx) xb_add(&bar[XB_TOPGEN], 1u);
            else XB_SPIN(xb_ld(&bar[XB_TOPGEN]) == tg, bar);
            __builtin_amdgcn_fence(__ATOMIC_ACQUIRE, "agent");
            xb_add(&bar[XB_XGEN(b.x)], 1u);
            asm volatile("s_waitcnt vmcnt(0)" ::: "memory");
        } else {
            XB_SPIN(xb_ld(&bar[XB_XGEN(b.x)]) == gen, bar);
            __builtin_amdgcn_fence(__ATOMIC_ACQUIRE, "agent");
            asm volatile("s_waitcnt vmcnt(0)" ::: "memory");
        }
    }
    __syncthreads();
}


constexpr int CW_BAR = 4096;
constexpr int LDS_BARW = LDS_BYTES - 16;
#define IN(k) (a.ph_lo <= (k) && (k) < a.ph_hi)
#define SEAM(k) do { if (fused && !((k) == PH_COUNT - 1 && layer == a.lay_hi - 1) && !((k) == a.ph_hi - 1 && a.ph_hi < PH_COUNT)) xcd_barrier(bar); } while (0)
template <int layer> __device__ __forceinline__ void layer_prog(const Args& a, LAS unsigned char* lds, const XcdBarrier& bar, bool fused, int gw, int NGW, int wave, int GT, int G) {
#define RUN(k, ...) if (IN(k)) { constexpr int nrep_ = (layer == 0 && (k) == PROBE_PH) ? 1 + PROBE_REP : 1; _Pragma("unroll") for (int rep = 0; rep < nrep_; ++rep) { \
        const int lane = fresh_lane(), tid = wave * 64 + lane, gtid = (int)blockIdx.x * NTHR + tid; (void)gtid; __VA_ARGS__; if (rep + 1 < nrep_) xcd_barrier(bar); } SEAM(k); }
    RUN(PH_CONVERT, phase_convert(a, lds, layer, gw, NGW, wave, lane, tid, gtid, GT); if (layer == 0) { __syncthreads(); phase_xconv(a, lds, gw, NGW, lane, tid); })
    RUN(PH_PROJ1, phase_g_proj1(a, lds, G, (int)blockIdx.x, wave, lane))
    RUN(PH_PRE, phase_pre(a, lds, layer, gw, NGW, wave, lane, tid, G))
    RUN(PH_MIX, phase_mix(a, lds, layer, layer * 4 + rep, wave, lane, tid, G))
    RUN(PH_GATES, phase_g_gates(a, lds, layer, G, (int)blockIdx.x, wave, lane))
    RUN(PH_BRANCH, phase_g_branch(a, lds, G, (int)blockIdx.x, wave, lane))
    RUN(PH_OUT, phase_g_out(a, lds, G, (int)blockIdx.x, wave, lane))
    RUN(PH_LN1, phase_ln1(a, lds, layer, gw, NGW, wave, lane))
    RUN(PH_SLOTS, phase_slots(a, lds, gw, NGW, wave, lane, tid))
    RUN(PH_MOE1, phase_moe1(a, lds, G, (int)blockIdx.x, tid, wave, lane))
    RUN(PH_MOE2, phase_moe2(a, lds, G, (int)blockIdx.x, tid, wave, lane))
    RUN(PH_LN2, phase_ln2(a, lds, layer, gw, NGW, lane, tid))
#undef RUN
}
#undef IN
#undef SEAM
__global__ void __launch_bounds__(NTHR, 2) mk(Args a) {
    extern __shared__ __attribute__((aligned(16))) unsigned char lds_raw[];
    LAS unsigned char* lds = (LAS unsigned char*)lds_raw;
    const int tid = threadIdx.x, lane = tid & 63, wave = __builtin_amdgcn_readfirstlane(tid >> 6);
    const int G = gridDim.x, gw = blockIdx.x * NWAVES + wave, NGW = G * NWAVES, gtid = blockIdx.x * NTHR + tid, GT = G * NTHR;
    const bool fused = (a.ph_hi - a.ph_lo > 1) || (a.lay_hi - a.lay_lo > 1);
    if (tid == 0) *(LAS u32x4*)(lds + LDS_BARW) = (u32x4){0u, 0u, 0u, 0u};
    __syncthreads();
    XcdBarrier bar; bar.bar = (unsigned*)(a.ws + WS_CTL) + CW_BAR; bar.x = 0; bar.st = (volatile LAS unsigned*)(lds + LDS_BARW);
    if (fused) bar = xcd_barrier_post((unsigned*)(a.ws + WS_CTL) + CW_BAR, (volatile LAS unsigned*)(lds + LDS_BARW));
    if (a.lay_lo <= 0 && 0 < a.lay_hi) layer_prog<0>(a, lds, bar, fused, gw, NGW, wave, GT, G);
    if (a.lay_lo <= 1 && 1 < a.lay_hi) layer_prog<1>(a, lds, bar, fused, gw, NGW, wave, GT, G);
}

extern "C" void kernel_launch(void* const* d_in, const int* in_sizes, int n_in, void* d_out, int out_size, void* d_ws, size_t ws_size, hipStream_t stream) {
    static int grid = 0;
    if (grid == 0) {
        if (n_in != 25 || in_sizes[0] != T * D || out_size != T * D || ws_size < WS_END) { fprintf(stderr, "kernel_launch: unexpected shapes (n_in %d, in0 %d, out %d, ws %zu < %zu)\n", n_in, n_in > 0 ? in_sizes[0] : -1, out_size, ws_size, (size_t)WS_END); grid = -1; return; }
        int dev = 0, cus = 0;
        if (hipGetDevice(&dev) != hipSuccess || hipDeviceGetAttribute(&cus, hipDeviceAttributeMultiprocessorCount, dev) != hipSuccess) { grid = -1; return; }
        if (hipFuncSetAttribute((const void*)mk, hipFuncAttributeMaxDynamicSharedMemorySize, LDS_BYTES) != hipSuccess) { fprintf(stderr, "kernel_launch: hipFuncSetAttribute failed\n"); grid = -1; return; }
        grid = cus;
    }
    if (grid < 0) return;
    unsigned char* ws = (unsigned char*)d_ws;
    (void)hipMemsetAsync(ws + WS_CTL, 0, 1 * MiB, stream);
    Args a{};
    for (int i = 0; i < 25; ++i) a.in[i] = (const float*)d_in[i];
    a.out = (float*)d_out; a.ws = ws;
#if MK_N_LAUNCHES == 1
    a.lay_lo = 0; a.lay_hi = DEPTH; a.ph_lo = 0; a.ph_hi = PH_COUNT;
    hipLaunchKernelGGL(mk, dim3(grid), dim3(NTHR), LDS_BYTES, stream, a);
#else
    for (int layer = 0; layer < DEPTH; ++layer) for (int ph = 0; ph < PH_COUNT; ++ph) { a.lay_lo = layer; a.lay_hi = layer + 1; a.ph_lo = ph; a.ph_hi = ph + 1; hipLaunchKernelGGL(mk, dim3(grid), dim3(NTHR), LDS_BYTES, stream, a); }
#endif
}
```

```cpp
#include <hip/hip_runtime.h>
#include <cstdio>
#include <cstdint>
#ifndef PROBE_PH
#define PROBE_PH (-1)
#endif
#ifndef PROBE_MIX
#define PROBE_MIX 0
#endif
#ifndef PROBE_REP
#define PROBE_REP 2
#endif
#ifndef MK_N_LAUNCHES
#define MK_N_LAUNCHES 1
#endif

#define GAS __attribute__((address_space(1)))
#define LAS __attribute__((address_space(3)))
typedef unsigned short bf16_t;
typedef short bf16x8 __attribute__((ext_vector_type(8)));
typedef float f32x4 __attribute__((ext_vector_type(4)));
typedef float f32x2 __attribute__((ext_vector_type(2)));
typedef unsigned u32x4 __attribute__((ext_vector_type(4)));
typedef unsigned u32x2 __attribute__((ext_vector_type(2)));

namespace pg8 {
#define PG8_LAS __attribute__((address_space(3)))
typedef unsigned short bf16_t;
typedef short bf16x8 __attribute__((ext_vector_type(8)));
typedef float f32x4 __attribute__((ext_vector_type(4)));
typedef unsigned u32x4 __attribute__((ext_vector_type(4)));
constexpr int BM = 256, BK = 64, HALF = 128, HTB = HALF * BK * 2  , STAGE_BYTES = 8 * HTB, NXCD = 8, WGM = 8;

__host__ __device__ __forceinline__ int lds_byte(int r, int c) { const int st = (r >> 4) * 2 + (c >> 5), rr = r & 15, cc = c & 31, ob = rr * 64 + cc * 2; return st * 1024 + (ob ^ (((ob >> 9) & 1) << 5)); }
__host__ __device__ __forceinline__ void stage_rc(int b, int& R, int& C) { const int st = b / 1024, sb = b % 1024, swz = sb ^ (((sb >> 9) & 1) << 5); R = (st >> 1) * 16 + swz / 64; C = (st & 1) * 32 + (swz % 64) / 2; }
__host__ __device__ __forceinline__ int perm32(int rho) { const int n = rho >> 4, i = rho & 15; return 8 * (i >> 2) + 4 * n + (i & 3); }

struct Unit { int pm, pn; };
struct Gemm { const bf16_t* A; const bf16_t* Bt; int M, N, K; };

struct StaticOrder {
    int nM, nN, nwg, G, c;
    __host__ __device__ void init(int M, int N, int G_, int c_) { nM = M / BM; nN = N / BM; nwg = nM * nN; G = G_; c = c_; }
    __host__ __device__ bool next(int i, Unit& u) const {
        const long L = (long)i * G + c; if (L >= nwg) return false;
        int wgid = (int)L; { const int q = nwg / NXCD, r = nwg % NXCD, xcd = wgid % NXCD, off = wgid / NXCD; wgid = (xcd < r ? xcd * (q + 1) : r * (q + 1) + (xcd - r) * q) + off; }
        const int nig = WGM * nN, gid = wgid / nig, fm = gid * WGM, gsz = (nM - fm) < WGM ? (nM - fm) : WGM;
        u.pm = fm + ((wgid % nig) % gsz); u.pn = (wgid % nig) / gsz; return true;
    }
    __device__ __forceinline__ void a_ready(const Unit&) const {}
    __device__ __forceinline__ void done(const Unit&) const {}
};
typedef float f32x2_ __attribute__((ext_vector_type(2)));
typedef __bf16 bf16x2_ __attribute__((ext_vector_type(2)));
__device__ __forceinline__ unsigned cvt_pk_bf16(float lo, float hi) { const f32x2_ v = {lo, hi}; return __builtin_bit_cast(unsigned, __builtin_convertvector(v, bf16x2_)); }
template <class Epi, class Sched, bool ALIGN_EPI = false, bool SP2 = false>
__device__ __forceinline__ void gemm_phase(PG8_LAS unsigned char* lds, const Gemm g, const Sched& S, const Epi& E, const int wid, const int lane) {
    const int tid = wid * 64 + lane, wr = wid >> 2, wc = wid & 3, fr = lane & 15, fq = lane >> 4;
    const int K = g.K, nt = K / BK;
    unsigned voffA[2], voffB[2];
#pragma unroll
    for (int i = 0; i < 2; ++i) { int R, C; stage_rc(tid * 16 + i * 8192, R, C); const int Rb = Epi::PERM ? ((R & ~31) + perm32(R & 31)) : R;
        voffA[i] = (unsigned)(R * K + C) * 2u; voffB[i] = (unsigned)(Rb * K + C) * 2u; }
    const size_t kstep = (size_t)(BK * 2);
    const size_t hstep = (size_t)HALF * K * 2;
    const size_t tstep = 2 * hstep;
    const unsigned ldsw = (unsigned)wid * 1024u;
    const int aoff = lds_byte(wr * 64 + fr, fq * 8), boff = lds_byte(wc * 32 + fr, fq * 8);
#define PG8_SA(b, h) (((b) * 2 + (h)) * HTB)
#define PG8_SB(b, h) ((4 + (b) * 2 + (h)) * HTB)
#define PG8_STAGE(bufoff, gbase, voff) do { _Pragma("unroll") for (int _i = 0; _i < 2; ++_i) \
        __builtin_amdgcn_global_load_lds((const unsigned*)((const char*)(gbase) + (voff)[_i]), (PG8_LAS unsigned*)(lds + (bufoff) + ldsw + _i * 8192), 16, 0, 0); } while (0)
#define PG8_LDA(dst, b, h) do { _Pragma("unroll") for (int m = 0; m < 4; ++m) _Pragma("unroll") for (int k = 0; k < 2; ++k) dst[m][k] = *(const PG8_LAS bf16x8*)(lds + PG8_SA(b, h) + aoff + m * 2048 + k * 1024); } while (0)
#define PG8_LDB(dst, b, h) do { _Pragma("unroll") for (int n = 0; n < 2; ++n) _Pragma("unroll") for (int k = 0; k < 2; ++k) dst[n][k] = *(const PG8_LAS bf16x8*)(lds + PG8_SB(b, h) + boff + n * 2048 + k * 1024); } while (0)
#define PG8_MMA(ai, bj, At, Bt) do { __builtin_amdgcn_s_setprio(1); _Pragma("unroll") for (int m = 0; m < 4; ++m) _Pragma("unroll") for (int n = 0; n < 2; ++n) _Pragma("unroll") for (int k = 0; k < 2; ++k) \
        acc[ai][bj][m][n] = __builtin_amdgcn_mfma_f32_16x16x32_bf16(Bt[n][k], At[m][k], acc[ai][bj][m][n], 0, 0, 0); __builtin_amdgcn_s_setprio(0); } while (0)
#define PG8_WAIT_V(n) asm volatile("s_waitcnt vmcnt(" #n ")" ::: "memory")
#define PG8_WAIT_L(n) asm volatile("s_waitcnt lgkmcnt(" #n ")" ::: "memory")
#define PG8_BAR __builtin_amdgcn_s_barrier()
#define PG8_SCHED __builtin_amdgcn_sched_barrier(0)
    Unit cur, nxt; int ui = 0;
    if (!S.next(0, cur)) return;
    f32x4 acc[2][2][4][2];
#pragma unroll
    for (int a = 0; a < 2; ++a)
#pragma unroll
        for (int b = 0; b < 2; ++b)
#pragma unroll
            for (int m = 0; m < 4; ++m)
#pragma unroll
                for (int n = 0; n < 2; ++n) acc[a][b][m][n] = (f32x4){0.f, 0.f, 0.f, 0.f};
    bf16x8 At[4][2], B0[2][2], B1[2][2];
    const char* cA = (const char*)g.A + (size_t)cur.pm * tstep; const char* cB = (const char*)g.Bt + (size_t)cur.pn * tstep;
    S.a_ready(cur);
    if constexpr (SP2) {
        PG8_STAGE(PG8_SB(0, 0), cB, voffB); PG8_STAGE(PG8_SB(0, 1), cB + hstep, voffB); PG8_STAGE(PG8_SA(0, 0), cA, voffA); PG8_STAGE(PG8_SA(0, 1), cA + hstep, voffA);
        if (wr == 1) PG8_BAR;
        PG8_WAIT_V(2); PG8_BAR;
        PG8_STAGE(PG8_SB(1, 0), cB + kstep, voffB); PG8_STAGE(PG8_SA(1, 0), cA + kstep, voffA); PG8_STAGE(PG8_SB(1, 1), cB + hstep + kstep, voffB);
        PG8_WAIT_V(6); PG8_BAR;
    } else {
        PG8_STAGE(PG8_SB(0, 0), cB, voffB); PG8_STAGE(PG8_SA(0, 0), cA, voffA); PG8_STAGE(PG8_SB(0, 1), cB + hstep, voffB); PG8_STAGE(PG8_SA(0, 1), cA + hstep, voffA);
        if (wr == 1) PG8_BAR;
        PG8_WAIT_V(4); PG8_BAR;
        PG8_STAGE(PG8_SB(1, 0), cB + kstep, voffB); PG8_STAGE(PG8_SA(1, 0), cA + kstep, voffA); PG8_STAGE(PG8_SB(1, 1), cB + hstep + kstep, voffB);
        PG8_WAIT_V(6); PG8_BAR;
    }
    for (;;) {
        const bool has_next = S.next(ui + 1, nxt);
        const char* nA = has_next ? (const char*)g.A + (size_t)nxt.pm * tstep : cA; const char* nB = has_next ? (const char*)g.Bt + (size_t)nxt.pn * tstep : cB;
        for (int t = 0; t < nt; t += 2) {
            const bool last = (t == nt - 2);
            const char* a1 = cA + (size_t)(t + 1) * kstep;
            const char* a2 = last ? nA : cA + (size_t)(t + 2) * kstep; const char* b2 = last ? nB : cB + (size_t)(t + 2) * kstep;
            const char* a3 = a2 + kstep; const char* b3 = b2 + kstep;
            if (last && has_next) S.a_ready(nxt);
            if constexpr (SP2) {
            PG8_LDB(B0, 0, 0); PG8_LDB(B1, 0, 1); PG8_SCHED; PG8_LDA(At, 0, 0); PG8_STAGE(PG8_SA(1, 1), a1 + hstep, voffA);
            PG8_WAIT_V(8); PG8_WAIT_L(0); PG8_BAR; PG8_MMA(0, 0, At, B0); PG8_MMA(0, 1, At, B1); PG8_BAR; PG8_SCHED;
            PG8_LDA(At, 0, 1); PG8_STAGE(PG8_SB(0, 0), b2, voffB); PG8_STAGE(PG8_SB(0, 1), b2 + hstep, voffB); PG8_STAGE(PG8_SA(0, 0), a2, voffA);
            PG8_WAIT_V(8); PG8_WAIT_L(0); PG8_BAR; PG8_MMA(1, 0, At, B0); PG8_MMA(1, 1, At, B1); PG8_BAR; PG8_SCHED;
            PG8_LDB(B0, 1, 0); PG8_LDB(B1, 1, 1); PG8_SCHED; PG8_LDA(At, 1, 0); PG8_STAGE(PG8_SA(0, 1), a2 + hstep, voffA);
            PG8_WAIT_V(8); PG8_WAIT_L(0); PG8_BAR; PG8_MMA(0, 0, At, B0); PG8_MMA(0, 1, At, B1); PG8_BAR; PG8_SCHED;
            PG8_LDA(At, 1, 1); PG8_STAGE(PG8_SB(1, 0), b3, voffB); PG8_STAGE(PG8_SB(1, 1), b3 + hstep, voffB); PG8_STAGE(PG8_SA(1, 0), a3, voffA);
            PG8_WAIT_V(8); PG8_WAIT_L(0); PG8_BAR; PG8_MMA(1, 0, At, B0); PG8_MMA(1, 1, At, B1); PG8_BAR; PG8_SCHED;
            } else {
            PG8_LDB(B0, 0, 0); PG8_SCHED; PG8_LDA(At, 0, 0); PG8_STAGE(PG8_SA(1, 1), a1 + hstep, voffA);
            PG8_WAIT_L(8); PG8_BAR; PG8_WAIT_L(0); PG8_MMA(0, 0, At, B0); PG8_BAR; PG8_SCHED;
            PG8_LDB(B1, 0, 1); PG8_STAGE(PG8_SB(0, 0), b2, voffB);
            PG8_BAR; PG8_WAIT_L(0); PG8_MMA(0, 1, At, B1); PG8_BAR;
            PG8_LDA(At, 0, 1); PG8_STAGE(PG8_SA(0, 0), a2, voffA);
            PG8_BAR; PG8_WAIT_L(0); PG8_MMA(1, 0, At, B0); PG8_BAR; PG8_SCHED;
            PG8_STAGE(PG8_SB(0, 1), b2 + hstep, voffB);
            PG8_WAIT_V(6); PG8_BAR; PG8_MMA(1, 1, At, B1); PG8_BAR;
            PG8_LDB(B0, 1, 0); PG8_SCHED; PG8_LDA(At, 1, 0); PG8_STAGE(PG8_SA(0, 1), a2 + hstep, voffA);
            PG8_WAIT_L(8); PG8_BAR; PG8_WAIT_L(0); PG8_MMA(0, 0, At, B0); PG8_BAR; PG8_SCHED;
            PG8_LDB(B1, 1, 1); PG8_STAGE(PG8_SB(1, 0), b3, voffB);
            PG8_BAR; PG8_WAIT_L(0); PG8_MMA(0, 1, At, B1); PG8_BAR;
            PG8_LDA(At, 1, 1); PG8_STAGE(PG8_SA(1, 0), a3, voffA);
            PG8_BAR; PG8_WAIT_L(0); PG8_MMA(1, 0, At, B0); PG8_BAR; PG8_SCHED;
            PG8_STAGE(PG8_SB(1, 1), b3 + hstep, voffB);
            PG8_WAIT_V(6); PG8_BAR; PG8_MMA(1, 1, At, B1); PG8_BAR;
            }
        }
        if constexpr (ALIGN_EPI) { if (wr == 0) PG8_BAR; }
        if constexpr (!Epi::AFTER_DRAIN) { E(acc, cur, wr, wc, fr, fq); S.done(cur); }
        if (!has_next) break;
#pragma unroll
        for (int a = 0; a < 2; ++a)
#pragma unroll
            for (int b = 0; b < 2; ++b)
#pragma unroll
                for (int m = 0; m < 4; ++m)
#pragma unroll
                    for (int n = 0; n < 2; ++n) acc[a][b][m][n] = (f32x4){0.f, 0.f, 0.f, 0.f};
        cur = nxt; cA = nA; cB = nB; ++ui;
        if constexpr (ALIGN_EPI) { if (wr == 1) PG8_BAR; }
    }
    PG8_WAIT_V(0);
    if constexpr (!ALIGN_EPI) { if (wr == 0) PG8_BAR; }
    PG8_BAR;
    if constexpr (Epi::AFTER_DRAIN) { E.fused(acc, cur, wr, wc, fr, fq, lds, wid, lane); S.done(cur); }
#undef PG8_SA
#undef PG8_SB
#undef PG8_STAGE
#undef PG8_LDA
#undef PG8_LDB
#undef PG8_MMA
#undef PG8_WAIT_V
#undef PG8_WAIT_L
#undef PG8_BAR
#undef PG8_SCHED
}
}

constexpr int BATCH = 32, SEQ = 2048, D = 1024, T = BATCH * SEQ, DEPTH = 2, CHUNK = 64, NCH = SEQ / CHUNK;
constexpr int A_HEADS = 8, A_HD = 64, A_W = 512, A_LEFT = 8, A_BAND = 576, A_CLIP = 256, A_NREL = 320;
constexpr int B_HEADS = 4, B_HD = 128, B_W = 512;
constexpr int C_W = 512;
constexpr int D_IN = 7176;
constexpr int OFF_QA = 0, OFF_KA = 512, OFF_VA = 1024, OFF_QKVB = 1536, OFF_BETA = 3072, OFF_DEC = 3076, OFF_GATEB = 3080, OFF_POOL = 3592, OFF_GATES = 4104;
constexpr int NEXP = 32, MOE_FF = 512, MOE_BLOCK = 256;
constexpr int NPAIR = 2 * T, NBLK_MAX = NPAIR / MOE_BLOCK + NEXP, CAP = NBLK_MAX * MOE_BLOCK;
constexpr float DN_ALPHA = 1.4142135623730951f;
constexpr float LN_EPS = 1e-5f, RMS_EPS = 1e-6f;
constexpr int N1 = 3584;

constexpr size_t MiB = 1ull << 20, U = 128 * MiB;
constexpr size_t WS_CTL = 0;
constexpr size_t WS_WIN1 = 1 * MiB, WS_WV = 8 * MiB, WS_WG = 9 * MiB, WS_WBR = 15 * MiB, WS_WOUT = 18 * MiB, WS_W13 = 20 * MiB, WS_W2 = 84 * MiB;
constexpr size_t WS_XB = U;
constexpr size_t WS_P = 2 * U;
constexpr size_t WS_QA = WS_P, WS_KA = WS_P + U / 2, WS_VT = WS_P + U, WS_QKVB = WS_P + 3 * U / 2, WS_GATEB = WS_P + 3 * U, WS_POOL = WS_P + 7 * U / 2;
constexpr size_t WS_OA = WS_P + 4 * U, WS_OB = WS_P + 9 * U / 2, WS_PLD = WS_P + 5 * U;
constexpr size_t WS_SM = 116 * MiB;
constexpr size_t WS_BDL = WS_SM, WS_EID = WS_SM + 2 * MiB, WS_WTS = WS_SM + 5 * MiB / 2, WS_SLOT = WS_SM + 3 * MiB, WS_HIST = WS_SM + 7 * MiB / 2, WS_BLKE = WS_SM + 15 * MiB / 4, WS_GC = WS_SM + 4 * MiB;
constexpr size_t WS_TMU = WS_P + 11 * U / 2, WS_TMW = WS_TMU + 32 * MiB;
constexpr size_t WS_GATES = WS_P, WS_Y = WS_P + 3 * U, WS_MIX = WS_P;
constexpr size_t WS_XG = WS_P, WS_HDN = WS_P + (size_t)CAP * 2048, WS_YMOE = WS_HDN + (size_t)CAP * 1024;
constexpr size_t WS_END = 8 * U;
static_assert(WS_YMOE + (size_t)CAP * 2048 <= WS_TMU, "moe buffers");
static_assert(WS_GC + 1 * MiB <= U, "small tables");
constexpr size_t WS_WRT = WS_SM + 5 * MiB;
static_assert(WS_WRT + 2 * 48 * 1024 * 2 <= U, "router weights");
static_assert(WS_W2 + 32 * MiB <= U, "weights");

__device__ __forceinline__ unsigned f2bf(float f) { unsigned u = __builtin_bit_cast(unsigned, f); return (u + 0x7fffu + ((u >> 16) & 1u)) >> 16; }
__device__ __forceinline__ unsigned pk2(float lo, float hi) { return f2bf(lo) | (f2bf(hi) << 16); }
__device__ __forceinline__ float bf2f(unsigned short b) { return __builtin_bit_cast(float, ((unsigned)b) << 16); }
__device__ __forceinline__ float bflo(unsigned w) { return __builtin_bit_cast(float, w << 16); }
__device__ __forceinline__ float bfhi(unsigned w) { return __builtin_bit_cast(float, w & 0xffff0000u); }
__device__ __forceinline__ float wave_sum(float v) {
#pragma unroll
    for (int o = 1; o < 64; o <<= 1) v += __shfl_xor(v, o);
    return v;
}
__device__ __forceinline__ float sigmoidf_(float x) { return 1.0f / (1.0f + __expf(-x)); }
__device__ __forceinline__ float siluf_(float x) { return x / (1.0f + __expf(-x)); }
__device__ __forceinline__ float softplusf_(float x) { return x > 20.f ? x : log1pf(expf(x)); }

__device__ __forceinline__ int fresh_lane() { int l; asm volatile("v_mbcnt_lo_u32_b32 %0, -1, 0\n\tv_mbcnt_hi_u32_b32 %0, -1, %0" : "=v"(l)); return l; }
struct Args { const float* in[25]; float* out; unsigned char* ws; int lay_lo, lay_hi, ph_lo, ph_hi; };

enum Phase { PH_CONVERT = 0, PH_PROJ1 = 1, PH_PRE = 2, PH_MIX = 3, PH_GATES = 4, PH_BRANCH = 5, PH_OUT = 6, PH_LN1 = 7, PH_SLOTS = 8, PH_MOE1 = 9, PH_MOE2 = 10, PH_LN2 = 11, PH_COUNT = 12 };

constexpr int NWAVES = 8, NTHR = 512;
constexpr int LDS_BYTES = 163840;

__device__ __forceinline__ void convert_item(const float* W, int ldw, int col0, int k0, bf16_t* WT, int Kd, int rowbase, int ilv_half, LAS unsigned char* lds, int tid) {
    LAS float* scr = (LAS float*)lds;
#pragma unroll
    for (int i = 0; i < 16; ++i) { const int k = 4 * i + (tid >> 7), c4 = (tid & 127) * 4;
        *(LAS f32x4*)(scr + k * 516 + c4) = *(const f32x4*)(W + (size_t)(k0 + k) * ldw + col0 + c4); }
    __syncthreads();
    const int nlo = tid & 31, cch = (tid >> 5) & 7, nhi = tid >> 8;
#pragma unroll
    for (int j = 0; j < 8; ++j) {
        const int n = nlo + 32 * (nhi + 2 * j); const LAS float* sp = scr + (8 * cch) * 516 + n;
        u32x4 o; o.x = pg8::cvt_pk_bf16(sp[0], sp[516]); o.y = pg8::cvt_pk_bf16(sp[2 * 516], sp[3 * 516]); o.z = pg8::cvt_pk_bf16(sp[4 * 516], sp[5 * 516]); o.w = pg8::cvt_pk_bf16(sp[6 * 516], sp[7 * 516]);
        const int fr_ = (ilv_half < 0) ? n : ((n >> 7) * 256 + ilv_half * 128 + (n & 127));
        *(u32x4*)(WT + (size_t)(rowbase + fr_) * Kd + k0 + 8 * cch) = o;
    }
    __syncthreads();
}
__device__ __forceinline__ void phase_convert(const Args& a, LAS unsigned char* lds, int layer, int gw, int NGW, int wave, int lane, int tid, int gtid, int GT) {
    unsigned char* ws = a.ws;
    const float* w_in = a.in[1] + (size_t)layer * D * D_IN;
    constexpr int I_IN = 14 * 16, I_BR = 2 * 2 * 8, I_OUT = 2 * 16, I_W13 = NEXP * 2 * 16, I_W2 = NEXP * 2 * 8, I_FOLD = 32, NITEMS = I_IN + I_BR + I_OUT + I_W13 + I_W2 + I_FOLD;
    const int G_ = NGW / NWAVES;
    for (int it = blockIdx.x; it < NITEMS; it += G_) {
        int r = it;
        if (r < I_IN) {
            const int kb = r & 15, cb = r >> 4;
            int c0, r0; size_t dd;
            if (cb == 0) { c0 = OFF_QA; r0 = 0; dd = WS_WIN1; } else if (cb == 1) { c0 = OFF_KA; r0 = 512; dd = WS_WIN1; }
            else if (cb < 5) { c0 = OFF_QKVB + 512 * (cb - 2); r0 = 1024 + 512 * (cb - 2); dd = WS_WIN1; }
            else if (cb == 5) { c0 = OFF_GATEB; r0 = 2560; dd = WS_WIN1; } else if (cb == 6) { c0 = OFF_POOL; r0 = 3072; dd = WS_WIN1; }
            else if (cb == 7) { c0 = OFF_VA; r0 = 0; dd = WS_WV; } else { c0 = OFF_GATES + 512 * (cb - 8); r0 = 512 * (cb - 8); dd = WS_WG; }
            convert_item(w_in, D_IN, c0, 64 * kb, (bf16_t*)(ws + dd), 1024, r0, -1, lds, tid);
            continue;
        }
        r -= I_IN;
        if (r < I_BR) {
            const int which = r >> 4, cb = (r >> 3) & 1, kb = r & 7;
            const float* W = (which == 0 ? a.in[9] : a.in[10]) + (size_t)layer * 512 * 1024;
            convert_item(W, 1024, 512 * cb, 64 * kb, (bf16_t*)(ws + WS_WBR) + (size_t)which * 1024 * 512, 512, 512 * cb, -1, lds, tid);
            continue;
        }
        r -= I_BR;
        if (r < I_OUT) {
            const int cb = r >> 4, kb = r & 15;
            convert_item(a.in[13] + (size_t)layer * 1024 * 1024, 1024, 512 * cb, 64 * kb, (bf16_t*)(ws + WS_WOUT), 1024, 512 * cb, -1, lds, tid);
            continue;
        }
        r -= I_OUT;
        if (r < I_W13) {
            const int e = r >> 5, half = (r >> 4) & 1, kb = r & 15;
            const float* W = (half == 0 ? a.in[20] : a.in[21]) + ((size_t)layer * NEXP + e) * 1024 * 512;
            convert_item(W, 512, 0, 64 * kb, (bf16_t*)(ws + WS_W13), 1024, e * 1024, half, lds, tid);
            continue;
        }
        r -= I_W13;
        if (r < I_W2) {
            const int e = r >> 4, cb = (r >> 3) & 1, kb = r & 7;
            const float* W = a.in[22] + ((size_t)layer * NEXP + e) * 512 * 1024;
            convert_item(W, 1024, 512 * cb, 64 * kb, (bf16_t*)(ws + WS_W2), 512, e * 1024 + 512 * cb, -1, lds, tid);
            continue;
        }
        r -= I_W2;
        {
            const int g = r >> 3, d0 = (r & 7) * 128;
            const float* pw = a.in[7] + ((size_t)layer * 4 + g) * 128 * 128; const float* ps = a.in[8] + (size_t)layer * 512 + g * 128;
            const float* wc = a.in[11] + ((size_t)layer * 512 + g * 128) * 1024 + d0;
            LAS float* pws = (LAS float*)lds; LAS float* wcs = pws + 128 * 128;
            for (int i = tid; i < 128 * 128; i += NTHR) { pws[i] = pw[i] * ps[i & 127]; wcs[i] = wc[(size_t)(i >> 7) * 1024 + (i & 127)]; }
            __syncthreads();
            const int d = tid & 127, cg = __builtin_amdgcn_readfirstlane(tid >> 7);
            float acc[32];
#pragma unroll
            for (int j = 0; j < 32; ++j) acc[j] = 0.f;
            for (int c2 = 0; c2 < 128; ++c2) { const float wv = wcs[c2 * 128 + d];
#pragma unroll
                for (int j = 0; j < 32; ++j) acc[j] += pws[(cg * 32 + j) * 128 + c2] * wv; }
            bf16_t* dst = (bf16_t*)(ws + WS_WBR) + (size_t)2 * 1024 * 512 + (size_t)(d0 + d) * 512 + g * 128 + cg * 32;
#pragma unroll
            for (int j = 0; j < 4; ++j) { u32x4 o; o.x = pg8::cvt_pk_bf16(acc[8 * j], acc[8 * j + 1]); o.y = pg8::cvt_pk_bf16(acc[8 * j + 2], acc[8 * j + 3]); o.z = pg8::cvt_pk_bf16(acc[8 * j + 4], acc[8 * j + 5]); o.w = pg8::cvt_pk_bf16(acc[8 * j + 6], acc[8 * j + 7]);
                *(u32x4*)(dst + 8 * j) = o; }
            __syncthreads();
        }
    }
    {
        const float* we = a.in[18] + (size_t)layer * D * 32; const float* wgp = a.in[16] + (size_t)layer * D * 4;
        bf16_t* dst = (bf16_t*)(ws + WS_WRT);
        for (int i = gtid; i < 48 * 1024; i += GT) {
            const int n = i >> 10, k = i & 1023;
            const float w = (n < 32) ? we[(size_t)k * 32 + n] : (n < 36 ? wgp[(size_t)k * 4 + (n - 32)] : 0.f);
            const unsigned h = f2bf(w); const float lo = w - bf2f((unsigned short)h);
            dst[i] = (bf16_t)h; dst[48 * 1024 + i] = (bf16_t)f2bf(lo);
        }
    }
}

__device__ __forceinline__ void row_store_bf16(bf16_t* dst_row, const f32x4 (&v)[4], int lane) {
    unsigned long long* o8 = (unsigned long long*)dst_row + lane;
#pragma unroll
    for (int j = 0; j < 4; ++j) o8[64 * j] = (unsigned long long)pk2(v[j].x, v[j].y) | ((unsigned long long)pk2(v[j].z, v[j].w) << 32);
}
__device__ __forceinline__ void row_bd_logits(const f32x4 (&v)[4], const LAS float* wbd, float* bdl_row, int lane) {
    float acc[8];
#pragma unroll
    for (int i = 0; i < 8; ++i) acc[i] = 0.f;
#pragma unroll
    for (int j = 0; j < 4; ++j)
#pragma unroll
        for (int c = 0; c < 4; ++c) {
            const int k = 256 * j + 4 * lane + c; const float xv = v[j][c];
            const f32x4 w0 = *(const LAS f32x4*)(wbd + k * 8), w1 = *(const LAS f32x4*)(wbd + k * 8 + 4);
            acc[0] += xv * w0.x; acc[1] += xv * w0.y; acc[2] += xv * w0.z; acc[3] += xv * w0.w;
            acc[4] += xv * w1.x; acc[5] += xv * w1.y; acc[6] += xv * w1.z; acc[7] += xv * w1.w;
            if (c == 3) asm volatile("" ::: "memory");
        }
    float r = 0.f;
#pragma unroll
    for (int i = 0; i < 8; ++i) { const float s = wave_sum(acc[i]); r = (lane == i) ? s : r; }
    if (lane < 8) bdl_row[lane] = r;
}
__device__ __forceinline__ void stage_wbd(const float* w_in_layer, LAS float* wbd, int tid) {
    for (int k = tid; k < 1024; k += NTHR) {
        const f32x4 a0 = *(const f32x4*)(w_in_layer + (size_t)k * D_IN + OFF_BETA), a1 = *(const f32x4*)(w_in_layer + (size_t)k * D_IN + OFF_BETA + 4);
        *(LAS f32x4*)(wbd + k * 8) = a0; *(LAS f32x4*)(wbd + k * 8 + 4) = a1;
    }
    __syncthreads();
}

__device__ __forceinline__ void phase_xconv(const Args& a, LAS unsigned char* lds, int gw, int NGW, int lane, int tid) {
    LAS float* wbd = (LAS float*)(lds);
    stage_wbd(a.in[1], wbd, tid);
    const float* x = a.in[0]; bf16_t* XB = (bf16_t*)(a.ws + WS_XB); float* bdl = (float*)(a.ws + WS_BDL);
    for (int m = gw; m < T; m += NGW) {
        const f32x4* xr = (const f32x4*)(x + (size_t)m * D) + lane;
        f32x4 v[4];
#pragma unroll
        for (int j = 0; j < 4; ++j) v[j] = xr[64 * j];
        row_store_bf16(XB + (size_t)m * D, v, lane);
        row_bd_logits(v, wbd, bdl + (size_t)m * 8, lane);
    }
    __syncthreads();
}

__device__ __forceinline__ void phase_pool(const Args& a, int gw, int NGW, int lane) {
    const bf16_t* pool = (const bf16_t*)(a.ws + WS_POOL); bf16_t* pld = (bf16_t*)(a.ws + WS_PLD);
    const int g = lane >> 4, win = 2 << g;
    for (int blk = gw; blk < T / 32; blk += NGW) {
        const int m0 = blk * 32, tl0 = m0 & (SEQ - 1);
        float s[8];
#pragma unroll
        for (int i = 0; i < 8; ++i) s[i] = 0.f;
        for (int q = 1; q < 16; ++q) {
            if (q < win && tl0 - q >= 0) { const u32x4 w = *(const u32x4*)(pool + (size_t)(m0 - q) * 512 + 8 * lane);
                s[0] += bflo(w.x); s[1] += bfhi(w.x); s[2] += bflo(w.y); s[3] += bfhi(w.y); s[4] += bflo(w.z); s[5] += bfhi(w.z); s[6] += bflo(w.w); s[7] += bfhi(w.w); }
        }
        for (int r = 0; r < 32; ++r) {
            const int m = m0 + r, tl = tl0 + r;
            const u32x4 cur = *(const u32x4*)(pool + (size_t)m * 512 + 8 * lane);
            const int old = tl - win + 1;
            u32x4 w = {0u, 0u, 0u, 0u};
            if (old >= 0) w = *(const u32x4*)(pool + (size_t)(m - win + 1) * 512 + 8 * lane);
            s[0] += bflo(cur.x); s[1] += bfhi(cur.x); s[2] += bflo(cur.y); s[3] += bfhi(cur.y); s[4] += bflo(cur.z); s[5] += bfhi(cur.z); s[6] += bflo(cur.w); s[7] += bfhi(cur.w);
            const int n = (tl + 1 < win) ? tl + 1 : win;
            const float inv = 1.0f / (float)n;
            u32x4 o;
            o.x = pg8::cvt_pk_bf16(s[0] * inv - bflo(cur.x), s[1] * inv - bfhi(cur.x)); o.y = pg8::cvt_pk_bf16(s[2] * inv - bflo(cur.y), s[3] * inv - bfhi(cur.y));
            o.z = pg8::cvt_pk_bf16(s[4] * inv - bflo(cur.z), s[5] * inv - bfhi(cur.z)); o.w = pg8::cvt_pk_bf16(s[6] * inv - bflo(cur.w), s[7] * inv - bfhi(cur.w));
            *(u32x4*)(pld + (size_t)m * 512 + 8 * lane) = o;
            s[0] -= bflo(w.x); s[1] -= bfhi(w.x); s[2] -= bflo(w.y); s[3] -= bfhi(w.y); s[4] -= bflo(w.z); s[5] -= bfhi(w.z); s[6] -= bflo(w.w); s[7] -= bfhi(w.w);
        }
    }
}

__device__ __forceinline__ void phase_ln1(const Args& a, LAS unsigned char* lds, int layer, int gw, int NGW, int wave, int lane) {
    const float* xin = (layer == 0) ? a.in[0] : a.out;
    const bf16_t* mix = (const bf16_t*)(a.ws + WS_MIX);
    float* xo = a.out; bf16_t* XB = (bf16_t*)(a.ws + WS_XB);
    const float* lg_ = a.in[14] + (size_t)layer * D; const float* lb_ = a.in[15] + (size_t)layer * D;
    const float* bg = a.in[17] + (size_t)layer * 4; const float* be = a.in[19] + (size_t)layer * 32;
    const bf16_t* wrt = (const bf16_t*)(a.ws + WS_WRT);
    int* eid = (int*)(a.ws + WS_EID); float* wts = (float*)(a.ws + WS_WTS); int* hist = (int*)(a.ws + WS_HIST);
    LAS float* lgt = (LAS float*)(lds + wave * 4096);
    LAS int* hst = (LAS int*)(lds + wave * 4096 + 3072);
    if (lane < 32) hst[lane] = 0;
    f32x4 gv[4], bv[4];
#pragma unroll
    for (int j = 0; j < 4; ++j) { gv[j] = ((const f32x4*)lg_)[64 * j + lane]; bv[j] = ((const f32x4*)lb_)[64 * j + lane]; }
    const int fr = lane & 15, fq = lane >> 4;
    for (int grp = gw; grp < T / 16; grp += NGW) {
        f32x4 xa[4]; u32x2 ma[4];
        {
            const f32x4* xr = (const f32x4*)(xin + (size_t)(grp * 16) * D) + lane; const u32x2* mr = (const u32x2*)(mix + (size_t)(grp * 16) * D) + lane;
#pragma unroll
            for (int j = 0; j < 4; ++j) { xa[j] = xr[64 * j]; ma[j] = mr[64 * j]; }
        }
        for (int rr = 0; rr < 16; ++rr) {
            const int m = grp * 16 + rr;
            f32x4 v[4]; float s = 0.f;
#pragma unroll
            for (int j = 0; j < 4; ++j) { const f32x4 mf = {bflo(ma[j].x), bfhi(ma[j].x), bflo(ma[j].y), bfhi(ma[j].y)}; v[j] = xa[j] * DN_ALPHA + mf; s += (v[j].x + v[j].y) + (v[j].z + v[j].w); }
            if (rr + 1 < 16) {
                const f32x4* xr = (const f32x4*)(xin + (size_t)(m + 1) * D) + lane; const u32x2* mr = (const u32x2*)(mix + (size_t)(m + 1) * D) + lane;
#pragma unroll
                for (int j = 0; j < 4; ++j) { xa[j] = xr[64 * j]; ma[j] = mr[64 * j]; }
            }
            const float mean = wave_sum(s) * (1.f / D); float s2 = 0.f;
#pragma unroll
            for (int j = 0; j < 4; ++j) { v[j] = v[j] - mean; s2 += (v[j].x * v[j].x + v[j].y * v[j].y) + (v[j].z * v[j].z + v[j].w * v[j].w); }
            const float rstd = 1.f / sqrtf(wave_sum(s2) * (1.f / D) + LN_EPS);
#pragma unroll
            for (int j = 0; j < 4; ++j) v[j] = v[j] * rstd * gv[j] + bv[j];
            f32x4* orow = (f32x4*)(xo + (size_t)m * D) + lane;
#pragma unroll
            for (int j = 0; j < 4; ++j) orow[64 * j] = v[j];
            row_store_bf16(XB + (size_t)m * D, v, lane);
        }
        asm volatile("s_waitcnt vmcnt(0)" ::: "memory");
        f32x4 acc[3];
#pragma unroll
        for (int t = 0; t < 3; ++t) acc[t] = (f32x4){0.f, 0.f, 0.f, 0.f};
        const float* xrow = xo + (size_t)(grp * 16 + fr) * D + 8 * fq;
#pragma unroll 4
        for (int ks = 0; ks < 32; ++ks) {
            const f32x4 x0 = *(const f32x4*)(xrow + ks * 32), x1 = *(const f32x4*)(xrow + ks * 32 + 4);
            u32x4 hi; hi.x = pg8::cvt_pk_bf16(x0.x, x0.y); hi.y = pg8::cvt_pk_bf16(x0.z, x0.w); hi.z = pg8::cvt_pk_bf16(x1.x, x1.y); hi.w = pg8::cvt_pk_bf16(x1.z, x1.w);
            u32x4 lo; lo.x = pg8::cvt_pk_bf16(x0.x - bflo(hi.x), x0.y - bfhi(hi.x)); lo.y = pg8::cvt_pk_bf16(x0.z - bflo(hi.y), x0.w - bfhi(hi.y));
            lo.z = pg8::cvt_pk_bf16(x1.x - bflo(hi.z), x1.y - bfhi(hi.z)); lo.w = pg8::cvt_pk_bf16(x1.z - bflo(hi.w), x1.w - bfhi(hi.w));
            const bf16x8 Bh = __builtin_bit_cast(bf16x8, hi), Bl = __builtin_bit_cast(bf16x8, lo);
#pragma unroll
            for (int t = 0; t < 3; ++t) {
                const bf16x8 Ah = *(const bf16x8*)(wrt + (size_t)(t * 16 + fr) * 1024 + ks * 32 + 8 * fq), Al = *(const bf16x8*)(wrt + (size_t)(48 + t * 16 + fr) * 1024 + ks * 32 + 8 * fq);
                acc[t] = __builtin_amdgcn_mfma_f32_16x16x32_bf16(Ah, Bh, acc[t], 0, 0, 0);
                acc[t] = __builtin_amdgcn_mfma_f32_16x16x32_bf16(Ah, Bl, acc[t], 0, 0, 0);
                acc[t] = __builtin_amdgcn_mfma_f32_16x16x32_bf16(Al, Bh, acc[t], 0, 0, 0);
            }
        }
#pragma unroll
        for (int t = 0; t < 3; ++t) *(LAS f32x4*)(lgt + fr * 48 + t * 16 + 4 * fq) = acc[t];
        asm volatile("s_waitcnt lgkmcnt(0)" ::: "memory");
        if (lane < 16) {
            const int m = grp * 16 + lane; const LAS float* lr = lgt + lane * 48;
            float ag[4];
#pragma unroll
            for (int i = 0; i < 4; ++i) ag[i] = lr[32 + i] + bg[i];
            int gsel = 0; float gm = ag[0];
#pragma unroll
            for (int i = 1; i < 4; ++i) if (ag[i] > gm) { gm = ag[i]; gsel = i; }
            float gs = 0.f;
#pragma unroll
            for (int i = 0; i < 4; ++i) gs += expf(ag[i] - gm);
            const float p_top = 1.0f / gs;
            float le[8];
#pragma unroll
            for (int i = 0; i < 8; ++i) le[i] = lr[gsel * 8 + i] + be[gsel * 8 + i];
            int i0 = 0; float l0 = le[0];
#pragma unroll
            for (int i = 1; i < 8; ++i) if (le[i] > l0) { l0 = le[i]; i0 = i; }
            int i1 = -1; float l1 = -3.0e38f;
#pragma unroll
            for (int i = 0; i < 8; ++i) if (i != i0 && le[i] > l1) { l1 = le[i]; i1 = i; }
            const float ex = expf(l1 - l0); const float w0 = p_top / (1.0f + ex), w1 = p_top * ex / (1.0f + ex);
            const int e0 = gsel * 8 + i0, e1 = gsel * 8 + i1;
            eid[2 * m] = e0; eid[2 * m + 1] = e1; wts[2 * m] = w0; wts[2 * m + 1] = w1;
            __hip_atomic_fetch_add(hst + e0, 1, __ATOMIC_RELAXED, __HIP_MEMORY_SCOPE_WORKGROUP); __hip_atomic_fetch_add(hst + e1, 1, __ATOMIC_RELAXED, __HIP_MEMORY_SCOPE_WORKGROUP);
        }
        asm volatile("s_waitcnt lgkmcnt(0)" ::: "memory");
    }
    if (lane < 32) hist[gw * 32 + lane] = hst[lane];
}

__device__ __forceinline__ void phase_slots(const Args& a, LAS unsigned char* lds, int gw, int NGW, int wave, int lane, int tid) {
    LAS int* red = (LAS int*)lds;
    LAS int* tot = red + 1024;
    LAS int* bef = tot + 32;
    LAS int* pst = bef + 32;
    LAS int* base = pst + 64;
    const int* hist = (const int*)(a.ws + WS_HIST);
    const int nwv = NGW;
    const int wg0 = gw - wave;
    {
        const int e = tid & 31, part = tid >> 5;
        const int per = (nwv + 15) / 16; const int lo = part * per, hi = (lo + per < nwv) ? lo + per : nwv;
        int st = 0, sb = 0;
        for (int g = lo; g < hi; ++g) { const int v = hist[g * 32 + e]; st += v; sb += (g < wg0) ? v : 0; }
        red[part * 32 + e] = st; red[512 + part * 32 + e] = sb;
    }
    __syncthreads();
    if (tid < 32) { int st = 0, sb = 0; for (int p = 0; p < 16; ++p) { st += red[p * 32 + tid]; sb += red[512 + p * 32 + tid]; } tot[tid] = st; bef[tid] = sb; }
    __syncthreads();
    if (tid == 0) { int acc = 0; for (int e = 0; e < 32; ++e) { pst[e] = acc; acc += (tot[e] + MOE_BLOCK - 1) / MOE_BLOCK * MOE_BLOCK; } pst[32] = acc; }
    __syncthreads();
    if (tid < 32) { int acc = pst[tid] + bef[tid]; for (int w = 0; w < NWAVES; ++w) { base[w * 32 + tid] = acc; acc += hist[(wg0 + w) * 32 + tid]; } }
    __syncthreads();
    if (blockIdx.x == 0) {
        int* blk_e = (int*)(a.ws + WS_BLKE);
        const int nblk = pst[32] / MOE_BLOCK;
        if (tid == 0) blk_e[1023] = nblk;
        for (int b = tid; b < nblk; b += NTHR) { int e = 0; for (int q = 0; q < 32; ++q) if (pst[q] <= b * MOE_BLOCK) e = q; blk_e[b] = e; }
    }
    const int* eid = (const int*)(a.ws + WS_EID); int* slot = (int*)(a.ws + WS_SLOT);
    const bf16_t* XB = (const bf16_t*)(a.ws + WS_XB); bf16_t* xg = (bf16_t*)(a.ws + WS_XG);
    int cnt = (lane < 32) ? base[wave * 32 + lane] : 0;
    for (int grp = gw; grp < T / 16; grp += NGW)
    for (int rr = 0; rr < 16; ++rr) {
        const int m = grp * 16 + rr;
        const int e0 = eid[2 * m], e1 = eid[2 * m + 1];
        const int s0 = __shfl(cnt, e0); cnt += (lane == e0) ? 1 : 0;
        const int s1 = __shfl(cnt, e1); cnt += (lane == e1) ? 1 : 0;
        if (lane == 0) { slot[2 * m] = s0; slot[2 * m + 1] = s1; }
        const u32x4* src = (const u32x4*)(XB + (size_t)m * D) + lane;
        const u32x4 p0 = src[0], p1 = src[64];
        u32x4* d0 = (u32x4*)(xg + (size_t)s0 * D) + lane; u32x4* d1 = (u32x4*)(xg + (size_t)s1 * D) + lane;
        d0[0] = p0; d0[64] = p1; d1[0] = p0; d1[64] = p1;
    }
    __syncthreads();
}

__device__ __forceinline__ void phase_ln2(const Args& a, LAS unsigned char* lds, int layer, int gw, int NGW, int lane, int tid) {
    LAS float* wbd = (LAS float*)(lds);
    const bool has_next = (layer + 1 < DEPTH);
    if (has_next) stage_wbd(a.in[1] + (size_t)(layer + 1) * D * D_IN, wbd, tid);
    float* xo = a.out; bf16_t* XB = (bf16_t*)(a.ws + WS_XB); float* bdl = (float*)(a.ws + WS_BDL);
    const bf16_t* ymoe = (const bf16_t*)(a.ws + WS_YMOE);
    const int* slot = (const int*)(a.ws + WS_SLOT); const float* wts = (const float*)(a.ws + WS_WTS);
    const float* lg_ = a.in[23] + (size_t)layer * D; const float* lb_ = a.in[24] + (size_t)layer * D;
    LAS f32x4* gbl = (LAS f32x4*)(lds + 32768);
    for (int i = tid; i < 256; i += NTHR) { gbl[i] = ((const f32x4*)lg_)[i]; gbl[256 + i] = ((const f32x4*)lb_)[i]; }
    __syncthreads();
    const int nrows = (T - gw + NGW - 1) / NGW;
    for (int i0 = 0; i0 < nrows; i0 += 64) {
        const int nb = (nrows - i0 < 64) ? nrows - i0 : 64;
        int sl0 = 0, sl1 = 0; float ww0 = 0.f, ww1 = 0.f;
        if (lane < nb) { const int mm = gw + (i0 + lane) * NGW; sl0 = slot[2 * mm]; sl1 = slot[2 * mm + 1]; ww0 = wts[2 * mm]; ww1 = wts[2 * mm + 1]; }
        f32x4 xa[4]; unsigned long long ya0[4], ya1[4];
        {
            const int m = gw + i0 * NGW; const int s0 = __builtin_amdgcn_readlane(sl0, 0), s1 = __builtin_amdgcn_readlane(sl1, 0);
            const f32x4* xr = (const f32x4*)(xo + (size_t)m * D) + lane;
            const unsigned long long* y0 = (const unsigned long long*)(ymoe + (size_t)s0 * D) + lane; const unsigned long long* y1 = (const unsigned long long*)(ymoe + (size_t)s1 * D) + lane;
#pragma unroll
            for (int j = 0; j < 4; ++j) { xa[j] = xr[64 * j]; ya0[j] = y0[64 * j]; ya1[j] = y1[64 * j]; }
        }
        for (int i = 0; i < nb; ++i) {
            const int m = gw + (i0 + i) * NGW;
            const float w0 = __builtin_bit_cast(float, __builtin_amdgcn_readlane(__builtin_bit_cast(int, ww0), i)), w1 = __builtin_bit_cast(float, __builtin_amdgcn_readlane(__builtin_bit_cast(int, ww1), i));
            f32x4 xc[4]; unsigned long long yc0[4], yc1[4];
#pragma unroll
            for (int j = 0; j < 4; ++j) { xc[j] = xa[j]; yc0[j] = ya0[j]; yc1[j] = ya1[j]; }
            if (i + 1 < nb) {
                const int mn = m + NGW; const int s0 = __builtin_amdgcn_readlane(sl0, i + 1), s1 = __builtin_amdgcn_readlane(sl1, i + 1);
                const f32x4* xr = (const f32x4*)(xo + (size_t)mn * D) + lane;
                const unsigned long long* y0 = (const unsigned long long*)(ymoe + (size_t)s0 * D) + lane; const unsigned long long* y1 = (const unsigned long long*)(ymoe + (size_t)s1 * D) + lane;
#pragma unroll
                for (int j = 0; j < 4; ++j) { xa[j] = xr[64 * j]; ya0[j] = y0[64 * j]; ya1[j] = y1[64 * j]; }
            }
            f32x4 v[4]; float s = 0.f;
#pragma unroll
            for (int j = 0; j < 4; ++j) {
                const unsigned long long p = yc0[j], q = yc1[j];
                f32x4 f; f.x = w0 * bflo((unsigned)p) + w1 * bflo((unsigned)q); f.y = w0 * bfhi((unsigned)p) + w1 * bfhi((unsigned)q);
                f.z = w0 * bflo((unsigned)(p >> 32)) + w1 * bflo((unsigned)(q >> 32)); f.w = w0 * bfhi((unsigned)(p >> 32)) + w1 * bfhi((unsigned)(q >> 32));
                v[j] = xc[j] * DN_ALPHA + f; s += (v[j].x + v[j].y) + (v[j].z + v[j].w);
            }
            const float mean = wave_sum(s) * (1.f / D); float s2 = 0.f;
#pragma unroll
            for (int j = 0; j < 4; ++j) { v[j] = v[j] - mean; s2 += (v[j].x * v[j].x + v[j].y * v[j].y) + (v[j].z * v[j].z + v[j].w * v[j].w); }
            const float rstd = 1.f / sqrtf(wave_sum(s2) * (1.f / D) + LN_EPS);
#pragma unroll
            for (int j = 0; j < 4; ++j) v[j] = v[j] * rstd * gbl[64 * j + lane] + gbl[256 + 64 * j + lane];
            f32x4* orow = (f32x4*)(xo + (size_t)m * D) + lane;
#pragma unroll
            for (int j = 0; j < 4; ++j) orow[64 * j] = v[j];
            if (has_next) { row_store_bf16(XB + (size_t)m * D, v, lane); row_bd_logits(v, wbd, bdl + (size_t)m * 8, lane); }
        }
    }
    __syncthreads();
}


template <class F> struct EpiP8 { static constexpr bool PERM = true, AFTER_DRAIN = false; F f;
    __device__ __forceinline__ void operator()(const f32x4 (&acc)[2][2][4][2], const pg8::Unit& u, int wr, int wc, int fr, int fq) const {
        const int row0 = u.pm * 256 + wr * 64 + fr, col0 = u.pn * 256 + wc * 32 + 8 * fq;
#pragma unroll
        for (int ai = 0; ai < 2; ++ai)
#pragma unroll
            for (int m = 0; m < 4; ++m)
#pragma unroll
                for (int bj = 0; bj < 2; ++bj) f(row0 + ai * 128 + m * 16, col0 + bj * 128, u.pn, acc[ai][bj][m][0], acc[ai][bj][m][1]);
    } };
template <class F> struct EpiPair { static constexpr bool PERM = true, AFTER_DRAIN = false; F f;
    __device__ __forceinline__ void operator()(const f32x4 (&acc)[2][2][4][2], const pg8::Unit& u, int wr, int wc, int fr, int fq) const {
        const int row0 = u.pm * 256 + wr * 64 + fr, col0 = u.pn * 256 + wc * 32 + 8 * fq;
#pragma unroll
        for (int ai = 0; ai < 2; ++ai)
#pragma unroll
            for (int m = 0; m < 4; ++m) f(row0 + ai * 128 + m * 16, col0, acc[ai][0][m][0], acc[ai][0][m][1], acc[ai][1][m][0], acc[ai][1][m][1]);
    } };
template <class F> struct EpiP4 { static constexpr bool PERM = false, AFTER_DRAIN = false; F f;
    __device__ __forceinline__ void operator()(const f32x4 (&acc)[2][2][4][2], const pg8::Unit& u, int wr, int wc, int fr, int fq) const {
        const int row0 = u.pm * 256 + wr * 64 + fr, col0 = u.pn * 256 + wc * 32 + 4 * fq;
#pragma unroll
        for (int ai = 0; ai < 2; ++ai)
#pragma unroll
            for (int m = 0; m < 4; ++m)
#pragma unroll
                for (int bj = 0; bj < 2; ++bj)
#pragma unroll
                    for (int n = 0; n < 2; ++n) f(row0 + ai * 128 + m * 16, col0 + bj * 128 + n * 16, acc[ai][bj][m][n]);
    } };
__device__ __forceinline__ u32x4 pack8(f32x4 a, f32x4 b) { u32x4 w; w.x = pg8::cvt_pk_bf16(a.x, a.y); w.y = pg8::cvt_pk_bf16(a.z, a.w); w.z = pg8::cvt_pk_bf16(b.x, b.y); w.w = pg8::cvt_pk_bf16(b.z, b.w); return w; }
__device__ __forceinline__ float fsig(float x) { return __builtin_amdgcn_rcpf(1.0f + __expf(-x)); }
struct F_Proj1 { unsigned char* ws;
    __device__ __forceinline__ void operator()(int row, int col, int pn, f32x4 a, f32x4 b) const {
        bf16_t* p;
        if (pn < 2) p = (bf16_t*)(ws + WS_QA) + (size_t)row * 512 + col;
        else if (pn < 4) p = (bf16_t*)(ws + WS_KA) + (size_t)row * 512 + (col - 512);
        else if (pn < 10) p = (bf16_t*)(ws + WS_QKVB) + (size_t)row * 1536 + (col - 1024);
        else if (pn < 12) p = (bf16_t*)(ws + WS_GATEB) + (size_t)row * 512 + (col - 2560);
        else p = (bf16_t*)(ws + WS_POOL) + (size_t)row * 512 + (col - 3072);
        *(u32x4*)p = pack8(a, b); } };
struct F_Bf16 { bf16_t* O; int ldc, cmask;
    __device__ __forceinline__ void operator()(int row, int col, int, f32x4 a, f32x4 b) const { *(u32x4*)(O + (size_t)row * ldc + (col & cmask)) = pack8(a, b); } };
struct F_Gates { bf16_t* O; const float* gb;
    __device__ __forceinline__ void operator()(int row, int col, int, f32x4 a, f32x4 b) const { const f32x4 b0 = *(const f32x4*)(gb + col), b1 = *(const f32x4*)(gb + col + 4);
        a = a + b0; b = b + b1; a.x = fsig(a.x); a.y = fsig(a.y); a.z = fsig(a.z); a.w = fsig(a.w); b.x = fsig(b.x); b.y = fsig(b.y); b.z = fsig(b.z); b.w = fsig(b.w);
        *(u32x4*)(O + (size_t)row * 3072 + col) = pack8(a, b); } };
template <int WHICH> struct F_Branch { bf16_t* Y; const bf16_t* gates;
    __device__ __forceinline__ void operator()(int row, int col, int, f32x4 a, f32x4 b) const {
        const u32x4 g = *(const u32x4*)(gates + (size_t)row * 3072 + WHICH * 1024 + col);
        a.x *= bflo(g.x); a.y *= bfhi(g.x); a.z *= bflo(g.y); a.w *= bfhi(g.y); b.x *= bflo(g.z); b.y *= bfhi(g.z); b.z *= bflo(g.w); b.w *= bfhi(g.w);
        bf16_t* yp = Y + (size_t)row * 1024 + col;
        if (WHICH > 0) { const u32x4 o = *(const u32x4*)yp; a.x += bflo(o.x); a.y += bfhi(o.x); a.z += bflo(o.y); a.w += bfhi(o.y); b.x += bflo(o.z); b.y += bfhi(o.z); b.z += bflo(o.w); b.w += bfhi(o.w); }
        *(u32x4*)yp = pack8(a, b); } };
struct F_F32 { float* O; int ldc;
    __device__ __forceinline__ void operator()(int row, int col, f32x4 v) const { *(f32x4*)(O + (size_t)row * ldc + col) = v; } };
struct F_Hdn { bf16_t* H;
    __device__ __forceinline__ void operator()(int row, int col, f32x4 a0, f32x4 a1, f32x4 b0, f32x4 b1) const {
        const int hc = ((col >> 8) & 3) * 128 + (col & 127);
        a0.x = a0.x * fsig(a0.x) * b0.x; a0.y = a0.y * fsig(a0.y) * b0.y; a0.z = a0.z * fsig(a0.z) * b0.z; a0.w = a0.w * fsig(a0.w) * b0.w;
        a1.x = a1.x * fsig(a1.x) * b1.x; a1.y = a1.y * fsig(a1.y) * b1.y; a1.z = a1.z * fsig(a1.z) * b1.z; a1.w = a1.w * fsig(a1.w) * b1.w;
        *(u32x4*)(H + (size_t)row * 512 + hc) = pack8(a0, a1); } };
struct MoeOrder { const LAS int* tab; int nunits, G, c;
    __device__ __forceinline__ bool next(int i, pg8::Unit& u) const { const int cs = ((G & 7) == 0) ? (c & 7) * (G >> 3) + (c >> 3) : c; const int L = i * G + cs; if (L >= nunits) return false; const int blk = L >> 2; u.pm = blk; u.pn = tab[blk] * 4 + (L & 3); return true; }
    __device__ __forceinline__ void a_ready(const pg8::Unit&) const {}
    __device__ __forceinline__ void done(const pg8::Unit&) const {} };
constexpr int LDS_TAB_OFF = 131072;

__device__ __forceinline__ void phase_g_proj1(const Args& a, LAS unsigned char* lds, int G, int c, int wave, int lane) {
    const bf16_t* XB = (const bf16_t*)(a.ws + WS_XB);
    { pg8::Gemm g{XB, (const bf16_t*)(a.ws + WS_WIN1), T, N1, 1024}; pg8::StaticOrder S; S.init(T, N1, G, c); EpiP8<F_Proj1> E{F_Proj1{a.ws}};
      pg8::gemm_phase<EpiP8<F_Proj1>, pg8::StaticOrder, true, true>(lds, g, S, E, wave, lane); }
    { pg8::Gemm g{(const bf16_t*)(a.ws + WS_WV), XB, 512, T, 1024}; pg8::StaticOrder S; S.init(512, T, G, c); EpiP8<F_Bf16> E{F_Bf16{(bf16_t*)(a.ws + WS_VT), T, 0x7fffffff}};
      pg8::gemm_phase<EpiP8<F_Bf16>, pg8::StaticOrder, true, true>(lds, g, S, E, wave, lane); }
}
__device__ __forceinline__ void phase_g_gates(const Args& a, LAS unsigned char* lds, int layer, int G, int c, int wave, int lane) {
    pg8::Gemm g{(const bf16_t*)(a.ws + WS_XB), (const bf16_t*)(a.ws + WS_WG), T, 3072, 1024}; pg8::StaticOrder S; S.init(T, 3072, G, c);
    EpiP8<F_Gates> E{F_Gates{(bf16_t*)(a.ws + WS_GATES), a.in[12] + (size_t)layer * 3072}};
    pg8::gemm_phase<EpiP8<F_Gates>, pg8::StaticOrder, true, true>(lds, g, S, E, wave, lane);
}
__device__ __forceinline__ void phase_g_branch(const Args& a, LAS unsigned char* lds, int G, int c, int wave, int lane) {
    bf16_t* Y = (bf16_t*)(a.ws + WS_Y); const bf16_t* gates = (const bf16_t*)(a.ws + WS_GATES); const bf16_t* W = (const bf16_t*)(a.ws + WS_WBR);
    pg8::StaticOrder S; S.init(T, 1024, G, c);
    { pg8::Gemm g{(const bf16_t*)(a.ws + WS_OA), W, T, 1024, 512}; EpiP8<F_Branch<0>> E{F_Branch<0>{Y, gates}}; pg8::gemm_phase<EpiP8<F_Branch<0>>, pg8::StaticOrder, true, true>(lds, g, S, E, wave, lane); }
    { pg8::Gemm g{(const bf16_t*)(a.ws + WS_OB), W + (size_t)1024 * 512, T, 1024, 512}; EpiP8<F_Branch<1>> E{F_Branch<1>{Y, gates}}; pg8::gemm_phase<EpiP8<F_Branch<1>>, pg8::StaticOrder, true, true>(lds, g, S, E, wave, lane); }
    { pg8::Gemm g{(const bf16_t*)(a.ws + WS_PLD), W + (size_t)2 * 1024 * 512, T, 1024, 512}; EpiP8<F_Branch<2>> E{F_Branch<2>{Y, gates}}; pg8::gemm_phase<EpiP8<F_Branch<2>>, pg8::StaticOrder, true, true>(lds, g, S, E, wave, lane); }
}
__device__ __forceinline__ void phase_g_out(const Args& a, LAS unsigned char* lds, int G, int c, int wave, int lane) {
    pg8::Gemm g{(const bf16_t*)(a.ws + WS_Y), (const bf16_t*)(a.ws + WS_WOUT), T, 1024, 1024}; pg8::StaticOrder S; S.init(T, 1024, G, c);
    EpiP8<F_Bf16> E{F_Bf16{(bf16_t*)(a.ws + WS_MIX), 1024, 0x7fffffff}};
    pg8::gemm_phase<EpiP8<F_Bf16>, pg8::StaticOrder, true, true>(lds, g, S, E, wave, lane);
}
__device__ __forceinline__ void moe_table(const Args& a, LAS unsigned char* lds, MoeOrder& S, int G, int c, int tid) {
    const int* blk_e = (const int*)(a.ws + WS_BLKE); LAS int* tab = (LAS int*)(lds + LDS_TAB_OFF);
    const int nblk = blk_e[1023];
    for (int i = tid; i < nblk; i += NTHR) tab[i] = blk_e[i];
    __syncthreads();
    S.tab = tab; S.nunits = nblk * 4; S.G = G; S.c = c;
}
__device__ __forceinline__ void phase_moe1(const Args& a, LAS unsigned char* lds, int G, int c, int tid, int wave, int lane) {
    MoeOrder S; moe_table(a, lds, S, G, c, tid);
    pg8::Gemm g{(const bf16_t*)(a.ws + WS_XG), (const bf16_t*)(a.ws + WS_W13), CAP, NEXP * 1024, 1024};
    EpiPair<F_Hdn> E{F_Hdn{(bf16_t*)(a.ws + WS_HDN)}};
    pg8::gemm_phase<EpiPair<F_Hdn>, MoeOrder, true, true>(lds, g, S, E, wave, lane);
}
__device__ __forceinline__ void phase_moe2(const Args& a, LAS unsigned char* lds, int G, int c, int tid, int wave, int lane) {
    MoeOrder S; moe_table(a, lds, S, G, c, tid);
    pg8::Gemm g{(const bf16_t*)(a.ws + WS_HDN), (const bf16_t*)(a.ws + WS_W2), CAP, NEXP * 1024, 512};
    EpiP8<F_Bf16> E{F_Bf16{(bf16_t*)(a.ws + WS_YMOE), 1024, 1023}};
    pg8::gemm_phase<EpiP8<F_Bf16>, MoeOrder, true, true>(lds, g, S, E, wave, lane);
}


__device__ __forceinline__ void attn_stage_bias(const Args& a, LAS unsigned char* lds, int layer, int tid) {
    LAS float* rb = (LAS float*)lds;
    const float* relb = a.in[2] + (size_t)layer * A_HEADS * A_NREL;
    for (int i = tid; i < A_HEADS * 384; i += NTHR) { const int hh = i / 384, j = i % 384; rb[i] = relb[hh * A_NREL + (j < A_NREL - 1 ? j : A_NREL - 1)] * 1.4426950408889634f; }
    __syncthreads();
}
__device__ __forceinline__ void attn_item(const Args& a, const LAS float* rb, int item, int lane) {
    const bf16_t* qA = (const bf16_t*)(a.ws + WS_QA); const bf16_t* kA = (const bf16_t*)(a.ws + WS_KA); const bf16_t* vT = (const bf16_t*)(a.ws + WS_VT); bf16_t* oA = (bf16_t*)(a.ws + WS_OA);
    const int fr = lane & 15, fq = lane >> 4;
    const int hq = item & 1, ci = (item >> 1) & 31, h = (item >> 6) & 7, b = item >> 9;
    const size_t tokq = (size_t)b * SEQ + ci * 64 + hq * 32;
    bf16x8 Bq[2][2];
#pragma unroll
    for (int qt = 0; qt < 2; ++qt)
#pragma unroll
        for (int ks = 0; ks < 2; ++ks) Bq[qt][ks] = *(const bf16x8*)(qA + (tokq + qt * 16 + fr) * 512 + h * 64 + ks * 32 + 8 * fq);
    f32x4 O[4][2];
#pragma unroll
    for (int dt = 0; dt < 4; ++dt) { O[dt][0] = (f32x4){0.f, 0.f, 0.f, 0.f}; O[dt][1] = (f32x4){0.f, 0.f, 0.f, 0.f}; }
    float mrun[2] = {-1.0e30f, -1.0e30f}, lrun[2] = {0.f, 0.f};
    const LAS float* rbh = rb + h * A_NREL;
    const float SC = 0.125f * 1.4426950408889634f;
    const int kc_lo = ci >= 8 ? ci - 8 : 0;
    for (int kc = kc_lo; kc <= ci; ++kc) {
        const int t = ci - kc;
        const size_t tokk = (size_t)b * SEQ + kc * 64;
        f32x4 S[4][2];
#pragma unroll
        for (int kt = 0; kt < 4; ++kt) {
            const bf16_t* kp = kA + (tokk + kt * 16 + fr) * 512 + h * 64 + 8 * fq;
            const bf16x8 Ak0 = *(const bf16x8*)kp, Ak1 = *(const bf16x8*)(kp + 32);
#pragma unroll
            for (int qt = 0; qt < 2; ++qt) {
                f32x4 z = (f32x4){0.f, 0.f, 0.f, 0.f};
                z = __builtin_amdgcn_mfma_f32_16x16x32_bf16(Ak0, Bq[qt][0], z, 0, 0, 0);
                S[kt][qt] = __builtin_amdgcn_mfma_f32_16x16x32_bf16(Ak1, Bq[qt][1], z, 0, 0, 0);
            }
        }
        if (t >= 5) {
            const float cb = rbh[319];
#pragma unroll
            for (int kt = 0; kt < 4; ++kt)
#pragma unroll
                for (int qt = 0; qt < 2; ++qt) S[kt][qt] = S[kt][qt] * SC + cb;
        } else {
#pragma unroll
            for (int kt = 0; kt < 4; ++kt)
#pragma unroll
                for (int qt = 0; qt < 2; ++qt)
#pragma unroll
                    for (int r = 0; r < 4; ++r) {
                        int dist = (hq * 32 + qt * 16 + fr) - (kt * 16 + 4 * fq + r) + 64 * t; dist = dist > A_CLIP ? A_CLIP : dist;
                        S[kt][qt][r] = S[kt][qt][r] * SC + rbh[dist + 63];
                    }
        }
#pragma unroll
        for (int qt = 0; qt < 2; ++qt) {
            float mx = S[0][qt][0];
#pragma unroll
            for (int kt = 0; kt < 4; ++kt)
#pragma unroll
                for (int r = 0; r < 4; ++r) mx = fmaxf(mx, S[kt][qt][r]);
            mx = fmaxf(mx, __shfl_xor(mx, 16)); mx = fmaxf(mx, __shfl_xor(mx, 32));
            const float mn = fmaxf(mrun[qt], mx), al = __builtin_amdgcn_exp2f(mrun[qt] - mn); mrun[qt] = mn;
            float ps = 0.f;
#pragma unroll
            for (int kt = 0; kt < 4; ++kt)
#pragma unroll
                for (int r = 0; r < 4; ++r) { const float p = __builtin_amdgcn_exp2f(S[kt][qt][r] - mn); S[kt][qt][r] = p; ps += p; }
            lrun[qt] = lrun[qt] * al + ps;
#pragma unroll
            for (int dt = 0; dt < 4; ++dt) O[dt][qt] = O[dt][qt] * al;
        }
        bf16x8 Bp[2][2];
#pragma unroll
        for (int qt = 0; qt < 2; ++qt)
#pragma unroll
            for (int s2 = 0; s2 < 2; ++s2) { const u32x4 w = pack8(S[2 * s2][qt], S[2 * s2 + 1][qt]); Bp[qt][s2] = __builtin_bit_cast(bf16x8, w); }
#pragma unroll
        for (int dt = 0; dt < 4; ++dt)
#pragma unroll
            for (int s2 = 0; s2 < 2; ++s2) {
                const bf16_t* vp = vT + (size_t)(h * 64 + dt * 16 + fr) * T + tokk + 32 * s2 + 4 * fq;
                const u32x2 lo = *(const u32x2*)vp, hi = *(const u32x2*)(vp + 16);
                const u32x4 w = {lo.x, lo.y, hi.x, hi.y}; const bf16x8 Av = __builtin_bit_cast(bf16x8, w);
#pragma unroll
                for (int qt = 0; qt < 2; ++qt) O[dt][qt] = __builtin_amdgcn_mfma_f32_16x16x32_bf16(Av, Bp[qt][s2], O[dt][qt], 0, 0, 0);
            }
    }
#pragma unroll
    for (int qt = 0; qt < 2; ++qt) {
        float l = lrun[qt]; l += __shfl_xor(l, 16); l += __shfl_xor(l, 32);
        const float inv = 1.0f / l;
#pragma unroll
        for (int dt = 0; dt < 4; ++dt) {
            const f32x4 o = O[dt][qt] * inv; u32x2 w; w.x = pg8::cvt_pk_bf16(o.x, o.y); w.y = pg8::cvt_pk_bf16(o.z, o.w);
            *(u32x2*)(oA + (tokq + qt * 16 + fr) * 512 + h * 64 + dt * 16 + 4 * fq) = w;
        }
    }
}
constexpr int AT_KV = 16384, AT_PITCH = 144, AT_TILE = 64 * AT_PITCH, AT_BUF = 2 * AT_TILE;
static_assert(AT_KV + 4 * AT_BUF <= 131072, "attention LDS map");
__device__ __forceinline__ void attn_group(const Args& a, LAS unsigned char* lds, const LAS float* rb, int grp, int wave, int lane, int tid) {
    const bf16_t* qA = (const bf16_t*)(a.ws + WS_QA); const bf16_t* kA = (const bf16_t*)(a.ws + WS_KA); const bf16_t* vT = (const bf16_t*)(a.ws + WS_VT); bf16_t* oA = (bf16_t*)(a.ws + WS_OA);
    const int fr = lane & 15, fq = lane >> 4;
    const int cg = grp & 7, h = (grp >> 3) & 7, b = grp >> 6;
    const int ci = cg * 4 + (wave >> 1), hq = wave & 1;
    const size_t tokq = (size_t)b * SEQ + ci * 64 + hq * 32;
    bf16x8 Bq[2][2];
#pragma unroll
    for (int qt = 0; qt < 2; ++qt)
#pragma unroll
        for (int ks = 0; ks < 2; ++ks) Bq[qt][ks] = *(const bf16x8*)(qA + (tokq + qt * 16 + fr) * 512 + h * 64 + ks * 32 + 8 * fq);
    f32x4 O[4][2];
#pragma unroll
    for (int dt = 0; dt < 4; ++dt) { O[dt][0] = (f32x4){0.f, 0.f, 0.f, 0.f}; O[dt][1] = (f32x4){0.f, 0.f, 0.f, 0.f}; }
    float mrun[2] = {-1.0e30f, -1.0e30f}, lrun[2] = {0.f, 0.f};
    const LAS float* rbh = rb + h * 384;
    const float SC = 0.125f * 1.4426950408889634f;
    const int kc_first = (cg * 4 >= 8) ? cg * 4 - 8 : 0, kc_last = cg * 4 + 3;
    const int srow = tid >> 3, sch = tid & 7;
    const bf16_t* kg = kA + ((size_t)b * SEQ + srow) * 512 + h * 64 + sch * 8;
    const bf16_t* vg = vT + (size_t)(h * 64 + srow) * T + (size_t)b * SEQ + sch * 8;
    const int sdst = AT_KV + srow * AT_PITCH + sch * 16;
    for (int k0 = kc_first; k0 <= kc_last; k0 += 4) {
        {
            u32x4 kr[4], vr[4];
#pragma unroll
            for (int j = 0; j < 4; ++j) { kr[j] = *(const u32x4*)(kg + (size_t)(k0 + j) * 64 * 512); vr[j] = *(const u32x4*)(vg + (size_t)(k0 + j) * 64); }
#pragma unroll
            for (int j = 0; j < 4; ++j) { *(LAS u32x4*)(lds + sdst + j * AT_BUF) = kr[j]; *(LAS u32x4*)(lds + sdst + j * AT_BUF + AT_TILE) = vr[j]; }
        }
        __syncthreads();
#pragma unroll 1
        for (int j = 0; j < 4; ++j) {
        const int kc = k0 + j, t = ci - kc;
        const int kbase = AT_KV + j * AT_BUF, vbase = kbase + AT_TILE;
        if (t >= 0 && t <= 8) {
            f32x4 S[4][2];
#pragma unroll
            for (int kt = 0; kt < 4; ++kt) {
                const bf16x8 Ak0 = *(const LAS bf16x8*)(lds + kbase + (kt * 16 + fr) * AT_PITCH + fq * 16), Ak1 = *(const LAS bf16x8*)(lds + kbase + (kt * 16 + fr) * AT_PITCH + 64 + fq * 16);
#pragma unroll
                for (int qt = 0; qt < 2; ++qt) {
                    f32x4 z = (f32x4){0.f, 0.f, 0.f, 0.f};
                    z = __builtin_amdgcn_mfma_f32_16x16x32_bf16(Ak0, Bq[qt][0], z, 0, 0, 0);
                    S[kt][qt] = __builtin_amdgcn_mfma_f32_16x16x32_bf16(Ak1, Bq[qt][1], z, 0, 0, 0);
                }
            }
            if (t >= 5) {
                const float cb = rbh[319];
#pragma unroll
                for (int kt = 0; kt < 4; ++kt)
#pragma unroll
                    for (int qt = 0; qt < 2; ++qt) S[kt][qt] = S[kt][qt] * SC + cb;
            } else {
                int bi = hq * 32 + fr - 4 * fq + 64 * t + 12; asm volatile("" : "+v"(bi));
                const LAS float* pb = rbh + bi;
#pragma unroll
                for (int kt = 0; kt < 4; ++kt)
#pragma unroll
                    for (int qt = 0; qt < 2; ++qt) {
                        const f32x4 b4 = {pb[51 + 16 * qt - 16 * kt], pb[50 + 16 * qt - 16 * kt], pb[49 + 16 * qt - 16 * kt], pb[48 + 16 * qt - 16 * kt]};
                        S[kt][qt] = S[kt][qt] * SC + b4;
                    }
            }
#pragma unroll
            for (int qt = 0; qt < 2; ++qt) {
                const f32x4 m4 = __builtin_elementwise_max(__builtin_elementwise_max(S[0][qt], S[1][qt]), __builtin_elementwise_max(S[2][qt], S[3][qt]));
                float mx = fmaxf(fmaxf(m4.x, m4.y), fmaxf(m4.z, m4.w));
                mx = fmaxf(mx, __shfl_xor(mx, 16)); mx = fmaxf(mx, __shfl_xor(mx, 32));
                const float mn = fmaxf(mrun[qt], mx), al = __builtin_amdgcn_exp2f(mrun[qt] - mn); mrun[qt] = mn;
                f32x4 ps4 = {0.f, 0.f, 0.f, 0.f};
#pragma unroll
                for (int kt = 0; kt < 4; ++kt) { f32x4 d = S[kt][qt] - mn; d.x = __builtin_amdgcn_exp2f(d.x); d.y = __builtin_amdgcn_exp2f(d.y); d.z = __builtin_amdgcn_exp2f(d.z); d.w = __builtin_amdgcn_exp2f(d.w); S[kt][qt] = d; ps4 = ps4 + d; }
                lrun[qt] = lrun[qt] * al + ((ps4.x + ps4.y) + (ps4.z + ps4.w));
#pragma unroll
                for (int dt = 0; dt < 4; ++dt) O[dt][qt] = O[dt][qt] * al;
            }
            bf16x8 Bp[2][2];
#pragma unroll
            for (int qt = 0; qt < 2; ++qt)
#pragma unroll
                for (int s2 = 0; s2 < 2; ++s2) { const u32x4 w = pack8(S[2 * s2][qt], S[2 * s2 + 1][qt]); Bp[qt][s2] = __builtin_bit_cast(bf16x8, w); }
#pragma unroll
            for (int dt = 0; dt < 4; ++dt)
#pragma unroll
                for (int s2 = 0; s2 < 2; ++s2) {
                    const LAS unsigned char* vp = lds + vbase + (dt * 16 + fr) * AT_PITCH + (32 * s2 + 4 * fq) * 2;
                    const u32x2 lo = *(const LAS u32x2*)vp, hi = *(const LAS u32x2*)(vp + 32);
                    const u32x4 w = {lo.x, lo.y, hi.x, hi.y}; const bf16x8 Av = __builtin_bit_cast(bf16x8, w);
#pragma unroll
                    for (int qt = 0; qt < 2; ++qt) O[dt][qt] = __builtin_amdgcn_mfma_f32_16x16x32_bf16(Av, Bp[qt][s2], O[dt][qt], 0, 0, 0);
                }
        }
        }
        __syncthreads();
    }
#pragma unroll
    for (int qt = 0; qt < 2; ++qt) {
        float l = lrun[qt]; l += __shfl_xor(l, 16); l += __shfl_xor(l, 32);
        const float inv = 1.0f / l;
#pragma unroll
        for (int dt = 0; dt < 4; ++dt) {
            const f32x4 o = O[dt][qt] * inv; u32x2 w; w.x = pg8::cvt_pk_bf16(o.x, o.y); w.y = pg8::cvt_pk_bf16(o.z, o.w);
            *(u32x2*)(oA + (tokq + qt * 16 + fr) * 512 + h * 64 + dt * 16 + 4 * fq) = w;
        }
    }
}
__device__ __forceinline__ void phase_attn(const Args& a, LAS unsigned char* lds, int layer, int wave, int lane, int tid, int G) {
    attn_stage_bias(a, lds, layer, tid);
    const LAS float* rb = (const LAS float*)lds;
    constexpr int NGRP = BATCH * A_HEADS * NCH / 4;
    const int per = (NGRP + G - 1) / G;
    for (int gi = 0; gi < per; ++gi) {
        const int grp = blockIdx.x * per + gi; if (grp >= NGRP) break;
        attn_item(a, rb, grp * 8 + wave, lane);
    }
    __syncthreads();
}


constexpr int PKR = 272, PKT = 144;
constexpr int G1_KR = 0, G1_LB = 4 * 64 * PKR, G1_CW = G1_LB + 65536, G1_GB = G1_CW + 8192, G1_BB = G1_GB + 1024, G1_GC = G1_BB + 1024, G1_END = G1_GC + 1024;
constexpr int G2_KR = 0, G2_QS = 17408, G2_KT = 34816, G2_VT = 53248, G2_VN = 71680, G2_QK = 90112, G2_ST = 99328, G2_CW = 134144, G2_SM = 140288, G2_WN = G2_SM + 2048, G2_END = G2_WN + 17408;
static_assert(G1_END <= LDS_BYTES - 16 && G2_END <= LDS_BYTES - 16, "gdn LDS maps");
#define MFMA16(a_, b_, c_) __builtin_amdgcn_mfma_f32_16x16x32_bf16((a_), (b_), (c_), 0, 0, 0)
#define LDSF(off) (*(const LAS bf16x8*)(lds + (off)))

__device__ __forceinline__ void gdn_pre_stage(const Args& a, LAS unsigned char* lds, int layer, int tid) {
    LAS float* cw = (LAS float*)(lds + G1_CW);
    const float* cwg = a.in[3] + (size_t)layer * 4 * 1536;
    for (int i = tid; i < 4 * 512; i += NTHR) cw[i] = cwg[(i >> 9) * 1536 + 512 + (i & 511)];
    __syncthreads();
}
__device__ __forceinline__ void gdn_pre_item(const Args& a, LAS unsigned char* lds, int layer, int item, int wave, int lane, int tid) {
    const int b = item >> 5, n = item & 31;
    const bf16_t* qkvB = (const bf16_t*)(a.ws + WS_QKVB); const float* bdl = (const float*)(a.ws + WS_BDL); float* gcg = (float*)(a.ws + WS_GC);
    const LAS float* cw = (const LAS float*)(lds + G1_CW); LAS float* gb = (LAS float*)(lds + G1_GB); LAS float* bb = (LAS float*)(lds + G1_BB); LAS float* gcb = (LAS float*)(lds + G1_GC);
    {
        const int tk = tid >> 3, cgp = tid & 7, hh = cgp >> 1, half = cgp & 1;
        const int tl = n * 64 + tk; const size_t r = (size_t)b * SEQ + tl;
        const int cbase = hh * 128 + half * 64;
        float kv[64];
#pragma unroll
        for (int c = 0; c < 64; ++c) kv[c] = 0.f;
#pragma unroll
        for (int i = 0; i < 4; ++i) {
            if (tl - 3 + i >= 0) {
                const u32x4* src = (const u32x4*)(qkvB + (r - 3 + i) * 1536 + 512 + cbase);
#pragma unroll
                for (int q = 0; q < 8; ++q) { const u32x4 w = src[q]; const LAS float* wp = cw + i * 512 + cbase + 8 * q;
                    const f32x4 w0 = *(const LAS f32x4*)wp, w1 = *(const LAS f32x4*)(wp + 4);
                    kv[8 * q + 0] += w0.x * bflo(w.x); kv[8 * q + 1] += w0.y * bfhi(w.x); kv[8 * q + 2] += w0.z * bflo(w.y); kv[8 * q + 3] += w0.w * bfhi(w.y);
                    kv[8 * q + 4] += w1.x * bflo(w.z); kv[8 * q + 5] += w1.y * bfhi(w.z); kv[8 * q + 6] += w1.z * bflo(w.w); kv[8 * q + 7] += w1.w * bfhi(w.w); }
            }
            asm volatile("" ::: "memory");
        }
        float ss = 0.f;
#pragma unroll
        for (int c = 0; c < 64; ++c) { kv[c] = siluf_(kv[c]); ss += kv[c] * kv[c]; }
        ss += __shfl_xor(ss, 1);
        const float rk = rsqrtf(ss + RMS_EPS);
        LAS unsigned char* dst = lds + G1_KR + hh * (64 * PKR) + tk * PKR + half * 128;
#pragma unroll
        for (int q = 0; q < 8; ++q) { f32x4 x0 = {kv[8 * q] * rk, kv[8 * q + 1] * rk, kv[8 * q + 2] * rk, kv[8 * q + 3] * rk}, x1 = {kv[8 * q + 4] * rk, kv[8 * q + 5] * rk, kv[8 * q + 6] * rk, kv[8 * q + 7] * rk};
            *(LAS u32x4*)(dst + 16 * q) = pack8(x0, x1); }
        if (half == 0) {
            const float Aexp = expf(a.in[4][layer * 4 + hh]), dtb = a.in[5][layer * 4 + hh];
            bb[hh * 64 + tk] = sigmoidf_(bdl[r * 8 + hh]);
            gb[hh * 64 + tk] = -Aexp * softplusf_(bdl[r * 8 + 4 + hh] + dtb);
        }
    }
    __syncthreads();
    {
        const int hh = wave >> 1, fr = lane & 15, fq = lane >> 4;
        float g = gb[hh * 64 + lane];
#pragma unroll
        for (int o = 1; o < 64; o <<= 1) { const float t = __shfl_up(g, o); if (lane >= o) g += t; }
        gcb[hh * 64 + lane] = g;
        if ((wave & 1) == 0) gcg[((size_t)b * SEQ + n * 64 + lane) * 4 + hh] = g;
        asm volatile("s_waitcnt lgkmcnt(0)" ::: "memory");
        const int kr = G1_KR + hh * (64 * PKR);
        LAS float* Lb = (LAS float*)(lds + G1_LB) + hh * 4096;
#pragma unroll
        for (int tt = 0; tt < 2; ++tt) {
            const int ti = 2 * (wave & 1) + tt;
            bf16x8 Af[4];
#pragma unroll
            for (int ks = 0; ks < 4; ++ks) Af[ks] = LDSF(kr + (ti * 16 + fr) * PKR + ks * 64 + fq * 16);
#pragma unroll
            for (int tj = 0; tj < 4; ++tj) {
                f32x4 acc = {0.f, 0.f, 0.f, 0.f};
                if (tj <= ti) {
#pragma unroll
                    for (int ks = 0; ks < 4; ++ks) acc = MFMA16(Af[ks], LDSF(kr + (tj * 16 + fr) * PKR + ks * 64 + fq * 16), acc);
                }
                const int j = tj * 16 + fr; const float gcj = gcb[hh * 64 + j];
#pragma unroll
                for (int rg = 0; rg < 4; ++rg) { const int i = ti * 16 + 4 * fq + rg;
                    Lb[i * 64 + j] = (i > j) ? bb[hh * 64 + i] * acc[rg] * __expf(gcb[hh * 64 + i] - gcj) : 0.f; }
            }
        }
    }
    __syncthreads();
    if (wave < 4) {
        const int hh = wave; const LAS float* Lb = (const LAS float*)(lds + G1_LB) + hh * 4096;
        float Tc[64];
        int ln = lane; asm volatile("" : "+v"(ln));
#pragma unroll
        for (int i = 0; i < 64; ++i) {
            float acc = (ln == i) ? 1.f : 0.f;
#pragma unroll
            for (int j4 = 0; j4 < (i + 3) / 4; ++j4) { const f32x4 l4 = *(const LAS f32x4*)(Lb + i * 64 + 4 * j4);
                if (4 * j4 + 0 < i) acc -= l4.x * Tc[4 * j4 + 0];
                if (4 * j4 + 1 < i) acc -= l4.y * Tc[4 * j4 + 1];
                if (4 * j4 + 2 < i) acc -= l4.z * Tc[4 * j4 + 2];
                if (4 * j4 + 3 < i) acc -= l4.w * Tc[4 * j4 + 3]; }
            Tc[i] = acc;
            if ((i & 3) == 3) asm volatile("" ::: "memory");
        }
        const float bc = bb[hh * 64 + lane], ec = bc * __expf(gcb[hh * 64 + lane]);
        bf16_t* tu = (bf16_t*)(a.ws + WS_TMU) + ((size_t)item * 4 + hh) * 4096; bf16_t* tw = (bf16_t*)(a.ws + WS_TMW) + ((size_t)item * 4 + hh) * 4096;
#pragma unroll
        for (int i = 0; i < 64; ++i) { tu[i * 64 + lane] = (bf16_t)f2bf(Tc[i] * bc); tw[i * 64 + lane] = (bf16_t)f2bf(Tc[i] * ec); }
    }
    __syncthreads();
}

__device__ __forceinline__ void st8(LAS unsigned char* p, f32x4 v) { u32x2 w; w.x = pg8::cvt_pk_bf16(v.x, v.y); w.y = pg8::cvt_pk_bf16(v.z, v.w); *(LAS u32x2*)p = w; }

__device__ __forceinline__ void gdn_scan_item(const Args& a, LAS unsigned char* lds, int layer, int item, int wave, int lane, int tid) {
    asm volatile("" : "+v"(tid), "+v"(lane));
    const int b = item >> 2, h = item & 3; int fr = lane & 15, fq = lane >> 4;
#define RELANE() asm volatile("" : "+v"(fr), "+v"(fq))
    const bf16_t* qkvB = (const bf16_t*)(a.ws + WS_QKVB); const float* bdl = (const float*)(a.ws + WS_BDL); const float* gcg = (const float*)(a.ws + WS_GC);
    const bf16_t* gateB = (const bf16_t*)(a.ws + WS_GATEB);
    bf16_t* oB = (bf16_t*)(a.ws + WS_OB);
    LAS float* cwl = (LAS float*)(lds + G2_CW);
    LAS float* gcs = (LAS float*)(lds + G2_SM); LAS float* egc = gcs + 64; LAS float* ekd = gcs + 128; LAS float* ng = gcs + 192; LAS float* red = gcs + 320;
    {
        const float* cwg = a.in[3] + (size_t)layer * 4 * 1536;
        for (int i = tid; i < 4 * 384; i += NTHR) { const int tap = i / 384, rem = i % 384, seg = rem >> 7, c = rem & 127; cwl[i] = cwg[tap * 1536 + seg * 512 + h * 128 + c]; }
        for (int i = tid; i < 128; i += NTHR) ng[i] = a.in[6][layer * 128 + i];
        for (int i = tid; i < 34816 / 16; i += NTHR) ((LAS u32x4*)(lds + G2_ST))[i] = (u32x4){0u, 0u, 0u, 0u};
    }
    f32x4 Sacc[8];
#pragma unroll
    for (int i = 0; i < 8; ++i) Sacc[i] = (f32x4){0.f, 0.f, 0.f, 0.f};
    __syncthreads();
#define G2_LBAR() asm volatile("s_waitcnt lgkmcnt(0)\n\ts_barrier" ::: "memory")
    for (int n = 0; n < NCH; ++n) {
        const size_t tok0 = (size_t)b * SEQ + n * 64;
        int zv_ = 0; asm volatile("" : "+v"(zv_));
        const float gcl = gcg[(tok0 + 63) * 4 + h + zv_];
        {
            asm volatile("" : "+v"(tid));
            const int tk = tid >> 3, cgp = tid & 7, c0 = cgp * 16;
            const int tl = n * 64 + tk; const size_t r = tok0 + tk;
            const LAS float* cwv = cwl; asm volatile("" : "+v"(cwv));
            const bf16_t* qkvb_it = qkvB + (size_t)tok0 * 1536 + h * 128;
            int rowo[4]; float vm[4];
#pragma unroll
            for (int i = 0; i < 4; ++i) { const bool ok = (tl - 3 + i >= 0); rowo[i] = (ok ? (tk - 3 + i) : tk) * 1536 + c0; vm[i] = ok ? 1.f : 0.f; }
#define rowp_(i) (qkvb_it + rowo[i])
#define G2_ACC16(d, x0, x1, wp, vm_) do { const f32x4 w0 = *(const LAS f32x4*)(wp) * (vm_), w1 = *(const LAS f32x4*)((wp) + 4) * (vm_), w2 = *(const LAS f32x4*)((wp) + 8) * (vm_), w3 = *(const LAS f32x4*)((wp) + 12) * (vm_); \
                d[0] += w0.x * bflo(x0.x); d[1] += w0.y * bfhi(x0.x); d[2] += w0.z * bflo(x0.y); d[3] += w0.w * bfhi(x0.y); d[4] += w1.x * bflo(x0.z); d[5] += w1.y * bfhi(x0.z); d[6] += w1.z * bflo(x0.w); d[7] += w1.w * bfhi(x0.w); \
                d[8] += w2.x * bflo(x1.x); d[9] += w2.y * bfhi(x1.x); d[10] += w2.z * bflo(x1.y); d[11] += w2.w * bfhi(x1.y); d[12] += w3.x * bflo(x1.z); d[13] += w3.y * bfhi(x1.z); d[14] += w3.z * bflo(x1.w); d[15] += w3.w * bfhi(x1.w); } while (0)
            u32x4 rw[4][2];
#define G2_LOAD8(segoff) do { _Pragma("unroll") for (int i = 0; i < 4; ++i) { rw[i][0] = *(const u32x4*)(rowp_(i) + (segoff)); rw[i][1] = *(const u32x4*)(rowp_(i) + (segoff) + 8); } } while (0)
            const int odd = tk & 1;
            const float gc = gcg[r * 4 + h];
            G2_LOAD8(0);
            {
                float q[16];
#pragma unroll
                for (int c = 0; c < 16; ++c) q[c] = 0.f;
#pragma unroll
                for (int i = 0; i < 4; ++i) G2_ACC16(q, rw[i][0], rw[i][1], cwv + i * 384 + c0, vm[i]);
                G2_LOAD8(512);
                float sq = 0.f;
#pragma unroll
                for (int c = 0; c < 16; ++c) { q[c] = siluf_(q[c]); sq += q[c] * q[c]; }
                sq += __shfl_xor(sq, 1); sq += __shfl_xor(sq, 2); sq += __shfl_xor(sq, 4);
                const float rq_ = rsqrtf(sq + RMS_EPS) * 0.08838834764831845f;
                f32x4 a0 = {q[0] * rq_, q[1] * rq_, q[2] * rq_, q[3] * rq_}, a1 = {q[4] * rq_, q[5] * rq_, q[6] * rq_, q[7] * rq_}, a2 = {q[8] * rq_, q[9] * rq_, q[10] * rq_, q[11] * rq_}, a3 = {q[12] * rq_, q[13] * rq_, q[14] * rq_, q[15] * rq_};
                *(LAS u32x4*)(lds + G2_QS + tk * PKR + c0 * 2) = pack8(a0, a1); *(LAS u32x4*)(lds + G2_QS + tk * PKR + c0 * 2 + 16) = pack8(a2, a3);
            }
            {
                float k[16];
#pragma unroll
                for (int c = 0; c < 16; ++c) k[c] = 0.f;
#pragma unroll
                for (int i = 0; i < 4; ++i) G2_ACC16(k, rw[i][0], rw[i][1], cwv + i * 384 + 128 + c0, vm[i]);
                G2_LOAD8(1024);
                float sk = 0.f;
#pragma unroll
                for (int c = 0; c < 16; ++c) { k[c] = siluf_(k[c]); sk += k[c] * k[c]; }
                sk += __shfl_xor(sk, 1); sk += __shfl_xor(sk, 2); sk += __shfl_xor(sk, 4);
                const float rk_ = rsqrtf(sk + RMS_EPS);
                unsigned kb[8];
#pragma unroll
                for (int c = 0; c < 8; ++c) kb[c] = pg8::cvt_pk_bf16(k[2 * c] * rk_, k[2 * c + 1] * rk_);
                *(LAS u32x4*)(lds + G2_KR + tk * PKR + c0 * 2) = (u32x4){kb[0], kb[1], kb[2], kb[3]}; *(LAS u32x4*)(lds + G2_KR + tk * PKR + c0 * 2 + 16) = (u32x4){kb[4], kb[5], kb[6], kb[7]};
#pragma unroll
                for (int c = 0; c < 8; ++c) {
                    const unsigned pk_ = (unsigned)__shfl_xor((int)kb[c], 8);
                    const unsigned wk = odd ? ((pk_ >> 16) | (kb[c] & 0xffff0000u)) : ((kb[c] & 0xffffu) | (pk_ << 16));
                    *(LAS unsigned*)(lds + G2_KT + (c0 + 2 * c + odd) * PKT + (tk & ~1) * 2) = wk;
                }
            }
            {
                float v[16];
#pragma unroll
                for (int c = 0; c < 16; ++c) v[c] = 0.f;
#pragma unroll
                for (int i = 0; i < 4; ++i) G2_ACC16(v, rw[i][0], rw[i][1], cwv + i * 384 + 256 + c0, vm[i]);
#pragma unroll
                for (int c = 0; c < 8; ++c) {
                    const unsigned vb = pg8::cvt_pk_bf16(siluf_(v[2 * c]), siluf_(v[2 * c + 1]));
                    const unsigned pv_ = (unsigned)__shfl_xor((int)vb, 8);
                    const unsigned wv = odd ? ((pv_ >> 16) | (vb & 0xffff0000u)) : ((vb & 0xffffu) | (pv_ << 16));
                    *(LAS unsigned*)(lds + G2_VT + (c0 + 2 * c + odd) * PKT + (tk & ~1) * 2) = wv;
                }
            }
#undef G2_LOAD8
#undef G2_ACC16
#undef rowp_
            if (cgp == 0) { gcs[tk] = gc; egc[tk] = __expf(gc); ekd[tk] = __expf(gcl - gc); }
        }
        const float gl = __expf(gcl);
        const bf16_t* tmu = (const bf16_t*)(a.ws + WS_TMU) + (((size_t)(b * 32 + n)) * 4 + h) * 4096; const bf16_t* tmw = (const bf16_t*)(a.ws + WS_TMW) + (((size_t)(b * 32 + n)) * 4 + h) * 4096;
        RELANE();
        bf16x8 TW[4][2];
#pragma unroll
        for (int it = 0; it < 4; ++it) { TW[it][0] = *(const bf16x8*)(tmw + (it * 16 + fr) * 64 + 8 * fq); TW[it][1] = *(const bf16x8*)(tmw + (it * 16 + fr) * 64 + 32 + 8 * fq); }
        G2_LBAR();
        RELANE();
        {
            const int tj = wave & 3;
#pragma unroll
            for (int tt = 0; tt < 2; ++tt) {
                const int ti = 2 * (wave >> 2) + tt;
                f32x4 acc = {0.f, 0.f, 0.f, 0.f};
                if (ti >= tj) {
#pragma unroll
                    for (int ks = 0; ks < 4; ++ks) acc = MFMA16(LDSF(G2_KR + (tj * 16 + fr) * PKR + ks * 64 + fq * 16), LDSF(G2_QS + (ti * 16 + fr) * PKR + ks * 64 + fq * 16), acc);
                }
                const int i = ti * 16 + fr; const float gci = gcs[i];
                f32x4 o;
#pragma unroll
                for (int rg = 0; rg < 4; ++rg) { const int j = tj * 16 + 4 * fq + rg; o[rg] = (i >= j) ? acc[rg] * __expf(gci - gcs[j]) : 0.f; }
                st8(lds + G2_QK + i * PKT + (tj * 16 + 4 * fq) * 2, o);
            }
        }
        RELANE();
        {
            const bf16x8 A0 = LDSF(G2_KT + (wave * 16 + fr) * PKT + fq * 16), A1 = LDSF(G2_KT + (wave * 16 + fr) * PKT + 64 + fq * 16);
#pragma unroll
            for (int it = 0; it < 4; ++it) {
                f32x4 acc = {0.f, 0.f, 0.f, 0.f};
                acc = MFMA16(A0, TW[it][0], acc); acc = MFMA16(A1, TW[it][1], acc);
                st8(lds + G2_WN + (it * 16 + fr) * PKR + (wave * 16 + 4 * fq) * 2, -acc);
            }
        }
        bf16x8 TU[4][2];
#pragma unroll
        for (int it = 0; it < 4; ++it) { TU[it][0] = *(const bf16x8*)(tmu + (it * 16 + fr) * 64 + 8 * fq); TU[it][1] = *(const bf16x8*)(tmu + (it * 16 + fr) * 64 + 32 + 8 * fq); }
        G2_LBAR();
        RELANE();
        f32x4 vn[4];
        {
            bf16x8 Bv[2], Bs[4];
#pragma unroll
            for (int ks = 0; ks < 2; ++ks) Bv[ks] = LDSF(G2_VT + (wave * 16 + fr) * PKT + ks * 64 + fq * 16);
#pragma unroll
            for (int ks = 0; ks < 4; ++ks) Bs[ks] = LDSF(G2_ST + (wave * 16 + fr) * PKR + ks * 64 + fq * 16);
#pragma unroll
            for (int it = 0; it < 4; ++it) {
                f32x4 acc = {0.f, 0.f, 0.f, 0.f};
#pragma unroll
                for (int ks = 0; ks < 2; ++ks) acc = MFMA16(TU[it][ks], Bv[ks], acc);
#pragma unroll
                for (int ks = 0; ks < 4; ++ks) acc = MFMA16(LDSF(G2_WN + (it * 16 + fr) * PKR + ks * 64 + fq * 16), Bs[ks], acc);
                vn[it] = acc;
            }
        }
        G2_LBAR();
        RELANE();
#pragma unroll
        for (int it = 0; it < 4; ++it) {
            st8(lds + G2_VN + (wave * 16 + fr) * PKT + (it * 16 + 4 * fq) * 2, vn[it]);
            const f32x4 e4 = *(const LAS f32x4*)(ekd + it * 16 + 4 * fq);
            st8(lds + G2_VT + (wave * 16 + fr) * PKT + (it * 16 + 4 * fq) * 2, vn[it] * e4);
        }
        G2_LBAR();
        RELANE();
        {
            const int it = wave & 3, dq = 4 * (wave >> 2);
            const size_t tok = tok0 + it * 16 + fr;
            u32x2 gt[4];
#pragma unroll
            for (int x = 0; x < 4; ++x) gt[x] = *(const u32x2*)(gateB + tok * 512 + h * 128 + (dq + x) * 16 + 4 * fq);
            bf16x8 Bq[4], Bk[2];
#pragma unroll
            for (int ks = 0; ks < 4; ++ks) Bq[ks] = LDSF(G2_QS + (it * 16 + fr) * PKR + ks * 64 + fq * 16);
#pragma unroll
            for (int ks = 0; ks < 2; ++ks) Bk[ks] = LDSF(G2_QK + (it * 16 + fr) * PKT + ks * 64 + fq * 16);
            const float eg = egc[it * 16 + fr];
            f32x4 O[4]; float ss = 0.f;
#pragma unroll
            for (int x = 0; x < 4; ++x) {
                f32x4 acc = {0.f, 0.f, 0.f, 0.f};
#pragma unroll
                for (int ks = 0; ks < 4; ++ks) acc = MFMA16(LDSF(G2_ST + ((dq + x) * 16 + fr) * PKR + ks * 64 + fq * 16), Bq[ks], acc);
                acc = acc * eg;
#pragma unroll
                for (int ks = 0; ks < 2; ++ks) acc = MFMA16(LDSF(G2_VN + ((dq + x) * 16 + fr) * PKT + ks * 64 + fq * 16), Bk[ks], acc);
                O[x] = acc; ss += (acc.x * acc.x + acc.y * acc.y) + (acc.z * acc.z + acc.w * acc.w);
            }
            ss += __shfl_xor(ss, 16); ss += __shfl_xor(ss, 32);
            if (fq == 0) red[(wave >> 2) * 64 + it * 16 + fr] = ss;
            RELANE();
            {
                const bf16x8 A0 = LDSF(G2_KT + (wave * 16 + fr) * PKT + fq * 16), A1 = LDSF(G2_KT + (wave * 16 + fr) * PKT + 64 + fq * 16);
#pragma unroll
                for (int dv = 0; dv < 8; ++dv) {
                    f32x4 acc = Sacc[dv] * gl;
                    acc = MFMA16(A0, LDSF(G2_VT + (dv * 16 + fr) * PKT + fq * 16), acc);
                    acc = MFMA16(A1, LDSF(G2_VT + (dv * 16 + fr) * PKT + 64 + fq * 16), acc);
                    Sacc[dv] = acc;
                }
            }
            G2_LBAR();
            RELANE();
            const float tot = red[it * 16 + fr] + red[64 + it * 16 + fr];
            const float rstd = rsqrtf(tot * (1.0f / 128.0f) + RMS_EPS);
#pragma unroll
            for (int x = 0; x < 4; ++x) {
                const f32x4 g4 = *(const LAS f32x4*)(ng + (dq + x) * 16 + 4 * fq);
                const float t0 = bflo(gt[x].x), t1 = bfhi(gt[x].x), t2 = bflo(gt[x].y), t3 = bfhi(gt[x].y);
                f32x4 o = O[x] * rstd * g4; o.x *= t0 * fsig(t0); o.y *= t1 * fsig(t1); o.z *= t2 * fsig(t2); o.w *= t3 * fsig(t3);
                u32x2 w; w.x = pg8::cvt_pk_bf16(o.x, o.y); w.y = pg8::cvt_pk_bf16(o.z, o.w);
                *(u32x2*)(oB + tok * 512 + h * 128 + (dq + x) * 16 + 4 * fq) = w;
            }
#pragma unroll
            for (int dv = 0; dv < 8; ++dv) st8(lds + G2_ST + (dv * 16 + fr) * PKR + (wave * 16 + 4 * fq) * 2, Sacc[dv]);
        }
        G2_LBAR();
    }
}
#undef G2_LBAR
#undef RELANE

constexpr int CW_ATTQ = 65536;
__device__ __forceinline__ void phase_pre(const Args& a, LAS unsigned char* lds, int layer, int gw, int NGW, int wave, int lane, int tid, int G) {
    gdn_pre_stage(a, lds, layer, tid);
    for (int item = blockIdx.x; item < BATCH * NCH; item += G) gdn_pre_item(a, lds, layer, item, wave, lane, tid);
    phase_pool(a, gw, NGW, lane);
}
__device__ __forceinline__ void phase_mix(const Args& a, LAS unsigned char* lds, int layer, int qsel, int wave, int lane, int tid, int G) {
    (void)qsel;
    constexpr int NSEQ = BATCH * B_HEADS, NGRP = BATCH * A_HEADS * NCH / 4;
    const bool split = G > NSEQ;
    if (!split || (int)blockIdx.x < NSEQ) {
        for (int item = blockIdx.x; item < NSEQ; item += G) gdn_scan_item(a, lds, layer, item, wave, lane, tid);
        __syncthreads();
        if (split) return;
        lane = fresh_lane(); tid = wave * 64 + lane;
    }
    attn_stage_bias(a, lds, layer, tid);
    const LAS float* rb = (const LAS float*)lds;
    const int nA = split ? G - NSEQ : G, aw = split ? (int)blockIdx.x - NSEQ : (int)blockIdx.x;
    const int per = (NGRP + nA - 1) / nA;
    for (int i = 0; i < per; ++i) {
        const int grp = aw * per + i;
        if (grp >= NGRP) break;
        attn_group(a, lds, rb, grp, wave, lane, tid);
    }
}

#define XB_TMO      128
#define XB_XCNT(j)  (256  + 64 * (j))
#define XB_XSUB(j)  (1280 + 64 * (j))
#define XB_XGEN(j)  (2304 + 64 * (j))
#define XB_TOP      3328
#define XB_TOPGEN   3392
#define XCD_BAR_WORDS 3456
#define XB_SPIN_CAP (1u << 18)

__device__ __forceinline__ unsigned xb_ld(unsigned* p)              { return __hip_atomic_load(p, __ATOMIC_RELAXED, __HIP_MEMORY_SCOPE_AGENT); }
__device__ __forceinline__ unsigned xb_add(unsigned* p, unsigned v) { return __hip_atomic_fetch_add(p, v, __ATOMIC_RELAXED, __HIP_MEMORY_SCOPE_AGENT); }
__device__ __forceinline__ unsigned xb_xcc_id() { return (unsigned)__builtin_amdgcn_s_getreg((3 << 11) | 20) & 0xFu; }
#define XB_SPIN(cond, bar) do { unsigned _sp = 0; while (cond) { __builtin_amdgcn_s_sleep(1); \
    if ((++_sp & 255u) == 0u) { if (xb_ld(&(bar)[XB_TMO])) break; if (_sp > XB_SPIN_CAP) { atomicAdd(&(bar)[XB_TMO], 1u); break; } } } } while (0)

struct XcdBarrier {
    unsigned* bar; unsigned x;
    volatile LAS unsigned* st;
};

__device__ __forceinline__ XcdBarrier xcd_barrier_post(unsigned* bar, volatile LAS unsigned* st) {
    XcdBarrier b; b.bar = bar; b.x = xb_xcc_id(); b.st = st;
    if (threadIdx.x == 0) (void)xb_add(&bar[XB_XCNT(b.x)], 1u);
    return b;
}
__device__ __forceinline__ void xcd_barrier_complete(unsigned* bar, unsigned x, unsigned& nloc, unsigned& nx) {
    const unsigned G = gridDim.x * gridDim.y * gridDim.z;
    unsigned sum, cnt, mine, sp = 0u;
    for (;;) {
        sum = 0u; cnt = 0u; mine = 0u;
#pragma unroll
        for (unsigned j = 0; j < 16; ++j) { const unsigned c = xb_ld(&bar[XB_XCNT(j)]); sum += c; cnt += (c > 0u) ? 1u : 0u; mine = (j == x) ? c : mine; }
        if (sum == G) break;
        __builtin_amdgcn_s_sleep(1);
        if ((++sp & 255u) == 0u) { if (xb_ld(&bar[XB_TMO])) break; if (sp > XB_SPIN_CAP) { atomicAdd(&bar[XB_TMO], 1u); break; } }
    }
    nloc = mine > 0u ? mine : 1u; nx = cnt > 0u ? cnt : 1u;
}

__device__ __forceinline__ void xcd_barrier(const XcdBarrier& b) {
    asm volatile("s_waitcnt vmcnt(0)" ::: "memory");
    __syncthreads();
    if (threadIdx.x == 0) {
        unsigned* bar = b.bar;
        __builtin_amdgcn_s_waitcnt(0);
        unsigned nloc = b.st[0], nx = b.st[1];
        if (nloc == 0u) { xcd_barrier_complete(bar, b.x, nloc, nx); b.st[0] = nloc; b.st[1] = nx; }
        const unsigned old = xb_add(&bar[XB_XSUB(b.x)], 1u);
        const unsigned gen = old / nloc;
        if (old + 1u == (gen + 1u) * nloc) {
            __builtin_amdgcn_fence(__ATOMIC_RELEASE, "agent");
            asm volatile("s_waitcnt vmcnt(0)" ::: "memory");
            const unsigned og = xb_add(&bar[XB_TOP], 1u);
            const unsigned tg = og / nx;
            if (og + 1u == (tg + 1u) * nx) xb_add(&bar[XB_TOPGEN], 1u);
            else XB_SPIN(xb_ld(&bar[XB_TOPGEN]) == tg, bar);
            __builtin_amdgcn_fence(__ATOMIC_ACQUIRE, "agent");
            xb_add(&bar[XB_XGEN(b.x)], 1u);
            asm volatile("s_waitcnt vmcnt(0)" ::: "memory");
        } else {
            XB_SPIN(xb_ld(&bar[XB_XGEN(b.x)]) == gen, bar);
            __builtin_amdgcn_fence(__ATOMIC_ACQUIRE, "agent");
            asm volatile("s_waitcnt vmcnt(0)" ::: "memory");
        }
    }
    __syncthreads();
}


constexpr int CW_BAR = 4096;
constexpr int LDS_BARW = LDS_BYTES - 16;
#define IN(k) (a.ph_lo <= (k) && (k) < a.ph_hi)
#define SEAM(k) do { if (fused && !((k) == PH_COUNT - 1 && layer == a.lay_hi - 1) && !((k) == a.ph_hi - 1 && a.ph_hi < PH_COUNT)) xcd_barrier(bar); } while (0)
template <int layer> __device__ __forceinline__ void layer_prog(const Args& a, LAS unsigned char* lds, const XcdBarrier& bar, bool fused, int gw, int NGW, int wave, int GT, int G) {
#define RUN(k, ...) if (IN(k)) { constexpr int nrep_ = (layer == 0 && (k) == PROBE_PH) ? 1 + PROBE_REP : 1; _Pragma("unroll") for (int rep = 0; rep < nrep_; ++rep) { \
        const int lane = fresh_lane(), tid = wave * 64 + lane, gtid = (int)blockIdx.x * NTHR + tid; (void)gtid; __VA_ARGS__; if (rep + 1 < nrep_) xcd_barrier(bar); } SEAM(k); }
    RUN(PH_CONVERT, phase_convert(a, lds, layer, gw, NGW, wave, lane, tid, gtid, GT); if (layer == 0) { __syncthreads(); phase_xconv(a, lds, gw, NGW, lane, tid); })
    RUN(PH_PROJ1, phase_g_proj1(a, lds, G, (int)blockIdx.x, wave, lane))
    RUN(PH_PRE, phase_pre(a, lds, layer, gw, NGW, wave, lane, tid, G))
    RUN(PH_MIX, phase_mix(a, lds, layer, layer * 4 + rep, wave, lane, tid, G))
    RUN(PH_GATES, phase_g_gates(a, lds, layer, G, (int)blockIdx.x, wave, lane))
    RUN(PH_BRANCH, phase_g_branch(a, lds, G, (int)blockIdx.x, wave, lane))
    RUN(PH_OUT, phase_g_out(a, lds, G, (int)blockIdx.x, wave, lane))
    RUN(PH_LN1, phase_ln1(a, lds, layer, gw, NGW, wave, lane))
    RUN(PH_SLOTS, phase_slots(a, lds, gw, NGW, wave, lane, tid))
    RUN(PH_MOE1, phase_moe1(a, lds, G, (int)blockIdx.x, tid, wave, lane))
    RUN(PH_MOE2, phase_moe2(a, lds, G, (int)blockIdx.x, tid, wave, lane))
    RUN(PH_LN2, phase_ln2(a, lds, layer, gw, NGW, lane, tid))
#undef RUN
}
#undef IN
#undef SEAM
__global__ void __launch_bounds__(NTHR, 2) mk(Args a) {
    extern __shared__ __attribute__((aligned(16))) unsigned char lds_raw[];
    LAS unsigned char* lds = (LAS unsigned char*)lds_raw;
    const int tid = threadIdx.x, lane = tid & 63, wave = __builtin_amdgcn_readfirstlane(tid >> 6);
    const int G = gridDim.x, gw = blockIdx.x * NWAVES + wave, NGW = G * NWAVES, gtid = blockIdx.x * NTHR + tid, GT = G * NTHR;
    const bool fused = (a.ph_hi - a.ph_lo > 1) || (a.lay_hi - a.lay_lo > 1);
    if (tid == 0) *(LAS u32x4*)(lds + LDS_BARW) = (u32x4){0u, 0u, 0u, 0u};
    __syncthreads();
    XcdBarrier bar; bar.bar = (unsigned*)(a.ws + WS_CTL) + CW_BAR; bar.x = 0; bar.st = (volatile LAS unsigned*)(lds + LDS_BARW);
    if (fused) bar = xcd_barrier_post((unsigned*)(a.ws + WS_CTL) + CW_BAR, (volatile LAS unsigned*)(lds + LDS_BARW));
    if (a.lay_lo <= 0 && 0 < a.lay_hi) layer_prog<0>(a, lds, bar, fused, gw, NGW, wave, GT, G);
    if (a.lay_lo <= 1 && 1 < a.lay_hi) layer_prog<1>(a, lds, bar, fused, gw, NGW, wave, GT, G);
}

extern "C" void kernel_launch(void* const* d_in, const int* in_sizes, int n_in, void* d_out, int out_size, void* d_ws, size_t ws_size, hipStream_t stream) {
    static int grid = 0;
    if (grid == 0) {
        if (n_in != 25 || in_sizes[0] != T * D || out_size != T * D || ws_size < WS_END) { fprintf(stderr, "kernel_launch: unexpected shapes (n_in %d, in0 %d, out %d, ws %zu < %zu)\n", n_in, n_in > 0 ? in_sizes[0] : -1, out_size, ws_size, (size_t)WS_END); grid = -1; return; }
        int dev = 0, cus = 0;
        if (hipGetDevice(&dev) != hipSuccess || hipDeviceGetAttribute(&cus, hipDeviceAttributeMultiprocessorCount, dev) != hipSuccess) { grid = -1; return; }
        if (hipFuncSetAttribute((const void*)mk, hipFuncAttributeMaxDynamicSharedMemorySize, LDS_BYTES) != hipSuccess) { fprintf(stderr, "kernel_launch: hipFuncSetAttribute failed\n"); grid = -1; return; }
        grid = cus;
    }
    if (grid < 0) return;
    unsigned char* ws = (unsigned char*)d_ws;
    (void)hipMemsetAsync(ws + WS_CTL, 0, 1 * MiB, stream);
    Args a{};
    for (int i = 0; i < 25; ++i) a.in[i] = (const float*)d_in[i];
    a.out = (float*)d_out; a.ws = ws;
#if MK_N_LAUNCHES == 1
    a.lay_lo = 0; a.lay_hi = DEPTH; a.ph_lo = 0; a.ph_hi = PH_COUNT;
    hipLaunchKernelGGL(mk, dim3(grid), dim3(NTHR), LDS_BYTES, stream, a);
#else
    for (int layer = 0; layer < DEPTH; ++layer) for (int ph = 0; ph < PH_COUNT; ++ph) { a.lay_lo = layer; a.lay_hi = layer + 1; a.ph_lo = ph; a.ph_hi = ph + 1; hipLaunchKernelGGL(mk, dim3(grid), dim3(NTHR), LDS_BYTES, stream, a); }
#endif
}
```
